# Optimizing an MI355X kernel written in HIP

```python
import math
import jax, jax.numpy as jnp
from jax import lax
import numpy as np

D_MODEL = 1024
BATCH = 8
SEQ = 2048
DEPTH = 4

N_Q_HEADS = 8
N_KV_HEADS = 2
HEAD_DIM = 64
Q_GROUP = N_Q_HEADS // N_KV_HEADS
WINDOW = 128
BLOCK = 128
ROPE_THETA = 500000.0
ROT_DIM = HEAD_DIM // 4
ATTN_WIDTH = N_Q_HEADS * HEAD_DIM
KV_WIDTH = N_KV_HEADS * HEAD_DIM
NEG_INF = -1e30
CONV_WIDTH = D_MODEL // 2
CONV_K = 3
SSM_WIDTH = D_MODEL // 2
SSM_GROUP = 16
SSM_GROUPS = SSM_WIDTH // SSM_GROUP
SSM_STATE = 64
DT_MIN = 1e-3
DT_MAX = 1e-1
N_BRANCH = 3
GATE_WIDTH = N_BRANCH * D_MODEL
FFN_HIDDEN = -(-8 * D_MODEL // (3 * 256)) * 256
NORM_EPS = 1e-6

IN_SIZES = (ATTN_WIDTH, KV_WIDTH, KV_WIDTH, CONV_WIDTH, CONV_WIDTH, CONV_WIDTH, SSM_WIDTH, GATE_WIDTH)
IN_COLS = sum(IN_SIZES)
IN_SPLITS = tuple(int(v) for v in np.cumsum(IN_SIZES)[:-1])

kernel_name = "hybrid_gated_swa_conv_s5_block"


def rmsnorm(x, g):
    xf = x.astype(jnp.float32)
    y = xf * lax.rsqrt(jnp.mean(xf * xf, axis=-1, keepdims=True) + NORM_EPS)
    return (y * g.astype(jnp.float32)).astype(x.dtype)


def rope_tables(seq_len):
    pos = jnp.arange(seq_len, dtype=jnp.float32)
    inv_freq = ROPE_THETA ** (-jnp.arange(0, ROT_DIM, 2, dtype=jnp.float32) / ROT_DIM)
    ang = pos[:, None] * inv_freq[None, :]
    return jnp.cos(ang), jnp.sin(ang)


def partial_rope(t, cos, sin):
    half = ROT_DIM // 2
    tf = t.astype(jnp.float32)
    t1, t2, rest = tf[..., :half], tf[..., half:ROT_DIM], tf[..., ROT_DIM:]
    c = cos[None, :, None, :]
    s = sin[None, :, None, :]
    out = jnp.concatenate([t1 * c - t2 * s, t2 * c + t1 * s, rest], axis=-1)
    return out.astype(t.dtype)


def sliding_window_attention(q, k, v, sinks):
    b, l = q.shape[0], q.shape[1]
    nb = l // BLOCK
    qb = q.reshape(b, nb, BLOCK, N_KV_HEADS, Q_GROUP, HEAD_DIM).astype(jnp.float32)

    def band(t):
        tp = jnp.pad(t, ((0, 0), (BLOCK, 0), (0, 0), (0, 0)))
        tp = tp.reshape(b, nb + 1, BLOCK, N_KV_HEADS, HEAD_DIM)
        return jnp.concatenate([tp[:, :-1], tp[:, 1:]], axis=2).astype(jnp.float32)

    kb, vb = band(k), band(v)
    s = jnp.einsum("bnqkgd,bnskd->bnkgqs", qb, kb) * (HEAD_DIM ** -0.5)
    qi = jnp.arange(BLOCK)[:, None]
    kj = jnp.arange(2 * BLOCK)[None, :]
    delta = qi + BLOCK - kj
    band_ok = (delta >= 0) & (delta < WINDOW)
    kpos = jnp.arange(nb)[:, None] * BLOCK - BLOCK + kj
    mask = band_ok[None, :, :] & (kpos >= 0)[:, None, :]
    s = jnp.where(mask[None, :, None, None, :, :], s, NEG_INF)
    sink = sinks.astype(jnp.float32).reshape(N_KV_HEADS, Q_GROUP)[None, None, :, :, None, None]
    m = jnp.maximum(jnp.max(s, axis=-1, keepdims=True), sink)
    p = jnp.exp(s - m)
    denom = jnp.sum(p, axis=-1, keepdims=True) + jnp.exp(sink - m)
    o = jnp.einsum("bnkgqs,bnskd->bnqkgd", p / denom, vb)
    return o.reshape(b, l, ATTN_WIDTH).astype(q.dtype)


def short_conv(z, w):
    l = z.shape[1]
    zp = jnp.pad(z, ((0, 0), (CONV_K - 1, 0), (0, 0)))
    y = w[0] * zp[:, 0:l]
    for j in range(1, CONV_K):
        y = y + w[j] * zp[:, j:j + l]
    return y


def s5_ssm(u, a_re, a_im, b_re, b_im, c_re, c_im, d, log_dt):
    bsz, l = u.shape[0], u.shape[1]
    uf = u.astype(jnp.float32).reshape(bsz, l, SSM_GROUPS, SSM_GROUP)
    lam = lax.complex(a_re.astype(jnp.float32), a_im.astype(jnp.float32))
    dt = jnp.exp(log_dt.astype(jnp.float32))[:, None]
    lam_bar = jnp.exp(lam * dt)
    b_c = lax.complex(b_re.astype(jnp.float32), b_im.astype(jnp.float32))
    b_bar = ((lam_bar - 1.0) / lam)[..., None] * b_c
    bu = jnp.einsum("blgh,gph->blgp", uf.astype(jnp.complex64), b_bar)
    a_elems = jnp.broadcast_to(lam_bar, bu.shape)

    def combine(e1, e2):
        a1, x1 = e1
        a2, x2 = e2
        return a1 * a2, a2 * x1 + x2

    _, states = lax.associative_scan(combine, (a_elems, bu), axis=1)
    c_c = lax.complex(c_re.astype(jnp.float32), c_im.astype(jnp.float32))
    y = jnp.einsum("blgp,ghp->blgh", states, c_c).real
    y = y + d.astype(jnp.float32).reshape(SSM_GROUPS, SSM_GROUP) * uf
    return y.reshape(bsz, l, SSM_WIDTH).astype(u.dtype)


def setup_inputs(seed: int = 0) -> dict:
    key = jax.random.key(seed)
    ks = jax.random.split(key, 24)
    L = DEPTH

    def nrm(k, shape, fan_in):
        return jax.random.normal(k, shape, jnp.float32) * (fan_in ** -0.5)

    x = jax.random.normal(ks[0], (BATCH, SEQ, D_MODEL), jnp.float32)
    norm_mix = 1.0 + 0.02 * jax.random.normal(ks[1], (L, D_MODEL), jnp.float32)
    w_in = nrm(ks[2], (L, D_MODEL, IN_COLS), D_MODEL)
    b_gate = 0.02 * jax.random.normal(ks[3], (L, GATE_WIDTH), jnp.float32)
    attn_sinks = 0.5 * jax.random.normal(ks[4], (L, N_Q_HEADS), jnp.float32)
    w_attn_o = nrm(ks[5], (L, ATTN_WIDTH, D_MODEL), ATTN_WIDTH)
    conv_w = nrm(ks[6], (L, CONV_K, CONV_WIDTH), CONV_K)
    w_conv_o = nrm(ks[7], (L, CONV_WIDTH, D_MODEL), CONV_WIDTH)
    ssm_a_re = -0.5 + 0.01 * jax.random.normal(ks[8], (L, SSM_GROUPS, SSM_STATE), jnp.float32)
    ssm_a_im = (math.pi * jnp.arange(SSM_STATE, dtype=jnp.float32))[None, None, :] \
        + 0.01 * jax.random.normal(ks[9], (L, SSM_GROUPS, SSM_STATE), jnp.float32)
    ssm_b_re = nrm(ks[10], (L, SSM_GROUPS, SSM_STATE, SSM_GROUP), 2 * SSM_GROUP)
    ssm_b_im = nrm(ks[11], (L, SSM_GROUPS, SSM_STATE, SSM_GROUP), 2 * SSM_GROUP)
    ssm_c_re = nrm(ks[12], (L, SSM_GROUPS, SSM_GROUP, SSM_STATE), 2 * SSM_STATE)
    ssm_c_im = nrm(ks[13], (L, SSM_GROUPS, SSM_GROUP, SSM_STATE), 2 * SSM_STATE)
    ssm_d = jax.random.normal(ks[14], (L, SSM_WIDTH), jnp.float32)
    ssm_log_dt = jax.random.uniform(ks[15], (L, SSM_GROUPS), jnp.float32,
                                    minval=math.log(DT_MIN), maxval=math.log(DT_MAX))
    w_ssm_glu = nrm(ks[16], (L, SSM_WIDTH, SSM_WIDTH), SSM_WIDTH)
    w_ssm_o = nrm(ks[17], (L, SSM_WIDTH, D_MODEL), SSM_WIDTH)
    w_mix_o = nrm(ks[18], (L, D_MODEL, D_MODEL), D_MODEL)
    norm_ffn = 1.0 + 0.02 * jax.random.normal(ks[19], (L, D_MODEL), jnp.float32)
    w_ffn_in = nrm(ks[20], (L, D_MODEL, 2 * FFN_HIDDEN), D_MODEL)
    w_ffn_out = nrm(ks[21], (L, FFN_HIDDEN, D_MODEL), FFN_HIDDEN)
    norm_final = 1.0 + 0.02 * jax.random.normal(ks[22], (D_MODEL,), jnp.float32)
    return {"x": x, "norm_mix": norm_mix, "w_in": w_in, "b_gate": b_gate,
            "attn_sinks": attn_sinks, "w_attn_o": w_attn_o, "conv_w": conv_w, "w_conv_o": w_conv_o,
            "ssm_a_re": ssm_a_re, "ssm_a_im": ssm_a_im, "ssm_b_re": ssm_b_re, "ssm_b_im": ssm_b_im,
            "ssm_c_re": ssm_c_re, "ssm_c_im": ssm_c_im, "ssm_d": ssm_d, "ssm_log_dt": ssm_log_dt,
            "w_ssm_glu": w_ssm_glu, "w_ssm_o": w_ssm_o, "w_mix_o": w_mix_o, "norm_ffn": norm_ffn,
            "w_ffn_in": w_ffn_in, "w_ffn_out": w_ffn_out, "norm_final": norm_final}


def reference(x, norm_mix, w_in, b_gate, attn_sinks, w_attn_o, conv_w, w_conv_o,
              ssm_a_re, ssm_a_im, ssm_b_re, ssm_b_im, ssm_c_re, ssm_c_im, ssm_d, ssm_log_dt,
              w_ssm_glu, w_ssm_o, w_mix_o, norm_ffn, w_ffn_in, w_ffn_out, norm_final):
    b, l = x.shape[0], x.shape[1]
    cos, sin = rope_tables(l)
    for i in range(DEPTH):
        h = rmsnorm(x, norm_mix[i])
        proj = h @ w_in[i]
        q, k, v, cb, cc, cx, u, g = jnp.split(proj, IN_SPLITS, axis=-1)
        q = partial_rope(q.reshape(b, l, N_Q_HEADS, HEAD_DIM), cos, sin)
        k = partial_rope(k.reshape(b, l, N_KV_HEADS, HEAD_DIM), cos, sin)
        v = v.reshape(b, l, N_KV_HEADS, HEAD_DIM)
        y_attn = sliding_window_attention(q, k, v, attn_sinks[i]) @ w_attn_o[i]
        y_conv = (cb * short_conv(cc * cx, conv_w[i])) @ w_conv_o[i]
        ys = jax.nn.gelu(s5_ssm(u, ssm_a_re[i], ssm_a_im[i], ssm_b_re[i], ssm_b_im[i],
                                ssm_c_re[i], ssm_c_im[i], ssm_d[i], ssm_log_dt[i]))
        y_ssm = (ys * jax.nn.sigmoid(ys @ w_ssm_glu[i])) @ w_ssm_o[i]
        gates = jax.nn.sigmoid(g + b_gate[i]).reshape(b, l, N_BRANCH, D_MODEL)
        merged = gates[:, :, 0] * y_attn + gates[:, :, 1] * y_conv + gates[:, :, 2] * y_ssm
        x = x + merged @ w_mix_o[i]
        h = rmsnorm(x, norm_ffn[i])
        gt, up = jnp.split(h @ w_ffn_in[i], 2, axis=-1)
        x = x + (jax.nn.silu(gt) * up) @ w_ffn_out[i]
    return rmsnorm(x, norm_final)
```

```cpp
#include <hip/hip_runtime.h>
#include <cstdio>
#include <cstdint>

#ifndef FAST_GEMM
#define FAST_GEMM 1
#endif
#ifndef N_LAUNCH_MODE
#define N_LAUNCH_MODE 1
#endif

#define LAS __attribute__((address_space(3)))
#define GAS __attribute__((address_space(1)))
typedef unsigned short bf16_t;
typedef short bf16x8 __attribute__((ext_vector_type(8)));
typedef float f32x4 __attribute__((ext_vector_type(4)));
typedef float f32x2 __attribute__((ext_vector_type(2)));
typedef unsigned u32x4 __attribute__((ext_vector_type(4)));
typedef unsigned u32x2 __attribute__((ext_vector_type(2)));

constexpr int DM = 1024, BATCH = 8, SEQ = 2048, DEPTH = 4, MTOK = BATCH * SEQ;
constexpr int INCOLS = 5888, FFN = 2816, FFN2 = 5632;
constexpr int C_Q = 0, C_K = 512, C_V = 640, C_CB = 768, C_CC = 1280, C_CX = 1792, C_U = 2304, C_G = 2816;
constexpr float NORM_EPS = 1e-6f;
constexpr float LOG2E = 1.4426950408889634f;
constexpr float QSCALE = 0.125f * LOG2E;

constexpr size_t MiB = 1u << 20;
constexpr size_t WS_CTL = 0;
constexpr size_t ZERO_BYTES = 1 * MiB;
constexpr size_t WS_SSM = 1 * MiB;
constexpr size_t WS_ROPE = 4 * MiB;
constexpr size_t WS_ROWSS = 5 * MiB;
constexpr size_t WS_W = 7 * MiB;
constexpr size_t W_BUF = 34 * MiB;
constexpr size_t WS_XBF = 75 * MiB;
constexpr size_t WS_R1 = 107 * MiB;
constexpr size_t WS_R2 = 195 * MiB;
constexpr size_t WS_R3 = 291 * MiB;
constexpr size_t WS_SSMM = 339 * MiB;
constexpr size_t SSMM_BUF = 9 * MiB;
constexpr size_t WS_END = 357 * MiB;
constexpr size_t SM_WY = 0, SM_GT = 6 * MiB, SM_L16 = 8 * MiB;
constexpr size_t WO_IN = 0, WO_AO = WO_IN + (size_t)INCOLS * DM, WO_CO = WO_AO + 1024 * 512, WO_GLU = WO_CO + 1024 * 512, WO_SO = WO_GLU + 512 * 512,
                 WO_MIX = WO_SO + 1024 * 512, WO_FI = WO_MIX + 1024 * 1024, WO_FO = WO_FI + (size_t)FFN2 * DM, WO_END = WO_FO + (size_t)DM * FFN;
static_assert(WO_END * 2 <= 34 * MiB, "weights fit");
constexpr size_t SO_LAM = 0;
constexpr size_t SO_BBAR = 64 * 1024;
constexpr size_t SO_POW = SO_BBAR + 32 * 64 * 16 * 2 * 4;
constexpr size_t SO_LAYER = 768 * 1024;

constexpr int RING_BYTES = 131072;
constexpr int MISC_OFF = RING_BYTES + 320;
constexpr int RSTAB_OFF = RING_BYTES + 4096;
constexpr int LDS_BYTES = 147456;
constexpr int NWAVES = 8, NTHREADS = 512;

__device__ __forceinline__ unsigned f2bf(float f) { unsigned u = __builtin_bit_cast(unsigned, f); return (u + 0x7fffu + ((u >> 16) & 1u)) >> 16; }
typedef __bf16 bf16x2_hw __attribute__((ext_vector_type(2)));
__device__ __forceinline__ unsigned pk2(float lo, float hi) { const f32x2 v = {lo, hi}; const bf16x2_hw b = __builtin_convertvector(v, bf16x2_hw); return __builtin_bit_cast(unsigned, b); }
__device__ __forceinline__ float bf2f(unsigned short b) { return __builtin_bit_cast(float, (unsigned)b << 16); }
__device__ __forceinline__ float bflo(unsigned w) { return __builtin_bit_cast(float, w << 16); }
__device__ __forceinline__ float bfhi(unsigned w) { return __builtin_bit_cast(float, w & 0xffff0000u); }
__device__ __forceinline__ void unpack8(const u32x4 w, float (&v)[8]) { v[0] = bflo(w.x); v[1] = bfhi(w.x); v[2] = bflo(w.y); v[3] = bfhi(w.y); v[4] = bflo(w.z); v[5] = bfhi(w.z); v[6] = bflo(w.w); v[7] = bfhi(w.w); }
__device__ __forceinline__ u32x4 pack8(const float (&v)[8]) { u32x4 w; w.x = pk2(v[0], v[1]); w.y = pk2(v[2], v[3]); w.z = pk2(v[4], v[5]); w.w = pk2(v[6], v[7]); return w; }
__device__ __forceinline__ float sigmoidf_(float x) { return __builtin_amdgcn_rcpf(1.0f + __builtin_amdgcn_exp2f(-LOG2E * x)); }
__device__ __forceinline__ float gelu_tanh(float y) { const float t = (1.5957691216057308f * LOG2E) * (y + 0.044715f * y * y * y); return y * __builtin_amdgcn_rcpf(1.0f + __builtin_amdgcn_exp2f(-t)); }
__device__ __forceinline__ float wave_sum(float v) {
#pragma unroll
    for (int o = 1; o < 64; o <<= 1) v += __shfl_xor(v, o);
    return v;
}

__device__ __forceinline__ int opaque_tid() { int t = threadIdx.x; asm volatile("" : "+v"(t)); return t; }
__device__ __forceinline__ float row_rs(const float* ss, int row) {
    const f32x4* p = (const f32x4*)(ss + (size_t)row * 16); const f32x4 a = p[0], b = p[1], c = p[2], d = p[3];
    const float t = ((a[0] + a[1]) + (a[2] + a[3])) + ((b[0] + b[1]) + (b[2] + b[3])) + (((c[0] + c[1]) + (c[2] + c[3])) + ((d[0] + d[1]) + (d[2] + d[3])));
    return __builtin_amdgcn_rsqf(t * (1.0f / DM) + NORM_EPS);
}
namespace pg8 {
constexpr int BM = 256, BK = 64, HALF = 128, HTB = HALF * BK * 2, STAGE_BYTES = 8 * HTB, NXCD = 8, WGM = 8;
struct Unit { int pm, pn, seg; };
struct Gemm { const bf16_t* A0; const bf16_t* A1; const bf16_t* A2; const bf16_t* B0; const bf16_t* B1; const bf16_t* B2; int K; };
__device__ __forceinline__ const bf16_t* sel3(const bf16_t* p0, const bf16_t* p1, const bf16_t* p2, int s) {
    unsigned long long a = (unsigned long long)p0, b = (unsigned long long)p1, c = (unsigned long long)p2;
    asm volatile("" : "+s"(a), "+s"(b), "+s"(c));
    return (const bf16_t*)(s == 0 ? a : (s == 1 ? b : c)); }
__device__ __forceinline__ const bf16_t* selA(const Gemm& g, int s) { return sel3(g.A0, g.A1, g.A2, s); }
__device__ __forceinline__ const bf16_t* selB(const Gemm& g, int s) { return sel3(g.B0, g.B1, g.B2, s); }

struct StaticOrder {
    int nM, nN, nwg, G, c, nseg;
    __device__ void init(int M, int N, int G_, int c_, int nseg_) { nM = M / BM; nN = N / BM; nwg = nM * nN; G = G_; c = c_; nseg = nseg_; }
    __device__ bool next(int i, Unit& u) const {
        const int ti = i / nseg; u.seg = i - ti * nseg;
        const long L = (long)ti * G + c; if (L >= nwg) return false;
        int wgid = (int)L; { const int q = nwg / NXCD, r = nwg % NXCD, xcd = wgid % NXCD, off = wgid / NXCD; wgid = (xcd < r ? xcd * (q + 1) : r * (q + 1) + (xcd - r) * q) + off; }
        const int nig = WGM * nN, gid = wgid / nig, fm = gid * WGM, gsz = (nM - fm) < WGM ? (nM - fm) : WGM;
        u.pm = fm + ((wgid % nig) % gsz); u.pn = (wgid % nig) / gsz; return true;
    }
};

typedef f32x4 Acc[2][2][4][2];

struct EpiInProj {
    static constexpr bool NEEDS_RS = true;
    const float* rowss; const float* ropec; const float* ropes; const float* bgate;
    bf16_t *Q, *Kb, *Vb, *CB, *CC, *CX, *U, *Gt;
    __device__ __forceinline__ bool operator()(Acc& acc, const Unit& u, int wr, int wc, int fr, int fq, const LAS float* rstab) const {
#pragma unroll
        for (int bj = 0; bj < 2; ++bj) {
            const int colt = u.pn * BM + bj * HALF;
            const int cl = wc * 32 + 8 * fq;
            bf16_t* dst; int pitch, mode;
            if (colt < C_K) { dst = Q + colt + cl; pitch = 512; mode = 2; }
            else if (colt < C_V) { dst = Kb + cl; pitch = 128; mode = 1; }
            else if (colt < C_CB) { dst = Vb + cl; pitch = 128; mode = 0; }
            else if (colt < C_CC) { dst = CB + (colt - C_CB) + cl; pitch = 512; mode = 0; }
            else if (colt < C_CX) { dst = CC + (colt - C_CC) + cl; pitch = 512; mode = 0; }
            else if (colt < C_U) { dst = CX + (colt - C_CX) + cl; pitch = 512; mode = 0; }
            else if (colt < C_G) { const int cu = (colt - C_U) + cl; dst = U + (size_t)(cu >> 4) * SEQ * 16 + (cu & 15); pitch = 16; mode = 3; }
            else { dst = Gt + (colt - C_G) + cl; pitch = 3072; mode = 4; }
            const bool rope = (mode == 1 || mode == 2) && ((wc & 1) == 0);
            float bg[8];
#pragma unroll
            for (int e = 0; e < 8; ++e) bg[e] = 0.f;
            if (mode == 4) { const f32x4 b0 = *(const f32x4*)(bgate + (colt - C_G) + cl), b1 = *(const f32x4*)(bgate + (colt - C_G) + cl + 4);
#pragma unroll
                for (int e = 0; e < 4; ++e) { bg[e] = b0[e]; bg[4 + e] = b1[e]; } }
#pragma unroll
            for (int ai = 0; ai < 2; ++ai)
#pragma unroll
                for (int m = 0; m < 4; ++m) {
                    const int row = u.pm * BM + ai * HALF + wr * 64 + m * 16 + fr;
                    const float rs = rstab[ai * HALF + wr * 64 + m * 16 + fr];
                    float v[8];
#pragma unroll
                    for (int e = 0; e < 4; ++e) { v[e] = acc[ai][bj][m][0][e] * rs; v[4 + e] = acc[ai][bj][m][1][e] * rs; }
                    if (rope) {
                        const int pos = row & (SEQ - 1);
                        const f32x4 c0 = *(const f32x4*)(ropec + pos * 8), c1 = *(const f32x4*)(ropec + pos * 8 + 4);
                        const f32x4 s0 = *(const f32x4*)(ropes + pos * 8), s1 = *(const f32x4*)(ropes + pos * 8 + 4);
                        const float sgn = (fq == 0) ? -1.f : 1.f;
#pragma unroll
                        for (int e = 0; e < 8; ++e) {
                            const float p = __shfl_xor(v[e], 16);
                            const float cs = e < 4 ? c0[e & 3] : c1[e & 3], sn = e < 4 ? s0[e & 3] : s1[e & 3];
                            const float r = v[e] * cs + sgn * p * sn;
                            v[e] = (fq < 2) ? r : v[e];
                        }
                    }
                    if (mode == 2) {
#pragma unroll
                        for (int e = 0; e < 8; ++e) v[e] *= QSCALE;
                    }
                    if (mode == 4) {
#pragma unroll
                        for (int e = 0; e < 8; ++e) { const float x = fminf(fmaxf(v[e] + bg[e], -60.f), 60.f); v[e] = sigmoidf_(x); }
                    }
                    size_t off;
                    if (mode == 3) off = ((size_t)(row >> 11) * 32 * SEQ + (row & (SEQ - 1))) * 16; else off = (size_t)row * pitch;
                    *(u32x4*)(dst + off) = pack8(v);
                    asm volatile("" ::: "memory");
                }
        }
        return true;
    }
};

struct EpiGlu {
    static constexpr bool NEEDS_RS = false;
    const float* rowss; const bf16_t* YS; bf16_t* Z;
    __device__ __forceinline__ bool operator()(Acc& acc, const Unit& u, int wr, int wc, int fr, int fq, const LAS float*) const {
        u32x4 yv[2][4][2];
#pragma unroll
        for (int ai = 0; ai < 2; ++ai)
#pragma unroll
            for (int m = 0; m < 4; ++m)
#pragma unroll
                for (int bj = 0; bj < 2; ++bj) yv[ai][m][bj] = *(const u32x4*)(YS + (size_t)(u.pm * BM + ai * HALF + wr * 64 + m * 16 + fr) * 512 + u.pn * BM + bj * HALF + wc * 32 + 8 * fq);
#pragma unroll
        for (int ai = 0; ai < 2; ++ai) {
#pragma unroll
            for (int m = 0; m < 4; ++m)
#pragma unroll
                for (int bj = 0; bj < 2; ++bj) {
                    float y[8]; unpack8(yv[ai][m][bj], y);
                    float v[8];
#pragma unroll
                    for (int e = 0; e < 4; ++e) { v[e] = y[e] * sigmoidf_(acc[ai][bj][m][0][e]); v[4 + e] = y[4 + e] * sigmoidf_(acc[ai][bj][m][1][e]); }
                    *(u32x4*)(Z + (size_t)(u.pm * BM + ai * HALF + wr * 64 + m * 16 + fr) * 512 + u.pn * BM + bj * HALF + wc * 32 + 8 * fq) = pack8(v);
                }
            asm volatile("" ::: "memory");
        }
        return true;
    }
};

struct EpiMerge {
    static constexpr bool NEEDS_RS = false;
    const float* rowss; const bf16_t* Gt; bf16_t* Mg; int seg_base;
    __device__ __forceinline__ bool operator()(Acc& acc, const Unit& u, int wr, int wc, int fr, int fq, const LAS float*) const {
        const int s = u.seg + seg_base;
        const bf16_t* gp = Gt + (size_t)(u.pm * BM + wr * 64 + fr) * 3072 + s * 1024 + u.pn * BM + wc * 32 + 8 * fq;
        bf16_t* mp = Mg + (size_t)(u.pm * BM + wr * 64 + fr) * DM + u.pn * BM + wc * 32 + 8 * fq;
#pragma unroll
        for (int ai = 0; ai < 2; ++ai) {
            u32x4 ga[4][2], gb[4][2];
#pragma unroll
            for (int m = 0; m < 4; ++m)
#pragma unroll
                for (int bj = 0; bj < 2; ++bj) {
                    const size_t o = (size_t)(ai * HALF + m * 16) * 3072 + bj * HALF;
                    ga[m][bj] = *(const u32x4*)(gp + o);
                    gb[m][bj] = (s < 2) ? *(const u32x4*)(gp + o + 1024) : ga[m][bj];
                }
#pragma unroll
            for (int m = 0; m < 4; ++m)
#pragma unroll
                for (int bj = 0; bj < 2; ++bj) {
                    float fa[8], fb[8]; unpack8(ga[m][bj], fa); unpack8(gb[m][bj], fb);
                    if (s < 2) {
#pragma unroll
                        for (int e = 0; e < 4; ++e) { acc[ai][bj][m][0][e] *= fa[e] * __builtin_amdgcn_rcpf(fb[e]); acc[ai][bj][m][1][e] *= fa[4 + e] * __builtin_amdgcn_rcpf(fb[4 + e]); }
                    } else {
                        float v[8];
#pragma unroll
                        for (int e = 0; e < 4; ++e) { v[e] = acc[ai][bj][m][0][e] * fa[e]; v[4 + e] = acc[ai][bj][m][1][e] * fa[4 + e]; }
                        *(u32x4*)(mp + (size_t)(ai * HALF + m * 16) * DM + bj * HALF) = pack8(v);
                    }
                }
            asm volatile("" ::: "memory");
        }
        return s == 2;
    }
};

struct EpiResid {
    static constexpr bool NEEDS_RS = false;
    const float* rowss; const float* Xin; float* X; bf16_t* XB; float* ss_next; bool dry;
    __device__ __forceinline__ bool operator()(Acc& acc, const Unit& u, int wr, int wc, int fr, int fq, const LAS float*) const {
        const int row0 = u.pm * BM + wr * 64 + fr, col0 = u.pn * BM + wc * 32 + 8 * fq;
        float* xp0 = X + (size_t)row0 * DM + col0; bf16_t* xb0 = XB + (size_t)row0 * DM + col0; const float* xi0 = Xin + (size_t)row0 * DM + col0;
#pragma unroll
        for (int ai = 0; ai < 2; ++ai) {
            f32x4 xv[4][2][2];
#pragma unroll
            for (int m = 0; m < 4; ++m)
#pragma unroll
                for (int bj = 0; bj < 2; ++bj) { const float* xp = xi0 + (size_t)(ai * HALF + m * 16) * DM + bj * HALF; xv[m][bj][0] = *(const f32x4*)xp; xv[m][bj][1] = *(const f32x4*)(xp + 4); }
#pragma unroll
            for (int m = 0; m < 4; ++m) {
                float ssq = 0.f;
#pragma unroll
                for (int bj = 0; bj < 2; ++bj) {
                    const size_t o = (size_t)(ai * HALF + m * 16) * DM + bj * HALF;
                    const f32x4 x0 = dry ? xv[m][bj][0] : xv[m][bj][0] + acc[ai][bj][m][0], x1 = dry ? xv[m][bj][1] : xv[m][bj][1] + acc[ai][bj][m][1];
                    *(f32x4*)(xp0 + o) = x0; *(f32x4*)(xp0 + o + 4) = x1;
                    const float v[8] = {x0[0], x0[1], x0[2], x0[3], x1[0], x1[1], x1[2], x1[3]};
#pragma unroll
                    for (int e = 0; e < 8; ++e) ssq += v[e] * v[e];
                    *(u32x4*)(xb0 + o) = pack8(v);
                }
                ssq += __shfl_xor(ssq, 16); ssq += __shfl_xor(ssq, 32);
                if (fq == 0) ss_next[(size_t)(row0 + ai * HALF + m * 16) * 16 + u.pn * 4 + wc] = ssq;
            }
            asm volatile("" ::: "memory");
        }
        return true;
    }
};

struct EpiFfnIn {
    static constexpr bool NEEDS_RS = true;
    const float* rowss; bf16_t* H;
    __device__ __forceinline__ bool operator()(Acc& acc, const Unit& u, int wr, int wc, int fr, int fq, const LAS float* rstab) const {
#pragma unroll
        for (int ai = 0; ai < 2; ++ai)
#pragma unroll
            for (int m = 0; m < 4; ++m) {
                const int row = u.pm * BM + ai * HALF + wr * 64 + m * 16 + fr;
                const float rs = rstab[ai * HALF + wr * 64 + m * 16 + fr];
                float v[8];
#pragma unroll
                for (int n = 0; n < 2; ++n)
#pragma unroll
                    for (int e = 0; e < 4; ++e) { const float g = acc[ai][0][m][n][e] * rs, up = acc[ai][1][m][n][e] * rs; v[4 * n + e] = g * sigmoidf_(g) * up; }
                *(u32x4*)(H + (size_t)row * FFN + u.pn * HALF + wc * 32 + 8 * fq) = pack8(v);
                asm volatile("" ::: "memory");
            }
        return true;
    }
};


__host__ __device__ __forceinline__ int lds_byte(int r, int c) { const int st = (r >> 4) * 2 + (c >> 5), rr = r & 15, cc = c & 31, ob = rr * 64 + cc * 2; return st * 1024 + (ob ^ (((ob >> 9) & 1) << 5)); }
__host__ __device__ __forceinline__ void stage_rc(int b, int& R, int& C) { const int st = b / 1024, sb = b % 1024, swz = sb ^ (((sb >> 9) & 1) << 5); R = (st >> 1) * 16 + swz / 64; C = (st & 1) * 32 + (swz % 64) / 2; }
__host__ __device__ __forceinline__ int perm32(int rho) { const int n = rho >> 4, i = rho & 15; return 8 * (i >> 2) + 4 * n + (i & 3); }

struct NoHook { __device__ __forceinline__ void operator()(const Unit&) const {} };
template <class Epi, bool ALIGN_EPI, bool SP2, class Hook>
__device__ __forceinline__ void gemm_phase(LAS unsigned char* lds, const Gemm g, const StaticOrder& S, const Epi& E, Acc& acc, const bool fresh, const Hook& H) {
    const int tid = opaque_tid(), wid = __builtin_amdgcn_readfirstlane(tid >> 6), lane = tid & 63, wr = wid >> 2, wc = wid & 3, fr = lane & 15, fq = lane >> 4;
    const int K = g.K, nt = K / BK;
    unsigned voffA[2], voffB[2];
#pragma unroll
    for (int i = 0; i < 2; ++i) { int R, C; stage_rc(tid * 16 + i * 8192, R, C); const int Rb = (R & ~31) + perm32(R & 31);
        voffA[i] = (unsigned)(R * K + C) * 2u; voffB[i] = (unsigned)(Rb * K + C) * 2u; }
    const size_t kstep = (size_t)(BK * 2);
    const size_t hstep = (size_t)HALF * K * 2;
    const size_t tstep = 2 * hstep;
    const unsigned ldsw = (unsigned)wid * 1024u;
    const int aoff = lds_byte(wr * 64 + fr, fq * 8), boff = lds_byte(wc * 32 + fr, fq * 8);
#define PG8_SA(b, h) (((b) * 2 + (h)) * HTB)
#define PG8_SB(b, h) ((4 + (b) * 2 + (h)) * HTB)
#define PG8_STAGE(bufoff, gbase, voff) do { _Pragma("unroll") for (int _i = 0; _i < 2; ++_i) \
        __builtin_amdgcn_global_load_lds((const unsigned*)((const char*)(gbase) + (voff)[_i]), (LAS unsigned*)(lds + (bufoff) + ldsw + _i * 8192), 16, 0, 0); } while (0)
#define PG8_LDA(dst, b, h) do { _Pragma("unroll") for (int m = 0; m < 4; ++m) _Pragma("unroll") for (int k = 0; k < 2; ++k) dst[m][k] = *(const LAS bf16x8*)(lds + PG8_SA(b, h) + aoff + m * 2048 + k * 1024); } while (0)
#define PG8_LDB(dst, b, h) do { _Pragma("unroll") for (int n = 0; n < 2; ++n) _Pragma("unroll") for (int k = 0; k < 2; ++k) dst[n][k] = *(const LAS bf16x8*)(lds + PG8_SB(b, h) + boff + n * 2048 + k * 1024); } while (0)
#define PG8_MMA(ai, bj, At, Bt) do { __builtin_amdgcn_s_setprio(1); _Pragma("unroll") for (int m = 0; m < 4; ++m) _Pragma("unroll") for (int n = 0; n < 2; ++n) _Pragma("unroll") for (int k = 0; k < 2; ++k) \
        acc[ai][bj][m][n] = __builtin_amdgcn_mfma_f32_16x16x32_bf16(Bt[n][k], At[m][k], acc[ai][bj][m][n], 0, 0, 0); __builtin_amdgcn_s_setprio(0); } while (0)
#define PG8_WAIT_V(n) asm volatile("s_waitcnt vmcnt(" #n ")" ::: "memory")
#define PG8_WAIT_L(n) asm volatile("s_waitcnt lgkmcnt(" #n ")" ::: "memory")
#define PG8_BAR __builtin_amdgcn_s_barrier()
#define PG8_SCHED __builtin_amdgcn_sched_barrier(0)
    Unit cur, nxt; int ui = 0, rs_pm = -1;
    if (!S.next(0, cur)) return;
    if (fresh) {
#pragma unroll
        for (int a = 0; a < 2; ++a)
#pragma unroll
            for (int b = 0; b < 2; ++b)
#pragma unroll
                for (int m = 0; m < 4; ++m)
#pragma unroll
                    for (int n = 0; n < 2; ++n) acc[a][b][m][n] = (f32x4){0.f, 0.f, 0.f, 0.f};
    }
    bf16x8 At[4][2], B0[2][2], B1[2][2];
    const char* cA = (const char*)selA(g, cur.seg) + (size_t)cur.pm * tstep; const char* cB = (const char*)selB(g, cur.seg) + (size_t)cur.pn * tstep;
    if constexpr (SP2) {
        PG8_STAGE(PG8_SB(0, 0), cB, voffB); PG8_STAGE(PG8_SB(0, 1), cB + hstep, voffB); PG8_STAGE(PG8_SA(0, 0), cA, voffA); PG8_STAGE(PG8_SA(0, 1), cA + hstep, voffA);
        if (wr == 1) PG8_BAR;
        PG8_WAIT_V(2); PG8_BAR;
        PG8_STAGE(PG8_SB(1, 0), cB + kstep, voffB); PG8_STAGE(PG8_SA(1, 0), cA + kstep, voffA); PG8_STAGE(PG8_SB(1, 1), cB + hstep + kstep, voffB);
        PG8_WAIT_V(6); PG8_BAR;
    } else {
        PG8_STAGE(PG8_SB(0, 0), cB, voffB); PG8_STAGE(PG8_SA(0, 0), cA, voffA); PG8_STAGE(PG8_SB(0, 1), cB + hstep, voffB); PG8_STAGE(PG8_SA(0, 1), cA + hstep, voffA);
        if (wr == 1) PG8_BAR;
        PG8_WAIT_V(4); PG8_BAR;
        PG8_STAGE(PG8_SB(1, 0), cB + kstep, voffB); PG8_STAGE(PG8_SA(1, 0), cA + kstep, voffA); PG8_STAGE(PG8_SB(1, 1), cB + hstep + kstep, voffB);
        PG8_WAIT_V(6); PG8_BAR;
    }
    for (;;) {
        const bool has_next = S.next(ui + 1, nxt);
        const char* nA = has_next ? (const char*)selA(g, nxt.seg) + (size_t)nxt.pm * tstep : cA; const char* nB = has_next ? (const char*)selB(g, nxt.seg) + (size_t)nxt.pn * tstep : cB;
        for (int t = 0; t < nt; t += 2) {
            const bool last = (t == nt - 2);
            const char* a1 = cA + (size_t)(t + 1) * kstep;
            const char* a2 = last ? nA : cA + (size_t)(t + 2) * kstep; const char* b2 = last ? nB : cB + (size_t)(t + 2) * kstep;
            const char* a3 = a2 + kstep; const char* b3 = b2 + kstep;
            if (last && has_next) H(nxt);
            if constexpr (SP2) {
            PG8_LDB(B0, 0, 0); PG8_LDB(B1, 0, 1); PG8_SCHED; PG8_LDA(At, 0, 0); PG8_STAGE(PG8_SA(1, 1), a1 + hstep, voffA);
            PG8_WAIT_V(8); PG8_WAIT_L(0); PG8_BAR; PG8_MMA(0, 0, At, B0); PG8_MMA(0, 1, At, B1); PG8_BAR; PG8_SCHED;
            PG8_LDA(At, 0, 1); PG8_STAGE(PG8_SB(0, 0), b2, voffB); PG8_STAGE(PG8_SB(0, 1), b2 + hstep, voffB); PG8_STAGE(PG8_SA(0, 0), a2, voffA);
            PG8_WAIT_V(8); PG8_WAIT_L(0); PG8_BAR; PG8_MMA(1, 0, At, B0); PG8_MMA(1, 1, At, B1); PG8_BAR; PG8_SCHED;
            PG8_LDB(B0, 1, 0); PG8_LDB(B1, 1, 1); PG8_SCHED; PG8_LDA(At, 1, 0); PG8_STAGE(PG8_SA(0, 1), a2 + hstep, voffA);
            PG8_WAIT_V(8); PG8_WAIT_L(0); PG8_BAR; PG8_MMA(0, 0, At, B0); PG8_MMA(0, 1, At, B1); PG8_BAR; PG8_SCHED;
            PG8_LDA(At, 1, 1); PG8_STAGE(PG8_SB(1, 0), b3, voffB); PG8_STAGE(PG8_SB(1, 1), b3 + hstep, voffB); PG8_STAGE(PG8_SA(1, 0), a3, voffA);
            PG8_WAIT_V(8); PG8_WAIT_L(0); PG8_BAR; PG8_MMA(1, 0, At, B0); PG8_MMA(1, 1, At, B1); PG8_BAR; PG8_SCHED;
            } else {
            PG8_LDB(B0, 0, 0); PG8_SCHED; PG8_LDA(At, 0, 0); PG8_STAGE(PG8_SA(1, 1), a1 + hstep, voffA);
            PG8_WAIT_L(8); PG8_BAR; PG8_WAIT_L(0); PG8_MMA(0, 0, At, B0); PG8_BAR; PG8_SCHED;
            PG8_LDB(B1, 0, 1); PG8_STAGE(PG8_SB(0, 0), b2, voffB);
            PG8_BAR; PG8_WAIT_L(0); PG8_MMA(0, 1, At, B1); PG8_BAR;
            PG8_LDA(At, 0, 1); PG8_STAGE(PG8_SA(0, 0), a2, voffA);
            PG8_BAR; PG8_WAIT_L(0); PG8_MMA(1, 0, At, B0); PG8_BAR; PG8_SCHED;
            PG8_STAGE(PG8_SB(0, 1), b2 + hstep, voffB);
            PG8_WAIT_V(6); PG8_BAR; PG8_MMA(1, 1, At, B1); PG8_BAR;
            PG8_LDB(B0, 1, 0); PG8_SCHED; PG8_LDA(At, 1, 0); PG8_STAGE(PG8_SA(0, 1), a2 + hstep, voffA);
            PG8_WAIT_L(8); PG8_BAR; PG8_WAIT_L(0); PG8_MMA(0, 0, At, B0); PG8_BAR; PG8_SCHED;
            PG8_LDB(B1, 1, 1); PG8_STAGE(PG8_SB(1, 0), b3, voffB);
            PG8_BAR; PG8_WAIT_L(0); PG8_MMA(0, 1, At, B1); PG8_BAR;
            PG8_LDA(At, 1, 1); PG8_STAGE(PG8_SA(1, 0), a3, voffA);
            PG8_BAR; PG8_WAIT_L(0); PG8_MMA(1, 0, At, B0); PG8_BAR; PG8_SCHED;
            PG8_STAGE(PG8_SB(1, 1), b3 + hstep, voffB);
            PG8_WAIT_V(6); PG8_BAR; PG8_MMA(1, 1, At, B1); PG8_BAR;
            }
        }
        if constexpr (ALIGN_EPI) { if (wr == 0) PG8_BAR; }
        int fr_ = fr, fq_ = fq, tid_ = tid; asm volatile("" : "+v"(fr_), "+v"(fq_), "+v"(tid_));
        const LAS float* rstab = (const LAS float*)(lds + RSTAB_OFF);
        if (Epi::NEEDS_RS && cur.pm != rs_pm) {
            rs_pm = cur.pm;
            const f32x4* p = (const f32x4*)(E.rowss + (size_t)(cur.pm * BM + (tid_ >> 1)) * 16) + (tid_ & 1) * 2; const f32x4 pa = p[0], pb = p[1];
            float t = ((pa[0] + pa[1]) + (pa[2] + pa[3])) + ((pb[0] + pb[1]) + (pb[2] + pb[3]));
            const float t2 = __shfl_xor(t, 1); t = (tid_ & 1) ? (t2 + t) : (t + t2);
            if ((tid_ & 1) == 0) ((LAS float*)(lds + RSTAB_OFF))[tid_ >> 1] = __builtin_amdgcn_rsqf(t * (1.0f / DM) + NORM_EPS);
            PG8_WAIT_L(0); PG8_BAR;
        }
        const bool reset = E(acc, cur, wr, wc, fr_, fq_, rstab);
        if (!has_next) break;
        if (reset) {
#pragma unroll
            for (int a = 0; a < 2; ++a)
#pragma unroll
                for (int b = 0; b < 2; ++b)
#pragma unroll
                    for (int m = 0; m < 4; ++m)
#pragma unroll
                        for (int n = 0; n < 2; ++n) acc[a][b][m][n] = (f32x4){0.f, 0.f, 0.f, 0.f};
        }
        cur = nxt; cA = nA; cB = nB; ++ui;
        if constexpr (ALIGN_EPI) { if (wr == 1) PG8_BAR; }
    }
    PG8_WAIT_V(0);
    if constexpr (!ALIGN_EPI) { if (wr == 0) PG8_BAR; }
    PG8_BAR;
#undef PG8_SA
#undef PG8_SB
#undef PG8_STAGE
#undef PG8_LDA
#undef PG8_LDB
#undef PG8_MMA
#undef PG8_WAIT_V
#undef PG8_WAIT_L
#undef PG8_BAR
#undef PG8_SCHED
}
}


#define XB_TMO      128
#define XB_XCNT(j)  (256  + 64 * (j))
#define XB_XSUB(j)  (1280 + 64 * (j))
#define XB_XGEN(j)  (2304 + 64 * (j))
#define XB_TOP      3328
#define XB_TOPGEN   3392
#define XCD_BAR_WORDS 3456
#define XB_SPIN_CAP (1u << 18)
__device__ __forceinline__ unsigned xb_ld(unsigned* p)              { return __hip_atomic_load(p, __ATOMIC_RELAXED, __HIP_MEMORY_SCOPE_AGENT); }
__device__ __forceinline__ unsigned xb_add(unsigned* p, unsigned v) { return __hip_atomic_fetch_add(p, v, __ATOMIC_RELAXED, __HIP_MEMORY_SCOPE_AGENT); }
__device__ __forceinline__ unsigned xb_xcc_id() { return (unsigned)__builtin_amdgcn_s_getreg((3 << 11) | 20) & 0xFu; }
#define XB_SPIN(cond, bar) do { unsigned _sp = 0; while (cond) { __builtin_amdgcn_s_sleep(1); \
    if ((++_sp & 255u) == 0u) { if (xb_ld(&(bar)[XB_TMO])) break; if (_sp > XB_SPIN_CAP) { atomicAdd(&(bar)[XB_TMO], 1u); break; } } } } while (0)
struct XcdBarrier { unsigned* bar; unsigned x; volatile LAS unsigned* st; };
__device__ __forceinline__ XcdBarrier xcd_barrier_post(unsigned* bar, volatile LAS unsigned* st) {
    XcdBarrier b; b.bar = bar; b.x = xb_xcc_id(); b.st = st;
    if (threadIdx.x == 0) (void)xb_add(&bar[XB_XCNT(b.x)], 1u);
    return b;
}
__device__ __forceinline__ void xcd_barrier_complete(unsigned* bar, unsigned x, unsigned& nloc, unsigned& nx) {
    const unsigned G = gridDim.x * gridDim.y * gridDim.z;
    unsigned sum, cnt, mine, sp = 0u;
    for (;;) {
        sum = 0u; cnt = 0u; mine = 0u;
#pragma unroll
        for (unsigned j = 0; j < 16; ++j) { const unsigned c = xb_ld(&bar[XB_XCNT(j)]); sum += c; cnt += (c > 0u) ? 1u : 0u; mine = (j == x) ? c : mine; }
        if (sum == G) break;
        __builtin_amdgcn_s_sleep(1);
        if ((++sp & 255u) == 0u) { if (xb_ld(&bar[XB_TMO])) break; if (sp > XB_SPIN_CAP) { atomicAdd(&bar[XB_TMO], 1u); break; } }
    }
    nloc = mine > 0u ? mine : 1u; nx = cnt > 0u ? cnt : 1u;
}
__device__ __forceinline__ void xcd_barrier(const XcdBarrier& b) {
    asm volatile("s_waitcnt vmcnt(0)" ::: "memory");
    __syncthreads();
    if (threadIdx.x == 0) {
        unsigned* bar = b.bar;
        __builtin_amdgcn_s_waitcnt(0);
        unsigned nloc = b.st[0], nx = b.st[1];
        if (nloc == 0u) { xcd_barrier_complete(bar, b.x, nloc, nx); b.st[0] = nloc; b.st[1] = nx; }
        const unsigned old = xb_add(&bar[XB_XSUB(b.x)], 1u);
        const unsigned gen = old / nloc;
        if (old + 1u == (gen + 1u) * nloc) {
            __builtin_amdgcn_fence(__ATOMIC_RELEASE, "agent");
            asm volatile("s_waitcnt vmcnt(0)" ::: "memory");
            const unsigned og = xb_add(&bar[XB_TOP], 1u);
            const unsigned tg = og / nx;
            if (og + 1u == (tg + 1u) * nx) xb_add(&bar[XB_TOPGEN], 1u);
            else XB_SPIN(xb_ld(&bar[XB_TOPGEN]) == tg, bar);
            __builtin_amdgcn_fence(__ATOMIC_ACQUIRE, "agent");
            xb_add(&bar[XB_XGEN(b.x)], 1u);
            asm volatile("s_waitcnt vmcnt(0)" ::: "memory");
        } else {
            XB_SPIN(xb_ld(&bar[XB_XGEN(b.x)]) == gen, bar);
            __builtin_amdgcn_fence(__ATOMIC_ACQUIRE, "agent");
            asm volatile("s_waitcnt vmcnt(0)" ::: "memory");
        }
    }
    __syncthreads();
}

struct BarrierHook { const XcdBarrier* b; int at_seg; __device__ __forceinline__ void operator()(const pg8::Unit& nxt) const { if (nxt.seg == at_seg) xcd_barrier(*b); } };

struct Args { const float* in[23]; float* out; unsigned char* ws; int ph_lo, ph_hi, li, pad; };
enum { I_X = 0, I_NMIX, I_WIN, I_BGATE, I_SINK, I_WAO, I_CONVW, I_WCO, I_ARE, I_AIM, I_BRE, I_BIM, I_CRE, I_CIM, I_SD, I_LOGDT, I_WGLU, I_WSO, I_WMIX, I_NFFN, I_WFI, I_WFO, I_NFIN };
constexpr int PH_PER_LAYER = 7, PH_L0 = 2, PH_FINAL = PH_L0 + DEPTH * PH_PER_LAYER, N_PHASES = PH_FINAL + 1;
constexpr int N_WITEMS = 8576;

struct Frame {
    LAS unsigned char* lds;
    int tid, lane, wave, G;
    unsigned char* ws;
};

__device__ __forceinline__ void transpose_item(const float* W, int K, int N, bf16_t* WT, int kb, int nb, int drow0, const float* kscale, LAS float* scr, int lane) {
    const int k0 = 64 * kb, n0 = 32 * nb, c = lane & 7;
    f32x4 s0 = {1.f, 1.f, 1.f, 1.f}, s1 = {1.f, 1.f, 1.f, 1.f};
    if (kscale) { s0 = *(const f32x4*)(kscale + k0 + 8 * c); s1 = *(const f32x4*)(kscale + k0 + 8 * c + 4); }
    const float* src = W + (size_t)(k0 + (lane >> 5)) * N + n0 + (lane & 31);
    float w[32];
#pragma unroll
    for (int i = 0; i < 32; ++i) w[i] = src[(size_t)(2 * i) * N];
#pragma unroll
    for (int i = 0; i < 32; ++i) scr[(2 * i + (lane >> 5)) * 33 + (lane & 31)] = w[i];
    asm volatile("s_waitcnt lgkmcnt(0)" ::: "memory");
#pragma unroll
    for (int j = 0; j < 4; ++j) { const int n = (lane >> 3) + 8 * j; const LAS float* s = scr + (8 * c) * 33 + n;
        u32x4 o; o.x = pk2(s[0 * 33] * s0[0], s[1 * 33] * s0[1]); o.y = pk2(s[2 * 33] * s0[2], s[3 * 33] * s0[3]); o.z = pk2(s[4 * 33] * s1[0], s[5 * 33] * s1[1]); o.w = pk2(s[6 * 33] * s1[2], s[7 * 33] * s1[3]);
        *(u32x4*)(WT + (size_t)(drow0 + n) * K + k0 + 8 * c) = o; }
    asm volatile("s_waitcnt lgkmcnt(0)" ::: "memory");
}

__device__ __forceinline__ void prep_global(Frame& F, const Args& a) {
    F.tid = opaque_tid(); F.lane = F.tid & 63;
    float* rc = (float*)(F.ws + WS_ROPE); float* rsn = rc + SEQ * 8;
    const int gt = blockIdx.x * NTHREADS + F.tid, NT = F.G * NTHREADS;
    for (int i = gt; i < SEQ * 8; i += NT) {
        const int pos = i >> 3, j = i & 7;
        const float invf = (float)exp(-(double)(2 * j) / 16.0 * log(500000.0));
        const float ang = (float)pos * invf;
        double s, c; sincos((double)ang, &s, &c);
        rc[i] = (float)c; rsn[i] = (float)s;
    }
    for (int i = gt; i < DEPTH * 32 * 64; i += NT) {
        const int l = i >> 11, gp = i & 2047, g = gp >> 6;
        const double dt = exp((double)a.in[I_LOGDT][l * 32 + g]);
        const double ar = (double)a.in[I_ARE][i], aim = (double)a.in[I_AIM][i];
        const double er = exp(ar * dt); double sn, cs; sincos(aim * dt, &sn, &cs);
        const double lr = er * cs, li = er * sn;
        const double nr = lr - 1.0, ni = li, den = ar * ar + aim * aim;
        const double cr = (nr * ar + ni * aim) / den, ci = (ni * ar - nr * aim) / den;
        float* lam = (float*)(F.ws + WS_SSM + (size_t)l * SO_LAYER + SO_LAM); float* bb = (float*)(F.ws + WS_SSM + (size_t)l * SO_LAYER + SO_BBAR);
        lam[gp * 2] = (float)lr; lam[gp * 2 + 1] = (float)li;
        float* pw = (float*)(F.ws + WS_SSM + (size_t)l * SO_LAYER + SO_POW) + (size_t)gp * 34;
        for (int k = 0; k <= 16; ++k) { const double mg = exp(ar * dt * k); double s2, c2; sincos(aim * dt * k, &s2, &c2); pw[2 * k] = (float)(mg * c2); pw[2 * k + 1] = (float)(mg * s2); }
        const float* bre = a.in[I_BRE] + (size_t)i * 16; const float* bim = a.in[I_BIM] + (size_t)i * 16;
        for (int h = 0; h < 16; ++h) { const double br = bre[h], bi = bim[h]; bb[(gp * 16 + h) * 2] = (float)(cr * br - ci * bi); bb[(gp * 16 + h) * 2 + 1] = (float)(cr * bi + ci * br); }
    }
    const int gw = blockIdx.x * NWAVES + F.wave, NGW = F.G * NWAVES;
    const float* x = a.in[I_X]; bf16_t* xb = (bf16_t*)(F.ws + WS_XBF); float* ss = (float*)(F.ws + WS_ROWSS);
    for (int r = gw; r < MTOK; r += NGW) {
        const f32x4* xr = (const f32x4*)(x + (size_t)r * DM) + F.lane;
        u32x2* ob = (u32x2*)(xb + (size_t)r * DM) + F.lane;
        float s = 0.f;
#pragma unroll
        for (int j = 0; j < 4; ++j) { const f32x4 v = xr[64 * j]; s += v[0] * v[0] + v[1] * v[1] + v[2] * v[2] + v[3] * v[3]; u32x2 w; w.x = pk2(v[0], v[1]); w.y = pk2(v[2], v[3]); ob[64 * j] = w; }
        s = wave_sum(s);
        if (F.lane < 16) ss[(size_t)r * 16 + F.lane] = (F.lane == 0) ? s : 0.f;
    }
}

__device__ __forceinline__ void prep_weights(Frame& F, const Args& a, int l, int it_lo, int it_hi, int gw, int ngw) {
    F.tid = opaque_tid(); F.lane = F.tid & 63;
    bf16_t* W = (bf16_t*)(F.ws + WS_W + (size_t)(l & 1) * W_BUF);
    LAS float* scr = (LAS float*)(F.lds + F.wave * 16384);
    const float* w_in = a.in[I_WIN] + (size_t)l * DM * INCOLS; const float* w_ao = a.in[I_WAO] + (size_t)l * 512 * DM; const float* w_co = a.in[I_WCO] + (size_t)l * 512 * DM;
    const float* w_gl = a.in[I_WGLU] + (size_t)l * 512 * 512; const float* w_so = a.in[I_WSO] + (size_t)l * 512 * DM; const float* w_mx = a.in[I_WMIX] + (size_t)l * DM * DM;
    const float* w_fi = a.in[I_WFI] + (size_t)l * DM * FFN2; const float* w_fo = a.in[I_WFO] + (size_t)l * FFN * DM;
    const float* nmix = a.in[I_NMIX] + l * DM; const float* nffn = a.in[I_NFFN] + l * DM;
    constexpr int I0 = 16 * 184, I1 = 8 * 32, I2 = 8 * 32, I3 = 8 * 16, I4 = 8 * 32, I5 = 16 * 32, I6 = 16 * 176, I7 = 44 * 32;
    static_assert(I0 + I1 + I2 + I3 + I4 + I5 + I6 + I7 == N_WITEMS, "weight items");
    for (int it = it_lo + gw; it < it_hi; it += ngw) {
        int r = it;
        if (r < I0) { const int kb = r / 184, nb = r % 184; transpose_item(w_in, DM, INCOLS, W + WO_IN, kb, nb, 32 * nb, nmix, scr, F.lane); continue; } r -= I0;
        if (r < I1) { const int kb = r / 32, nb = r % 32; transpose_item(w_ao, 512, DM, W + WO_AO, kb, nb, 32 * nb, nullptr, scr, F.lane); continue; } r -= I1;
        if (r < I2) { const int kb = r / 32, nb = r % 32; transpose_item(w_co, 512, DM, W + WO_CO, kb, nb, 32 * nb, nullptr, scr, F.lane); continue; } r -= I2;
        if (r < I3) { const int kb = r / 16, nb = r % 16; transpose_item(w_gl, 512, 512, W + WO_GLU, kb, nb, 32 * nb, nullptr, scr, F.lane); continue; } r -= I3;
        if (r < I4) { const int kb = r / 32, nb = r % 32; transpose_item(w_so, 512, DM, W + WO_SO, kb, nb, 32 * nb, nullptr, scr, F.lane); continue; } r -= I4;
        if (r < I5) { const int kb = r / 32, nb = r % 32; transpose_item(w_mx, DM, DM, W + WO_MIX, kb, nb, 32 * nb, nullptr, scr, F.lane); continue; } r -= I5;
        if (r < I6) { const int kb = r / 176, nb = r % 176; const int n0 = 32 * nb; const int j0 = n0 < FFN ? n0 : n0 - FFN; const int drow0 = 256 * (j0 / 128) + (n0 < FFN ? 0 : 128) + (j0 % 128);
            transpose_item(w_fi, DM, FFN2, W + WO_FI, kb, nb, drow0, nffn, scr, F.lane); continue; } r -= I6;
        { const int kb = r / 32, nb = r % 32; transpose_item(w_fo, FFN, DM, W + WO_FO, kb, nb, 32 * nb, nullptr, scr, F.lane); }
    }
}

__device__ __forceinline__ void prep_ssm(Frame& F, const Args& a, int l, int item_lo, int item_step) {
    F.tid = opaque_tid(); F.lane = F.tid & 63;
    __syncthreads();
    {
        LAS float* pw = (LAS float*)(F.lds);
        LAS float* cC = pw + 64 * 34;
        LAS float* bB = cC + 16 * 64 * 2;
        LAS float* kd = bB + 64 * 16 * 2;
        unsigned char* smm = F.ws + WS_SSMM + (size_t)(l & 1) * SSMM_BUF;
        bf16_t* WY = (bf16_t*)(smm + SM_WY); bf16_t* GT = (bf16_t*)(smm + SM_GT); float* L16 = (float*)(smm + SM_L16);
        const int tid = F.tid;
        for (int item = item_lo; item < 256; item += item_step) {
            const int g = item >> 3, part = item & 7;
            const float* gpw = (const float*)(F.ws + WS_SSM + (size_t)l * SO_LAYER + SO_POW) + (size_t)g * 64 * 34;
            const float* gbb = (const float*)(F.ws + WS_SSM + (size_t)l * SO_LAYER + SO_BBAR) + (size_t)g * 64 * 32;
            const float* gcr = a.in[I_CRE] + (size_t)(l * 32 + g) * 1024; const float* gci = a.in[I_CIM] + (size_t)(l * 32 + g) * 1024;
            for (int i = tid; i < 64 * 34; i += NTHREADS) pw[i] = gpw[i];
            for (int i = tid; i < 2048; i += NTHREADS) bB[i] = gbb[i];
            for (int i = tid; i < 1024; i += NTHREADS) { cC[2 * i] = gcr[i]; cC[2 * i + 1] = gci[i]; }
            __syncthreads();
            {
                const int dd = tid >> 8, h = (tid >> 4) & 15, h2 = tid & 15, d = 2 * part + dd;
                float a0 = 0.f, a1 = 0.f, a2 = 0.f, a3 = 0.f;
#pragma unroll 4
                for (int p = 0; p < 64; p += 4) {
#pragma unroll
                    for (int u = 0; u < 4; ++u) {
                        const f32x2 c = *(const LAS f32x2*)(cC + (h * 64 + p + u) * 2), w = *(const LAS f32x2*)(pw + (p + u) * 34 + 2 * d), bv = *(const LAS f32x2*)(bB + ((p + u) * 16 + h2) * 2);
                        const float tr = c[0] * w[0] - c[1] * w[1], ti = c[0] * w[1] + c[1] * w[0];
                        const float t = tr * bv[0] - ti * bv[1];
                        if (u == 0) a0 += t; else if (u == 1) a1 += t; else if (u == 2) a2 += t; else a3 += t;
                    }
                }
                float acc = (a0 + a1) + (a2 + a3);
                if (d == 0 && h == h2) acc += a.in[I_SD][l * 512 + g * 16 + h];
                kd[tid] = acc;
            }
            __syncthreads();
            for (int dd = 0; dd < 2; ++dd) {
                const int d = 2 * part + dd, nblk = 16 - d;
                for (int it = tid; it < nblk * 32; it += NTHREADS) {
                    const int bi = it >> 5, r = (it >> 1) & 15, hc = it & 1, tau = d + bi, sI = bi;
                    float v[8];
#pragma unroll
                    for (int j = 0; j < 8; ++j) v[j] = kd[(dd * 16 + r) * 16 + hc * 8 + j];
                    *(u32x4*)(WY + ((size_t)g * 256 + tau * 16 + r) * 384 + sI * 16 + hc * 8) = pack8(v);
                }
            }
            if (tid < 32) { const int r = tid >> 1, hc = tid & 1; unsigned zz = 0u; asm volatile("" : "+v"(zz)); u32x4 z; z.x = zz; z.y = zz; z.z = zz; z.w = zz;
                *(u32x4*)(WY + ((size_t)g * 256 + (2 * part) * 16 + r) * 384 + (2 * part + 1) * 16 + hc * 8) = z; }
            {
                const int r = tid >> 4, kc = tid & 15, n = part * 32 + r, tau = n >> 4, h = n & 15, q = kc * 8; const bool im = q >= 64; const int p0 = im ? q - 64 : q;
                float v[8];
#pragma unroll
                for (int j = 0; j < 8; ++j) { const int p = p0 + j; const float cr = cC[(h * 64 + p) * 2], ci = cC[(h * 64 + p) * 2 + 1], pr = pw[p * 34 + 2 * (tau + 1)], pi = pw[p * 34 + 2 * (tau + 1) + 1];
                    v[j] = im ? -(cr * pi + ci * pr) : (cr * pr - ci * pi); }
                *(u32x4*)(WY + ((size_t)g * 256 + n) * 384 + 256 + q) = pack8(v);
            }
            {
                const int r = tid >> 5, kc = tid & 31, k0 = kc * 8, n = part * 16 + r, sI = k0 >> 4, h0 = k0 & 15, p = n & 63; const bool im = n >= 64;
                const float pr = pw[p * 34 + 2 * (15 - sI)], pi = pw[p * 34 + 2 * (15 - sI) + 1];
                float v[8];
#pragma unroll
                for (int j = 0; j < 8; ++j) { const float br = bB[(p * 16 + h0 + j) * 2], bi = bB[(p * 16 + h0 + j) * 2 + 1]; v[j] = im ? (pr * bi + pi * br) : (pr * br - pi * bi); }
                *(u32x4*)(GT + ((size_t)g * 128 + n) * 256 + k0) = pack8(v);
            }
            if (part == 0 && tid < 64) { L16[(g * 64 + tid) * 2] = pw[tid * 34 + 32]; L16[(g * 64 + tid) * 2 + 1] = pw[tid * 34 + 33]; }
            __syncthreads();
        }
    }
}


typedef float f32x16 __attribute__((ext_vector_type(16)));
constexpr int UX_PITCH = 784, SSM_S_OFF = 64 * UX_PITCH;

constexpr int AT_KPITCH = 144, AT_VPITCH = 520, AT_VT_OFF = 256 * AT_KPITCH;

constexpr int CONVW_OFF = RING_BYTES + 8192;
__device__ __forceinline__ void conv_item(const bf16_t* CB, const bf16_t* CC, const bf16_t* CX, bf16_t* CA, const LAS float* cw, int it) {
    const int row = it >> 6, c0 = (it & 63) * 8, t = row & (SEQ - 1);
    const size_t o = (size_t)row * 512 + c0;
    const size_t o1 = (t >= 1) ? o - 512 : o, o2 = (t >= 2) ? o - 1024 : o;
    const u32x4 vb = *(const u32x4*)(CB + o), vc0 = *(const u32x4*)(CC + o), vx0 = *(const u32x4*)(CX + o);
    const u32x4 vc1 = *(const u32x4*)(CC + o1), vx1 = *(const u32x4*)(CX + o1), vc2 = *(const u32x4*)(CC + o2), vx2 = *(const u32x4*)(CX + o2);
    float cb[8], a0[8], b0[8], a1[8], b1[8], a2[8], b2[8];
    unpack8(vb, cb); unpack8(vc0, a0); unpack8(vx0, b0); unpack8(vc1, a1); unpack8(vx1, b1); unpack8(vc2, a2); unpack8(vx2, b2);
    const float m1 = (t >= 1) ? 1.f : 0.f, m2 = (t >= 2) ? 1.f : 0.f;
    float v[8];
#pragma unroll
    for (int e = 0; e < 8; ++e) v[e] = cb[e] * (cw[c0 + e] * (a2[e] * b2[e] * m2) + cw[512 + c0 + e] * (a1[e] * b1[e] * m1) + cw[1024 + c0 + e] * (a0[e] * b0[e]));
    *(u32x4*)(CA + o) = pack8(v);
}

__device__ __forceinline__ void conv_batch4(const bf16_t* CB, const bf16_t* CC, const bf16_t* CX, bf16_t* CA, const LAS float* cw, int it0, int stride, int it_end) {
    u32x4 vb[4], vc[4][3], vx[4][3];
#pragma unroll
    for (int k = 0; k < 4; ++k) {
        const int it = min(it0 + k * stride, it_end - 1);
        const int row = it >> 6, c0 = (it & 63) * 8, t = row & (SEQ - 1);
        const size_t o = (size_t)row * 512 + c0, o1 = (t >= 1) ? o - 512 : o, o2 = (t >= 2) ? o - 1024 : o;
        vb[k] = *(const u32x4*)(CB + o);
        vc[k][0] = *(const u32x4*)(CC + o); vx[k][0] = *(const u32x4*)(CX + o);
        vc[k][1] = *(const u32x4*)(CC + o1); vx[k][1] = *(const u32x4*)(CX + o1);
        vc[k][2] = *(const u32x4*)(CC + o2); vx[k][2] = *(const u32x4*)(CX + o2);
    }
#pragma unroll
    for (int k = 0; k < 4; ++k) {
        const int it = it0 + k * stride;
        if (it < it_end) {
            const int row = it >> 6, c0 = (it & 63) * 8, t = row & (SEQ - 1);
            float cb[8], a0[8], b0[8], a1[8], b1[8], a2[8], b2[8];
            unpack8(vb[k], cb); unpack8(vc[k][0], a0); unpack8(vx[k][0], b0); unpack8(vc[k][1], a1); unpack8(vx[k][1], b1); unpack8(vc[k][2], a2); unpack8(vx[k][2], b2);
            const float m1 = (t >= 1) ? 1.f : 0.f, m2 = (t >= 2) ? 1.f : 0.f;
            float v[8];
#pragma unroll
            for (int e = 0; e < 8; ++e) v[e] = cb[e] * (cw[c0 + e] * (a2[e] * b2[e] * m2) + cw[512 + c0 + e] * (a1[e] * b1[e] * m1) + cw[1024 + c0 + e] * (a0[e] * b0[e]));
            *(u32x4*)(CA + (size_t)row * 512 + c0) = pack8(v);
        }
    }
}

__device__ __forceinline__ void mixers_phase(Frame& F, const Args& a, int l) {
    F.tid = opaque_tid(); F.lane = F.tid & 63;
    const int tid = F.tid, lane = F.lane, wave = F.wave, l31 = lane & 31, hi = lane >> 5;
    const bf16_t* Q = (const bf16_t*)(F.ws + WS_R1); const bf16_t* Kb = Q + (size_t)MTOK * 512; const bf16_t* Vb = Kb + (size_t)MTOK * 128;
    const bf16_t* CB = (const bf16_t*)(F.ws + WS_R1 + 24 * MiB); const bf16_t* CC = CB + (size_t)MTOK * 512; const bf16_t* CX = CC + (size_t)MTOK * 512;
    const bf16_t* U = (const bf16_t*)(F.ws + WS_R1 + 72 * MiB);
    bf16_t* AO = (bf16_t*)(F.ws + WS_R3); bf16_t* YS = (bf16_t*)(F.ws + WS_R3 + 16 * MiB); bf16_t* CA = (bf16_t*)(F.ws + WS_R3 + 32 * MiB);
    const unsigned char* smm = F.ws + WS_SSMM + (size_t)(l & 1) * SSMM_BUF;
    const bf16_t* WY = (const bf16_t*)(smm + SM_WY); const bf16_t* GT = (const bf16_t*)(smm + SM_GT); const float* L16 = (const float*)(smm + SM_L16);
    LAS unsigned char* kl = F.lds; LAS unsigned char* vt = F.lds + AT_VT_OFF;
    LAS unsigned char* ux = F.lds; LAS float* S = (LAS float*)(F.lds + SSM_S_OFF);
    LAS float* cw = (LAS float*)(F.lds + CONVW_OFF);
    for (int i = tid; i < 1536; i += NTHREADS) cw[i] = a.in[I_CONVW][l * 1536 + i];
    const int conv_per_blk = (MTOK * 64 + F.G - 1) / F.G;
    const int conv_lo = blockIdx.x * conv_per_blk, conv_end = min(conv_lo + conv_per_blk, MTOK * 64), conv_mid = min(conv_lo + ((conv_per_blk / 2 + 4 * NTHREADS - 1) / (4 * NTHREADS)) * (4 * NTHREADS), conv_end);
    bool conv_a_done = false, conv_b_done = false;
    __syncthreads();
    for (int unit = blockIdx.x; unit < BATCH * 32; unit += F.G) {
        {
            const int b = unit >> 5, n = (unit >> 1) & 15, kvh = unit & 1;
            const int rowq0 = b * SEQ + n * 128, rowk0 = rowq0 - 128;
            const int hq = kvh * 4 + (wave >> 1);
            u32x4 kv[4], vv[4];
#pragma unroll
            for (int i = 0; i < 4; ++i) {
                const int v = tid + i * NTHREADS, key = v >> 3, dc = v & 7;
                const int rk = (n == 0 && key < 128) ? rowq0 : rowk0 + key;
                kv[i] = *(const u32x4*)(Kb + (size_t)rk * 128 + kvh * 64 + dc * 8);
                vv[i] = *(const u32x4*)(Vb + (size_t)rk * 128 + kvh * 64 + dc * 8);
            }
            bf16x8 qf[2][4];
#pragma unroll
            for (int sb = 0; sb < 2; ++sb)
#pragma unroll
                for (int ks = 0; ks < 4; ++ks) qf[sb][ks] = *(const bf16x8*)(Q + (size_t)(rowq0 + (wave & 1) * 64 + sb * 32 + l31) * 512 + hq * 64 + ks * 16 + hi * 8);
            const float sl = a.in[I_SINK][l * 8 + hq] * LOG2E;
#pragma unroll
            for (int i = 0; i < 4; ++i) {
                const int v = tid + i * NTHREADS, key = v >> 3, dc = v & 7;
                *(LAS u32x4*)(kl + key * AT_KPITCH + dc * 16) = kv[i];
                LAS bf16_t* vp = (LAS bf16_t*)(vt + (dc * 8) * AT_VPITCH + key * 2);
                vp[0 * (AT_VPITCH / 2)] = (bf16_t)(vv[i].x & 0xffffu); vp[1 * (AT_VPITCH / 2)] = (bf16_t)(vv[i].x >> 16);
                vp[2 * (AT_VPITCH / 2)] = (bf16_t)(vv[i].y & 0xffffu); vp[3 * (AT_VPITCH / 2)] = (bf16_t)(vv[i].y >> 16);
                vp[4 * (AT_VPITCH / 2)] = (bf16_t)(vv[i].z & 0xffffu); vp[5 * (AT_VPITCH / 2)] = (bf16_t)(vv[i].z >> 16);
                vp[6 * (AT_VPITCH / 2)] = (bf16_t)(vv[i].w & 0xffffu); vp[7 * (AT_VPITCH / 2)] = (bf16_t)(vv[i].w >> 16);
            }
            __syncthreads();
#pragma unroll
            for (int sb = 0; sb < 2; ++sb) {
                const int q0 = (wave & 1) * 64 + sb * 32;
                const size_t qrow = (size_t)(rowq0 + q0 + l31);
                f32x16 sc[5];
#pragma unroll
                for (int kt = 0; kt < 5; ++kt) {
                    f32x16 acc = {};
                    const LAS unsigned char* kp = kl + (q0 + 32 * kt + l31) * AT_KPITCH + hi * 16;
#pragma unroll
                    for (int ks = 0; ks < 4; ++ks) acc = __builtin_amdgcn_mfma_f32_32x32x16_bf16(*(const LAS bf16x8*)(kp + ks * 32), qf[sb][ks], acc, 0, 0, 0);
                    sc[kt] = acc;
                }
                float mx = -1e30f;
#pragma unroll
                for (int kt = 0; kt < 5; ++kt)
#pragma unroll
                    for (int r = 0; r < 16; ++r) {
                        const int c = (r & 3) + 8 * (r >> 2) + 4 * hi, diff = 32 * kt + c - l31;
                        const bool ok = (diff >= 1) && (diff <= 128) && (n > 0 || q0 + 32 * kt + c >= 128);
                        const float v = ok ? sc[kt][r] : -1e30f;
                        sc[kt][r] = v; mx = fmaxf(mx, v);
                    }
                mx = fmaxf(mx, __shfl_xor(mx, 32));
                mx = fmaxf(mx, sl);
                float ls = 0.f;
#pragma unroll
                for (int kt = 0; kt < 5; ++kt)
#pragma unroll
                    for (int r = 0; r < 16; ++r) { const float p = __builtin_amdgcn_exp2f(sc[kt][r] - mx); sc[kt][r] = p; ls += p; }
                ls += __shfl_xor(ls, 32);
                ls += __builtin_amdgcn_exp2f(sl - mx);
                f32x16 o0 = {}, o1 = {};
#pragma unroll
                for (int kt = 0; kt < 5; ++kt)
#pragma unroll
                    for (int s2 = 0; s2 < 2; ++s2) {
                        u32x4 pw; pw.x = pk2(sc[kt][8 * s2 + 0], sc[kt][8 * s2 + 1]); pw.y = pk2(sc[kt][8 * s2 + 2], sc[kt][8 * s2 + 3]); pw.z = pk2(sc[kt][8 * s2 + 4], sc[kt][8 * s2 + 5]); pw.w = pk2(sc[kt][8 * s2 + 6], sc[kt][8 * s2 + 7]);
                        const bf16x8 pf = __builtin_bit_cast(bf16x8, pw);
                        const int col = q0 + 32 * kt + 16 * s2 + 4 * hi;
                        const LAS unsigned char* vp0 = vt + l31 * AT_VPITCH + col * 2;
                        const LAS unsigned char* vp1 = vp0 + 32 * AT_VPITCH;
                        const u32x2 a0 = *(const LAS u32x2*)(vp0), a1 = *(const LAS u32x2*)(vp0 + 16);
                        const u32x2 c0 = *(const LAS u32x2*)(vp1), c1 = *(const LAS u32x2*)(vp1 + 16);
                        u32x4 va; va.x = a0.x; va.y = a0.y; va.z = a1.x; va.w = a1.y;
                        u32x4 vc; vc.x = c0.x; vc.y = c0.y; vc.z = c1.x; vc.w = c1.y;
                        o0 = __builtin_amdgcn_mfma_f32_32x32x16_bf16(__builtin_bit_cast(bf16x8, va), pf, o0, 0, 0, 0);
                        o1 = __builtin_amdgcn_mfma_f32_32x32x16_bf16(__builtin_bit_cast(bf16x8, vc), pf, o1, 0, 0, 0);
                    }
                const float inv = __builtin_amdgcn_rcpf(ls);
                bf16_t* op = AO + qrow * 512 + hq * 64 + 4 * hi;
#pragma unroll
                for (int qd = 0; qd < 4; ++qd) {
                    u32x2 w0; w0.x = pk2(o0[4 * qd] * inv, o0[4 * qd + 1] * inv); w0.y = pk2(o0[4 * qd + 2] * inv, o0[4 * qd + 3] * inv);
                    u32x2 w1; w1.x = pk2(o1[4 * qd] * inv, o1[4 * qd + 1] * inv); w1.y = pk2(o1[4 * qd + 2] * inv, o1[4 * qd + 3] * inv);
                    *(u32x2*)(op + 8 * qd) = w0; *(u32x2*)(op + 32 + 8 * qd) = w1;
                }
            }
        }
        {
            const int x = unit & 7, j = unit >> 3, g = 4 * x + (j >> 3), b = j & 7;
            const bf16_t* ug = U + (size_t)(b * 32 + g) * SEQ * 16;
            const bf16_t* wy = WY + (size_t)g * 256 * 384; const bf16_t* gt = GT + (size_t)g * 128 * 256;
            u32x4 ur[4];
#pragma unroll
            for (int i = 0; i < 4; ++i) ur[i] = ((const u32x4*)ug)[tid + i * NTHREADS];
            const int rb = wave >> 2, cb = wave & 3;
            float xr = 0.f, xi = 0.f, lr = 0.f, li = 0.f;
            if (wave == 0) { lr = L16[(g * 64 + lane) * 2]; li = L16[(g * 64 + lane) * 2 + 1]; }
            if (!conv_b_done) { conv_a_done = true; conv_b_done = true; for (int it0 = conv_lo + tid; it0 < conv_end; it0 += 4 * NTHREADS) conv_batch4(CB, CC, CX, CA, cw, it0, NTHREADS, conv_end); }
            __syncthreads();
#pragma unroll 1
            for (int half = 0; half < 2; ++half) {
                bf16x8 gfr[16];
                { const bf16_t* bp = gt + (size_t)(cb * 32 + l31) * 256 + hi * 8;
#pragma unroll
                  for (int ks = 0; ks < 16; ++ks) gfr[ks] = *(const bf16x8*)(bp + ks * 16); }
#pragma unroll
                for (int i = 0; i < 4; ++i) { const int v = tid + i * NTHREADS, c = v >> 5, kc = v & 31; *(LAS u32x4*)(ux + c * UX_PITCH + kc * 16) = ur[i]; }
                if (half == 0) {
#pragma unroll
                    for (int i = 0; i < 4; ++i) ur[i] = ((const u32x4*)(ug + (size_t)1024 * 16))[tid + i * NTHREADS];
                }
                __syncthreads();
                {
                    f32x16 acc = {};
                    const LAS unsigned char* ap = ux + (rb * 32 + l31) * UX_PITCH + hi * 16;
#pragma unroll
                    for (int ks = 0; ks < 16; ++ks) acc = __builtin_amdgcn_mfma_f32_32x32x16_bf16(*(const LAS bf16x8*)(ap + ks * 32), gfr[ks], acc, 0, 0, 0);
#pragma unroll
                    for (int r = 0; r < 16; ++r) S[(rb * 32 + (r & 3) + 8 * (r >> 2) + 4 * hi) * 128 + cb * 32 + l31] = acc[r];
                }
                bf16x8 afr[24];
                { const bf16_t* ap = wy + (size_t)(wave * 32 + l31) * 384 + hi * 8;
#pragma unroll
                  for (int ks = 0; ks < 24; ++ks) if (ks >= 16 || ks <= 2 * wave + 1) afr[ks] = *(const bf16x8*)(ap + ks * 16); else afr[ks] = (bf16x8){0, 0, 0, 0, 0, 0, 0, 0}; }
                __syncthreads();
                if (wave == 0) {
#pragma unroll 1
                    for (int c0 = 0; c0 < 64; c0 += 8) {
                        float sr[8], si[8];
#pragma unroll
                        for (int q = 0; q < 8; ++q) { sr[q] = S[(c0 + q) * 128 + lane]; si[q] = S[(c0 + q) * 128 + 64 + lane]; }
#pragma unroll
                        for (int q = 0; q < 8; ++q) {
                            *(LAS bf16_t*)(ux + (c0 + q) * UX_PITCH + (256 + lane) * 2) = (bf16_t)f2bf(xr);
                            *(LAS bf16_t*)(ux + (c0 + q) * UX_PITCH + (320 + lane) * 2) = (bf16_t)f2bf(xi);
                            const float nr = lr * xr - li * xi + sr[q], ni = lr * xi + li * xr + si[q];
                            xr = nr; xi = ni;
                        }
                    }
                }
                __syncthreads();
                {
                    f32x16 acc0 = {}, acc1 = {};
                    const LAS unsigned char* bp0 = ux + l31 * UX_PITCH + hi * 16;
                    const LAS unsigned char* bp1 = bp0 + 32 * UX_PITCH;
#pragma unroll
                    for (int ks = 0; ks < 24; ++ks) {
                        if (ks < 16 && ks > 2 * wave + 1) continue;
                        const bf16x8 b0 = *(const LAS bf16x8*)(bp0 + ks * 32);
                        const bf16x8 b1 = *(const LAS bf16x8*)(bp1 + ks * 32);
                        acc0 = __builtin_amdgcn_mfma_f32_32x32x16_bf16(afr[ks], b0, acc0, 0, 0, 0);
                        acc1 = __builtin_amdgcn_mfma_f32_32x32x16_bf16(afr[ks], b1, acc1, 0, 0, 0);
                    }
#pragma unroll
                    for (int cbk = 0; cbk < 2; ++cbk)
#pragma unroll
                        for (int q = 0; q < 4; ++q) {
                            const int tau = 2 * wave + (q >> 1), h0 = 8 * (q & 1) + 4 * hi, chunk = cbk * 32 + l31;
                            const size_t row = (size_t)b * SEQ + half * 1024 + 16 * chunk + tau;
                            float y0, y1, y2, y3;
                            if (cbk == 0) { y0 = acc0[4 * q]; y1 = acc0[4 * q + 1]; y2 = acc0[4 * q + 2]; y3 = acc0[4 * q + 3]; } else { y0 = acc1[4 * q]; y1 = acc1[4 * q + 1]; y2 = acc1[4 * q + 2]; y3 = acc1[4 * q + 3]; }
                            u32x2 w; w.x = pk2(gelu_tanh(y0), gelu_tanh(y1)); w.y = pk2(gelu_tanh(y2), gelu_tanh(y3));
                            *(u32x2*)(YS + row * 512 + g * 16 + h0) = w;
                        }
                }
                __syncthreads();
            }
        }
    }
    if (!conv_a_done) for (int it0 = conv_lo + tid; it0 < conv_mid; it0 += 4 * NTHREADS) conv_batch4(CB, CC, CX, CA, cw, it0, NTHREADS, conv_mid);
    if (!conv_b_done) for (int it0 = conv_mid + tid; it0 < conv_end; it0 += 4 * NTHREADS) conv_batch4(CB, CC, CX, CA, cw, it0, NTHREADS, conv_end);
}

__device__ __forceinline__ void final_norm(Frame& F, const Args& a) {
    F.tid = opaque_tid(); F.lane = F.tid & 63;
    const int gw = blockIdx.x * NWAVES + F.wave, NGW = F.G * NWAVES;
    const float* ss = (const float*)(F.ws + WS_ROWSS); const float* gn = a.in[I_NFIN];
    for (int r = gw; r < MTOK; r += NGW) {
        const float rs = row_rs(ss, r);
        f32x4* xr = (f32x4*)(a.out + (size_t)r * DM) + F.lane; const f32x4* gp = (const f32x4*)gn + F.lane;
#pragma unroll
        for (int j = 0; j < 4; ++j) { f32x4 v = xr[64 * j]; const f32x4 gg = gp[64 * j]; v = v * rs * gg; xr[64 * j] = v; }
    }
}

#ifndef REP_INPROJ
#define REP_INPROJ 1
#endif
#ifndef REP_MIXERS
#define REP_MIXERS 1
#endif
#ifndef REP_FFNIN
#define REP_FFNIN 1
#endif
#ifndef REP_BAR
#define REP_BAR 1
#endif
#ifndef REP_MIXO
#define REP_MIXO 1
#endif
#ifndef REP_FFNOUT
#define REP_FFNOUT 1
#endif
#ifndef REP_MERGE
#define REP_MERGE 1
#endif
#define RUN_GEMM(g, S, E, acc, fresh) pg8::gemm_phase<decltype(E), true, true, pg8::NoHook>(F.lds, g, S, E, acc, fresh, pg8::NoHook{})
__global__ void __launch_bounds__(NTHREADS, 2) fwd_kernel(Args args) {
    extern __shared__ __attribute__((aligned(16))) unsigned char lds[];
    Frame F;
    F.lds = (LAS unsigned char*)lds; F.tid = threadIdx.x; F.lane = F.tid & 63; F.wave = __builtin_amdgcn_readfirstlane(F.tid >> 6); F.G = gridDim.x; F.ws = args.ws;
    const int lo = args.ph_lo, hi = args.ph_hi;
#define IN(k) (lo <= (k) && (k) < hi)
#define SEAM(k) do { if (IN(k) && IN((k) + 1)) { for (int rb_ = 0; rb_ < REP_BAR; ++rb_) xcd_barrier(bar); } } while (0)
#define REPEAT(n) for (int rep_ = 0; rep_ < (n); ++rep_, (rep_ < (n) ? xcd_barrier(bar) : (void)0))
    for (int u = F.tid; u < (LDS_BYTES - RING_BYTES) / 4; u += NTHREADS) ((LAS unsigned*)(F.lds + RING_BYTES))[u] = 0u;
    __syncthreads();
    XcdBarrier bar; bar.bar = (unsigned*)(args.ws + WS_CTL) + 4096; bar.x = 0; bar.st = (volatile LAS unsigned*)(F.lds + MISC_OFF);
    if (hi - lo > 1) bar = xcd_barrier_post((unsigned*)(args.ws + WS_CTL) + 4096, (volatile LAS unsigned*)(F.lds + MISC_OFF));
    unsigned char* ws0 = args.ws;
    const int gwave = blockIdx.x * NWAVES + F.wave, ngwave = F.G * NWAVES;
    if (IN(0)) { prep_global(F, args); prep_weights(F, args, 0, 0, N_WITEMS, gwave, ngwave); }
    SEAM(0);

#pragma unroll 1
    for (int l = 0; l < DEPTH; ++l) {
        const int pb = PH_L0 + l * PH_PER_LAYER;
        unsigned char* ws = ws0; asm volatile("" : "+s"(ws));
        bf16_t* W = (bf16_t*)(ws + WS_W + (size_t)(l & 1) * W_BUF);
        bf16_t* XB = (bf16_t*)(ws + WS_XBF);
        float* ROWSS = (float*)(ws + WS_ROWSS);
        bf16_t* Q = (bf16_t*)(ws + WS_R1); bf16_t* Kb = Q + (size_t)MTOK * 512; bf16_t* Vb = Kb + (size_t)MTOK * 128;
        bf16_t* CB = (bf16_t*)(ws + WS_R1 + 24 * MiB); bf16_t* CC = CB + (size_t)MTOK * 512; bf16_t* CX = CC + (size_t)MTOK * 512; bf16_t* U = (bf16_t*)(ws + WS_R1 + 72 * MiB);
        bf16_t* MG = (bf16_t*)(ws + WS_R1); bf16_t* Z = (bf16_t*)(ws + WS_R1 + 32 * MiB);
        bf16_t* GT = (bf16_t*)(ws + WS_R2); bf16_t* HD = (bf16_t*)(ws + WS_R2);
        bf16_t* AO = (bf16_t*)(ws + WS_R3); bf16_t* YS = (bf16_t*)(ws + WS_R3 + 16 * MiB); bf16_t* CA = (bf16_t*)(ws + WS_R3 + 32 * MiB);
        float* XRES = args.out; asm volatile("" : "+s"(XRES));
        const bool split = (F.G == 256) && IN(pb + 2) && IN(pb + 3);
        if (IN(pb + 0)) {
            pg8::Gemm g{XB, XB, XB, W + WO_IN, W + WO_IN, W + WO_IN, DM}; pg8::StaticOrder S; S.init(MTOK, INCOLS, F.G, (int)blockIdx.x, 1);
            pg8::EpiInProj E{ROWSS, (const float*)(ws + WS_ROPE), (const float*)(ws + WS_ROPE) + SEQ * 8, args.in[I_BGATE] + l * 3072, Q, Kb, Vb, CB, CC, CX, U, GT};
            REPEAT(REP_INPROJ) { pg8::Acc acc; RUN_GEMM(g, S, E, acc, true); }
            {
                if (F.G == 256) { if (blockIdx.x >= 192) prep_ssm(F, args, l, blockIdx.x - 192, 64); } else prep_ssm(F, args, l, blockIdx.x, F.G);
            }
        }
        SEAM(pb + 0);
        if (IN(pb + 1)) REPEAT(REP_MIXERS) { mixers_phase(F, args, l); }
        SEAM(pb + 1);
#define GLU_UNITS() do { \
            {     \
                pg8::Gemm g{YS, YS, YS, W + WO_GLU, W + WO_GLU, W + WO_GLU, 512}; pg8::StaticOrder S; S.init(MTOK, 512, F.G, (int)blockIdx.x, 1); \
                pg8::EpiGlu E{nullptr, YS, Z}; \
                pg8::Acc acc; RUN_GEMM(g, S, E, acc, true); \
            } } while (0)
        if (split) REPEAT(REP_MERGE) {
            GLU_UNITS();
            pg8::Gemm g{AO, CA, Z, W + WO_AO, W + WO_CO, W + WO_SO, 512}; pg8::StaticOrder S; S.init(MTOK, DM, F.G, (int)blockIdx.x, 3);
            pg8::EpiMerge E{nullptr, GT, MG, 0};
            const BarrierHook H{&bar, 2};
            pg8::Acc acc; pg8::gemm_phase<pg8::EpiMerge, true, true, BarrierHook>(F.lds, g, S, E, acc, true, H);
        } else {
            if (IN(pb + 2)) GLU_UNITS();
            SEAM(pb + 2);
            if (IN(pb + 3)) {
                pg8::Gemm g{AO, CA, Z, W + WO_AO, W + WO_CO, W + WO_SO, 512}; pg8::StaticOrder S; S.init(MTOK, DM, F.G, (int)blockIdx.x, 3);
                pg8::EpiMerge E{nullptr, GT, MG, 0};
                pg8::Acc acc; RUN_GEMM(g, S, E, acc, true);
            }
        }
#undef GLU_UNITS
        SEAM(pb + 3);
        if (IN(pb + 4)) {
            pg8::Gemm g{MG, MG, MG, W + WO_MIX, W + WO_MIX, W + WO_MIX, DM}; pg8::StaticOrder S; S.init(MTOK, DM, F.G, (int)blockIdx.x, 1);
            REPEAT(REP_MIXO) { pg8::EpiResid E{nullptr, (l == 0 && rep_ == 0) ? args.in[I_X] : XRES, XRES, XB, ROWSS + (size_t)MTOK * 16, rep_ + 1 < REP_MIXO}; pg8::Acc acc; RUN_GEMM(g, S, E, acc, true); }
        }
        SEAM(pb + 4);
        if (IN(pb + 5)) {
            pg8::Gemm g{XB, XB, XB, W + WO_FI, W + WO_FI, W + WO_FI, DM}; pg8::StaticOrder S; S.init(MTOK, FFN2, F.G, (int)blockIdx.x, 1);
            pg8::EpiFfnIn E{ROWSS + (size_t)MTOK * 16, HD};
            REPEAT(REP_FFNIN) { pg8::Acc acc; RUN_GEMM(g, S, E, acc, true); }
            if (l + 1 < DEPTH) {
                if (F.G == 256) { if (blockIdx.x >= 128) prep_weights(F, args, l + 1, 0, N_WITEMS, gwave - 1024, 1024); } else prep_weights(F, args, l + 1, 0, N_WITEMS, gwave, ngwave);
            }
        }
        SEAM(pb + 5);
        if (IN(pb + 6)) {
            pg8::Gemm g{HD, HD, HD, W + WO_FO, W + WO_FO, W + WO_FO, FFN}; pg8::StaticOrder S; S.init(MTOK, DM, F.G, (int)blockIdx.x, 1);
            REPEAT(REP_FFNOUT) { pg8::EpiResid E{nullptr, XRES, XRES, XB, ROWSS, rep_ + 1 < REP_FFNOUT}; pg8::Acc acc; RUN_GEMM(g, S, E, acc, true); }
        }
        SEAM(pb + 6);
    }
    if (IN(PH_FINAL)) final_norm(F, args);
#undef IN
}

extern "C" void kernel_launch(void* const* d_in, const int* in_sizes, int n_in, void* d_out, int out_size, void* d_ws, size_t ws_size, hipStream_t stream) {
    static int grid = 0;
    if (grid == 0) {
        if (n_in != 23 || out_size != MTOK * DM || ws_size < WS_END) { fprintf(stderr, "kernel_launch: unexpected shapes (n_in %d out %d ws %zu)\n", n_in, out_size, ws_size); grid = -1; return; }
        if (hipFuncSetAttribute((const void*)fwd_kernel, hipFuncAttributeMaxDynamicSharedMemorySize, LDS_BYTES) != hipSuccess) { fprintf(stderr, "hipFuncSetAttribute failed\n"); grid = -1; return; }
        int dev = 0, cus = 0, per_cu = 0; (void)hipGetDevice(&dev); (void)hipDeviceGetAttribute(&cus, hipDeviceAttributeMultiprocessorCount, dev);
        if (hipOccupancyMaxActiveBlocksPerMultiprocessor(&per_cu, (const void*)fwd_kernel, NTHREADS, LDS_BYTES) != hipSuccess || per_cu < 1) { fprintf(stderr, "occupancy query failed (%d)\n", per_cu); (void)hipGetLastError(); per_cu = 1; }
        grid = cus > 0 ? cus : 256;
    }
    if (grid < 0) return;
    (void)hipMemsetAsync((char*)d_ws, 0, ZERO_BYTES, stream);
    Args a{};
    for (int i = 0; i < 23; ++i) a.in[i] = (const float*)d_in[i];
    a.out = (float*)d_out; a.ws = (unsigned char*)d_ws;
#if N_LAUNCH_MODE == 1
    a.ph_lo = 0; a.ph_hi = N_PHASES; a.li = 0;
    void* kargs[] = {&a};
    hipError_t e = hipLaunchCooperativeKernel((const void*)fwd_kernel, dim3(grid), dim3(NTHREADS), kargs, LDS_BYTES, stream);
    if (e != hipSuccess) fprintf(stderr, "cooperative launch failed: %s (grid %d)\n", hipGetErrorString(e), grid);
#else
    for (int p = 0; p < N_PHASES; ++p) {
        a.ph_lo = p; a.ph_hi = p + 1; a.li = 0;
        hipLaunchKernelGGL(fwd_kernel, dim3(grid), dim3(NTHREADS), LDS_BYTES, stream, a);
    }
#endif
}
```

```cpp
#include <hip/hip_runtime.h>
#include <cstdio>
#include <cstdint>

#ifndef FAST_GEMM
#define FAST_GEMM 1
#endif
#ifndef N_LAUNCH_MODE
#define N_LAUNCH_MODE 1
#endif

#define LAS __attribute__((address_space(3)))
#define GAS __attribute__((address_space(1)))
typedef unsigned short bf16_t;
typedef short bf16x8 __attribute__((ext_vector_type(8)));
typedef float f32x4 __attribute__((ext_vector_type(4)));
typedef float f32x2 __attribute__((ext_vector_type(2)));
typedef unsigned u32x4 __attribute__((ext_vector_type(4)));
typedef unsigned u32x2 __attribute__((ext_vector_type(2)));

constexpr int DM = 1024, BATCH = 8, SEQ = 2048, DEPTH = 4, MTOK = BATCH * SEQ;
constexpr int INCOLS = 5888, FFN = 2816, FFN2 = 5632;
constexpr int C_Q = 0, C_K = 512, C_V = 640, C_CB = 768, C_CC = 1280, C_CX = 1792, C_U = 2304, C_G = 2816;
constexpr float NORM_EPS = 1e-6f;
constexpr float LOG2E = 1.4426950408889634f;
constexpr float QSCALE = 0.125f * LOG2E;

constexpr size_t MiB = 1u << 20;
constexpr size_t WS_CTL = 0;
constexpr size_t ZERO_BYTES = 1 * MiB;
constexpr size_t WS_SSM = 1 * MiB;
constexpr size_t WS_ROPE = 4 * MiB;
constexpr size_t WS_ROWSS = 5 * MiB;
constexpr size_t WS_W = 7 * MiB;
constexpr size_t W_BUF = 34 * MiB;
constexpr size_t WS_XBF = 75 * MiB;
constexpr size_t WS_R1 = 107 * MiB;
constexpr size_t WS_R2 = 195 * MiB;
constexpr size_t WS_R3 = 291 * MiB;
constexpr size_t WS_Q = WS_R1, WS_K = WS_R1 + 16 * MiB, WS_V = WS_R1 + 20 * MiB, WS_CB = WS_R1 + 24 * MiB, WS_ZC = WS_R1 + 40 * MiB, WS_MG = WS_R1 + 56 * MiB;
constexpr size_t WS_GT = WS_R2, WS_HD = WS_R2, WS_U = WS_R3, WS_Z = WS_R3, WS_YS = WS_R3 + 16 * MiB, WS_CA = WS_R3 + 32 * MiB, WS_AO = WS_Q;
constexpr int HD_PITCH = 3072;
constexpr size_t WS_SSMM = 339 * MiB;
constexpr size_t SSMM_BUF = 9 * MiB;
constexpr size_t WS_END = 357 * MiB;
constexpr size_t SM_WY = 0, SM_GT = 6 * MiB, SM_L16 = 8 * MiB;
constexpr size_t WO_IN = 0, WO_AO = WO_IN + (size_t)INCOLS * DM, WO_CO = WO_AO + 1024 * 512, WO_GLU = WO_CO + 1024 * 512, WO_SO = WO_GLU + 512 * 512,
                 WO_MIX = WO_SO + 1024 * 512, WO_FI = WO_MIX + 1024 * 1024, WO_FO = WO_FI + (size_t)FFN2 * DM, WO_END = WO_FO + (size_t)DM * FFN;
static_assert(WO_END * 2 <= 34 * MiB, "weights fit");
constexpr size_t SO_LAM = 0;
constexpr size_t SO_BBAR = 64 * 1024;
constexpr size_t SO_POW = SO_BBAR + 32 * 64 * 16 * 2 * 4;
constexpr size_t SO_LAYER = 768 * 1024;

constexpr int RING_BYTES = 131072;
constexpr int MISC_OFF = RING_BYTES + 320;
constexpr int RSTAB_OFF = RING_BYTES + 4096;
constexpr int LDS_BYTES = 147456;
constexpr int NWAVES = 8, NTHREADS = 512;

__device__ __forceinline__ unsigned f2bf(float f) { unsigned u = __builtin_bit_cast(unsigned, f); return (u + 0x7fffu + ((u >> 16) & 1u)) >> 16; }
typedef __bf16 bf16x2_hw __attribute__((ext_vector_type(2)));
__device__ __forceinline__ unsigned pk2(float lo, float hi) { const f32x2 v = {lo, hi}; const bf16x2_hw b = __builtin_convertvector(v, bf16x2_hw); return __builtin_bit_cast(unsigned, b); }
__device__ __forceinline__ float bf2f(unsigned short b) { return __builtin_bit_cast(float, (unsigned)b << 16); }
__device__ __forceinline__ float bflo(unsigned w) { return __builtin_bit_cast(float, w << 16); }
__device__ __forceinline__ float bfhi(unsigned w) { return __builtin_bit_cast(float, w & 0xffff0000u); }
__device__ __forceinline__ void unpack8(const u32x4 w, float (&v)[8]) { v[0] = bflo(w.x); v[1] = bfhi(w.x); v[2] = bflo(w.y); v[3] = bfhi(w.y); v[4] = bflo(w.z); v[5] = bfhi(w.z); v[6] = bflo(w.w); v[7] = bfhi(w.w); }
__device__ __forceinline__ u32x4 pack8(const float (&v)[8]) { u32x4 w; w.x = pk2(v[0], v[1]); w.y = pk2(v[2], v[3]); w.z = pk2(v[4], v[5]); w.w = pk2(v[6], v[7]); return w; }
__device__ __forceinline__ float sigmoidf_(float x) { return __builtin_amdgcn_rcpf(1.0f + __builtin_amdgcn_exp2f(-LOG2E * x)); }
__device__ __forceinline__ float gelu_tanh(float y) { const float t = (1.5957691216057308f * LOG2E) * (y + 0.044715f * y * y * y); return y * __builtin_amdgcn_rcpf(1.0f + __builtin_amdgcn_exp2f(-t)); }
template <class T> __device__ __forceinline__ T gld(const void* p) { return *(const GAS T*)p; }
template <class T> __device__ __forceinline__ void gst(void* p, const T v) { *(GAS T*)p = v; }
__device__ __forceinline__ void gst_wt16(void* p, const u32x4 v) { asm volatile("global_store_dwordx4 %0, %1, off sc1\n\ts_nop 1" :: "v"(p), "v"(v) : "memory"); }
__device__ __forceinline__ void gst_wt4(void* p, const float v) { asm volatile("global_store_dword %0, %1, off sc1" :: "v"(p), "v"(v) : "memory"); }
__device__ __forceinline__ float wave_sum(float v) {
#pragma unroll
    for (int o = 1; o < 64; o <<= 1) v += __shfl_xor(v, o);
    return v;
}

#ifndef PROBE_AMP
#define PROBE_AMP -1
#endif
#define AMP_BEGIN(id) unsigned long long amp_t0_##id = 0; if (PROBE_AMP == (id)) amp_t0_##id = __builtin_amdgcn_s_memrealtime()
#define AMP_END(id) do { if (PROBE_AMP == (id)) { const unsigned long long t1_ = __builtin_amdgcn_s_memrealtime(); const unsigned long long tgt_ = t1_ + 3ull * (t1_ - amp_t0_##id); while (__builtin_amdgcn_s_memrealtime() < tgt_) __builtin_amdgcn_s_sleep(8); } } while (0)
__device__ __forceinline__ int opaque_tid(int wave) { unsigned z = 0u; asm volatile("" : "+v"(z)); return wave * 64 + (int)__builtin_amdgcn_mbcnt_hi(~0u, __builtin_amdgcn_mbcnt_lo(~0u, z)); }
__device__ __forceinline__ float row_rs(const float* ss, int row) {
    const f32x4* p = (const f32x4*)(ss + (size_t)row * 16); const f32x4 a = p[0], b = p[1], c = p[2], d = p[3];
    const float t = ((a[0] + a[1]) + (a[2] + a[3])) + ((b[0] + b[1]) + (b[2] + b[3])) + (((c[0] + c[1]) + (c[2] + c[3])) + ((d[0] + d[1]) + (d[2] + d[3])));
    return __builtin_amdgcn_rsqf(t * (1.0f / DM) + NORM_EPS);
}
namespace pg8 {
constexpr int BM = 256, BK = 64, HALF = 128, HTB = HALF * BK * 2, STAGE_BYTES = 8 * HTB, NXCD = 8, WGM = 8;
struct Unit { int pm, pn, seg; };
struct Gemm { const bf16_t* A0; const bf16_t* A1; const bf16_t* A2; const bf16_t* B0; const bf16_t* B1; const bf16_t* B2; int K; int lda; };
__device__ __forceinline__ const bf16_t* sel3(const bf16_t* p0, const bf16_t* p1, const bf16_t* p2, int s) {
    unsigned long long a = (unsigned long long)p0, b = (unsigned long long)p1, c = (unsigned long long)p2;
    asm volatile("" : "+s"(a), "+s"(b), "+s"(c));
    return (const bf16_t*)(s == 0 ? a : (s == 1 ? b : c)); }
__device__ __forceinline__ const bf16_t* selA(const Gemm& g, int s) { return sel3(g.A0, g.A1, g.A2, s); }
__device__ __forceinline__ const bf16_t* selB(const Gemm& g, int s) { return sel3(g.B0, g.B1, g.B2, s); }

struct StaticOrder {
    int nM, nN, nwg, G, c, nseg;
    __device__ void init(int M, int N, int G_, int c_, int nseg_) { nM = M / BM; nN = N / BM; nwg = nM * nN; G = G_; c = c_; nseg = nseg_; }
    __device__ bool next(int i, Unit& u) const {
        const int ti = i / nseg; u.seg = i - ti * nseg;
        const long L = (long)ti * G + c; if (L >= nwg) return false;
        int wgid = (int)L; { const int q = nwg / NXCD, r = nwg % NXCD, xcd = wgid % NXCD, off = wgid / NXCD; wgid = (xcd < r ? xcd * (q + 1) : r * (q + 1) + (xcd - r) * q) + off; }
        const int nig = WGM * nN, gid = wgid / nig, fm = gid * WGM, gsz = (nM - fm) < WGM ? (nM - fm) : WGM;
        u.pm = fm + ((wgid % nig) % gsz); u.pn = (wgid % nig) / gsz; return true;
    }
};

typedef f32x4 Acc[2][2][4][2];

struct EpiInProj {
    static constexpr bool NEEDS_RS = true;
    const float* rowss; const float* ropec; const float* ropes; const float* bgate;
    bf16_t *Q, *Kb, *Vb, *CB, *ZC, *U, *Gt;
    static constexpr int NSTORE = 16;
    __device__ __forceinline__ bool operator()(Acc& acc, const Unit& u, int wr, int wc, int fr, int fq, const LAS float* rstab) const {
        const int cl = wc * 32 + 8 * fq;
        const int rowb = u.pm * BM + wr * 64 + fr;
        const LAS float* rsp = rstab + wr * 64 + fr;
        if (u.pn >= 5 && u.pn < 9) {
            bf16_t* p0 = ZC + (size_t)rowb * 512 + (u.pn - 5) * HALF + cl;
#pragma unroll
            for (int ai = 0; ai < 2; ++ai)
#pragma unroll
                for (int m = 0; m < 4; ++m) {
                    const float rs = rsp[ai * HALF + m * 16], rs2 = rs * rs;
                    float v[8];
#pragma unroll
                    for (int e = 0; e < 4; ++e) { v[e] = acc[ai][0][m][0][e] * acc[ai][1][m][0][e] * rs2; v[4 + e] = acc[ai][0][m][1][e] * acc[ai][1][m][1][e] * rs2; }
                    { const u32x4 pz = pack8(v); u32x2 z0; z0.x = pz.x; z0.y = pz.y; u32x2 z1; z1.x = pz.z; z1.y = pz.w;
                      gst<u32x2>(p0 + (ai * HALF + m * 16) * 512, z0); gst<u32x2>(p0 + (ai * HALF + m * 16) * 512 + 4, z1); }
                    asm volatile("" ::: "memory");
                }
            return true;
        }
#pragma unroll
        for (int bj = 0; bj < 2; ++bj) {
            const int colt = u.pn * BM + bj * HALF;
            if (colt >= C_G) {
                const int pl = (u.pn < 19) ? bj : 2, go = (u.pn < 19) ? (u.pn - 11) * HALF : colt - (C_G + 2048);
                bf16_t* p0 = Gt + (size_t)rowb * 3072 + pl * 1024 + go + cl;
                float bg[8];
                { const f32x4 b0 = gld<f32x4>(bgate + pl * 1024 + go + cl), b1 = gld<f32x4>(bgate + pl * 1024 + go + cl + 4);
#pragma unroll
                  for (int e = 0; e < 4; ++e) { bg[e] = -LOG2E * b0[e]; bg[4 + e] = -LOG2E * b1[e]; } }
#pragma unroll
                for (int ai = 0; ai < 2; ++ai)
#pragma unroll
                    for (int m = 0; m < 4; ++m) {
                        const float nrs = -LOG2E * rsp[ai * HALF + m * 16];
                        float v[8];
#pragma unroll
                        for (int e = 0; e < 4; ++e) {
                            v[e] = 1.0f + __builtin_amdgcn_exp2f(fminf(__builtin_fmaf(acc[ai][bj][m][0][e], nrs, bg[e]), 86.f));
                            v[4 + e] = 1.0f + __builtin_amdgcn_exp2f(fminf(__builtin_fmaf(acc[ai][bj][m][1][e], nrs, bg[4 + e]), 86.f));
                        }
                        gst<u32x4>(p0 + (ai * HALF + m * 16) * 3072, pack8(v));
                        asm volatile("" ::: "memory");
                    }
            } else {
                bf16_t* p0; int pitch; float scale = 1.0f; bool rope = false;
                if (colt < C_K) { p0 = Q + (size_t)rowb * 512 + colt + cl; pitch = 512; scale = QSCALE; rope = (wc & 1) == 0; }
                else if (colt < C_V) { p0 = Kb + (size_t)rowb * 128 + cl; pitch = 128; rope = (wc & 1) == 0; }
                else if (colt < C_CB) { p0 = Vb + (size_t)rowb * 128 + cl; pitch = 128; }
                else if (colt < C_CC) { p0 = CB + (size_t)rowb * 512 + (colt - C_CB) + cl; pitch = 512; }
                else { const int cu = (colt - C_U) + cl; p0 = U + (size_t)(cu >> 4) * SEQ * 16 + (cu & 15) + ((size_t)(rowb >> 11) * 32 * SEQ + (rowb & (SEQ - 1))) * 16; pitch = 16; }
                if (rope) {
                    const float sgn = (fq == 0) ? -1.f : 1.f;
#pragma unroll
                    for (int ai = 0; ai < 2; ++ai)
#pragma unroll
                        for (int m = 0; m < 4; ++m) {
                            const float rs = rsp[ai * HALF + m * 16] * scale;
                            const int pos = (rowb + ai * HALF + m * 16) & (SEQ - 1);
                            const f32x4 c0 = gld<f32x4>(ropec + pos * 8), c1 = gld<f32x4>(ropec + pos * 8 + 4);
                            const f32x4 s0 = gld<f32x4>(ropes + pos * 8), s1 = gld<f32x4>(ropes + pos * 8 + 4);
                            float v[8];
#pragma unroll
                            for (int e = 0; e < 4; ++e) { v[e] = acc[ai][bj][m][0][e] * rs; v[4 + e] = acc[ai][bj][m][1][e] * rs; }
#pragma unroll
                            for (int e = 0; e < 8; ++e) {
                                const float p = __shfl_xor(v[e], 16);
                                const float cs = e < 4 ? c0[e & 3] : c1[e & 3], sn = e < 4 ? s0[e & 3] : s1[e & 3];
                                const float r = v[e] * cs + sgn * p * sn;
                                v[e] = (fq < 2) ? r : v[e];
                            }
                            gst<u32x4>(p0 + (ai * HALF + m * 16) * pitch, pack8(v));
                            asm volatile("" ::: "memory");
                        }
                } else {
#pragma unroll
                    for (int ai = 0; ai < 2; ++ai)
#pragma unroll
                        for (int m = 0; m < 4; ++m) {
                            const float rs = rsp[ai * HALF + m * 16] * scale;
                            float v[8];
#pragma unroll
                            for (int e = 0; e < 4; ++e) { v[e] = acc[ai][bj][m][0][e] * rs; v[4 + e] = acc[ai][bj][m][1][e] * rs; }
                            gst<u32x4>(p0 + (ai * HALF + m * 16) * pitch, pack8(v));
                            asm volatile("" ::: "memory");
                        }
                }
            }
        }
        return true;
    }
};

struct EpiGlu {
    static constexpr bool NEEDS_RS = false;
    const float* rowss; const bf16_t* YS; bf16_t* Z;
    static constexpr int NSTORE = 0;
    __device__ __forceinline__ bool operator()(Acc& acc, const Unit& u, int wr, int wc, int fr, int fq, const LAS float*) const {
        const size_t o0 = (size_t)(u.pm * BM + wr * 64 + fr) * 512 + u.pn * BM + wc * 32 + 8 * fq; const bf16_t* yp = YS + o0; bf16_t* zp = Z + o0;
        u32x4 yv[2][4][2];
#pragma unroll
        for (int ai = 0; ai < 2; ++ai)
#pragma unroll
            for (int m = 0; m < 4; ++m)
#pragma unroll
                for (int bj = 0; bj < 2; ++bj) yv[ai][m][bj] = gld<u32x4>(yp + (ai * HALF + m * 16) * 512 + bj * HALF);
#pragma unroll
        for (int ai = 0; ai < 2; ++ai) {
#pragma unroll
            for (int m = 0; m < 4; ++m)
#pragma unroll
                for (int bj = 0; bj < 2; ++bj) {
                    float y[8]; unpack8(yv[ai][m][bj], y);
                    float v[8];
#pragma unroll
                    for (int e = 0; e < 4; ++e) { v[e] = y[e] * sigmoidf_(acc[ai][bj][m][0][e]); v[4 + e] = y[4 + e] * sigmoidf_(acc[ai][bj][m][1][e]); }
                    gst<u32x4>(zp + (ai * HALF + m * 16) * 512 + bj * HALF, pack8(v));
                }
            asm volatile("" ::: "memory");
        }
        return true;
    }
};

struct EpiMerge {
    static constexpr bool NEEDS_RS = false;
    const float* rowss; const bf16_t* Gt; bf16_t* Mg; int seg_base;  static constexpr int NSTORE = 0;
    __device__ __forceinline__ bool operator()(Acc& acc, const Unit& u, int wr, int wc, int fr, int fq, const LAS float*) const {
        const int s = u.seg + seg_base;
        const bf16_t* gp = Gt + (size_t)(u.pm * BM + wr * 64 + fr) * 3072 + u.pn * BM + wc * 32 + 8 * fq;
        const bf16_t* pd = gp + (s == 0 ? 0 : (s == 1 ? 1024 : 2048));
        const bf16_t* pn_ = gp + (s == 0 ? 1024 : 2048);
        bf16_t* mp = Mg + (size_t)(u.pm * BM + wr * 64 + fr) * DM + u.pn * BM + wc * 32 + 8 * fq;
#pragma unroll
        for (int ai = 0; ai < 2; ++ai) {
            u32x4 ga[4][2], gb[4][2];
#pragma unroll
            for (int m = 0; m < 4; ++m)
#pragma unroll
                for (int bj = 0; bj < 2; ++bj) {
                    const size_t o = (size_t)(ai * HALF + m * 16) * 3072 + bj * HALF;
                    gb[m][bj] = gld<u32x4>(pd + o);
                    ga[m][bj] = (s < 2) ? gld<u32x4>(pn_ + o) : gb[m][bj];
                }
#pragma unroll
            for (int m = 0; m < 4; ++m)
#pragma unroll
                for (int bj = 0; bj < 2; ++bj) {
                    float fa[8], fb[8], f[8]; unpack8(ga[m][bj], fa); unpack8(gb[m][bj], fb);
#pragma unroll
                    for (int e = 0; e < 8; ++e) { const float r = __builtin_amdgcn_rcpf(fb[e]); f[e] = (s < 2) ? fa[e] * r : r; }
                    if (s < 2) {
#pragma unroll
                        for (int e = 0; e < 4; ++e) { acc[ai][bj][m][0][e] *= f[e]; acc[ai][bj][m][1][e] *= f[4 + e]; }
                    } else {
                        float v[8];
#pragma unroll
                        for (int e = 0; e < 4; ++e) { v[e] = acc[ai][bj][m][0][e] * f[e]; v[4 + e] = acc[ai][bj][m][1][e] * f[4 + e]; }
                        gst<u32x4>(mp + (size_t)(ai * HALF + m * 16) * DM + bj * HALF, pack8(v));
                    }
                }
            asm volatile("" ::: "memory");
        }
        return s == 2;
    }
};

struct EpiResid {
    static constexpr bool NEEDS_RS = false;
    const float* rowss; const float* Xin; bf16_t* XB; float* ss_next; bool first; bool dry;  static constexpr int NSTORE = 0;
    __device__ __forceinline__ void row_group(Acc& acc, const int ai, const int m, const float (&xo0)[8], const float (&xo1)[8], bf16_t* xb0, const int row0, const int pn, const int wc, const int fq) const {
        float ssq = 0.f;
#pragma unroll
        for (int bj = 0; bj < 2; ++bj) {
            float v[8];
#pragma unroll
            for (int e = 0; e < 4; ++e) { const float a0 = bj ? xo1[e] : xo0[e], a1 = bj ? xo1[4 + e] : xo0[4 + e]; v[e] = dry ? a0 : a0 + acc[ai][bj][m][0][e]; v[4 + e] = dry ? a1 : a1 + acc[ai][bj][m][1][e]; }
#pragma unroll
            for (int e = 0; e < 8; ++e) ssq += v[e] * v[e];
            gst<u32x4>(xb0 + (size_t)(ai * HALF + m * 16) * DM + bj * HALF, pack8(v));
        }
        ssq += __shfl_xor(ssq, 16); ssq += __shfl_xor(ssq, 32);
        if (fq == 0) gst<float>(ss_next + (size_t)(row0 + ai * HALF + m * 16) * 16 + pn * 4 + wc, ssq);
    }
    __device__ __forceinline__ bool operator()(Acc& acc, const Unit& u, int wr, int wc, int fr, int fq, const LAS float*) const {
        const int row0 = u.pm * BM + wr * 64 + fr, col0 = u.pn * BM + wc * 32 + 8 * fq;
        bf16_t* xb0 = XB + (size_t)row0 * DM + col0; const float* xi0 = Xin + (size_t)row0 * DM + col0;
        if (first) {
#pragma unroll
            for (int ai = 0; ai < 2; ++ai)
#pragma unroll
            for (int mh = 0; mh < 2; ++mh) {
                f32x4 xv[4][2][2];
#pragma unroll
                for (int m = 2 * mh; m < 2 * mh + 2; ++m)
#pragma unroll
                    for (int bj = 0; bj < 2; ++bj) { const float* xp = xi0 + (size_t)(ai * HALF + m * 16) * DM + bj * HALF; xv[m][bj][0] = __builtin_nontemporal_load((const GAS f32x4*)xp); xv[m][bj][1] = __builtin_nontemporal_load((const GAS f32x4*)(xp + 4)); }
#pragma unroll
                for (int m = 2 * mh; m < 2 * mh + 2; ++m) {
                    float x0[8], x1[8];
#pragma unroll
                    for (int e = 0; e < 4; ++e) { x0[e] = xv[m][0][0][e]; x0[4 + e] = xv[m][0][1][e]; x1[e] = xv[m][1][0][e]; x1[4 + e] = xv[m][1][1][e]; }
                    row_group(acc, ai, m, x0, x1, xb0, row0, u.pn, wc, fq);
                }
                asm volatile("" ::: "memory");
            }
        } else {
#pragma unroll
            for (int ai = 0; ai < 2; ++ai) {
                u32x4 xv[4][2];
#pragma unroll
                for (int m = 0; m < 4; ++m)
#pragma unroll
                    for (int bj = 0; bj < 2; ++bj) xv[m][bj] = gld<u32x4>(xb0 + (size_t)(ai * HALF + m * 16) * DM + bj * HALF);
#pragma unroll
                for (int m = 0; m < 4; ++m) {
                    float x0[8], x1[8]; unpack8(xv[m][0], x0); unpack8(xv[m][1], x1);
                    row_group(acc, ai, m, x0, x1, xb0, row0, u.pn, wc, fq);
                }
                asm volatile("" ::: "memory");
            }
        }
        return true;
    }
};

struct EpiFfnIn {
    static constexpr bool NEEDS_RS = true;
    const float* rowss; bf16_t* H;
    static constexpr int NSTORE = 8;
    __device__ __forceinline__ bool operator()(Acc& acc, const Unit& u, int wr, int wc, int fr, int fq, const LAS float* rstab) const {
        bf16_t* p0 = H + (size_t)(u.pm * BM + wr * 64 + fr) * HD_PITCH + u.pn * HALF + wc * 32 + 8 * fq;
        const LAS float* rsp = rstab + wr * 64 + fr;
#pragma unroll
        for (int ai = 0; ai < 2; ++ai)
#pragma unroll
            for (int m = 0; m < 4; ++m) {
                const float rs = rsp[ai * HALF + m * 16], nrs = -LOG2E * rs, rs2 = rs * rs;
                float v[8];
#pragma unroll
                for (int n = 0; n < 2; ++n)
#pragma unroll
                    for (int e = 0; e < 4; ++e) {
                        const float g = acc[ai][0][m][n][e], up = acc[ai][1][m][n][e];
                        v[4 * n + e] = (g * up * rs2) * __builtin_amdgcn_rcpf(1.0f + __builtin_amdgcn_exp2f(g * nrs));
                    }
                gst<u32x4>(p0 + (ai * HALF + m * 16) * HD_PITCH, pack8(v));
                asm volatile("" ::: "memory");
            }
        return true;
    }
};


__host__ __device__ __forceinline__ int lds_byte(int r, int c) { const int st = (r >> 4) * 2 + (c >> 5), rr = r & 15, cc = c & 31, ob = rr * 64 + cc * 2; return st * 1024 + (ob ^ (((ob >> 9) & 1) << 5)); }
__host__ __device__ __forceinline__ void stage_rc(int b, int& R, int& C) { const int st = b / 1024, sb = b % 1024, swz = sb ^ (((sb >> 9) & 1) << 5); R = (st >> 1) * 16 + swz / 64; C = (st & 1) * 32 + (swz % 64) / 2; }
__host__ __device__ __forceinline__ int perm32(int rho) { const int n = rho >> 4, i = rho & 15; return 8 * (i >> 2) + 4 * n + (i & 3); }

struct NoHook { __device__ __forceinline__ void operator()(const Unit&) const {} };
struct Src { __amdgpu_buffer_rsrc_t r; unsigned o; };
__device__ __forceinline__ Src operator+(Src s_, size_t d) { s_.o += (unsigned)d; return s_; }
__device__ __forceinline__ Src make_src(const bf16_t* p, size_t off) { Src s_; s_.r = __builtin_amdgcn_make_buffer_rsrc((void*)p, (short)0, 0x7fffffff, 0x00020000); s_.o = (unsigned)off; return s_; }
template <class Epi, bool ALIGN_EPI, bool SP2, class Hook>
__device__ __forceinline__ void gemm_phase(LAS unsigned char* lds, const Gemm g, const StaticOrder& S, const Epi& E, Acc& acc, const bool fresh, const Hook& H, const int wave_id) {
    const int tid = opaque_tid(wave_id), wid = wave_id, lane = tid & 63, wr = wid >> 2, wc = wid & 3, fr = lane & 15, fq = lane >> 4;
    const int K = g.K, nt = K / BK, lda = g.lda ? g.lda : K;
    unsigned voffA[2], voffB[2];
#pragma unroll
    for (int i = 0; i < 2; ++i) { int R, C; stage_rc(tid * 16 + i * 8192, R, C); const int Rb = (R & ~31) + perm32(R & 31);
        voffA[i] = (unsigned)(R * lda + C) * 2u; voffB[i] = (unsigned)(Rb * K + C) * 2u; }
    const size_t kstep = (size_t)(BK * 2);
    const size_t hstep = (size_t)HALF * K * 2, hstepA = (size_t)HALF * lda * 2;
    const size_t tstep = 2 * hstep, tstepA = 2 * hstepA;
    const unsigned ldsw = (unsigned)wid * 1024u;
    const int aoff = lds_byte(wr * 64 + fr, fq * 8), boff = lds_byte(wc * 32 + fr, fq * 8);
#define PG8_SA(b, h) (((b) * 2 + (h)) * HTB)
#define PG8_SB(b, h) ((4 + (b) * 2 + (h)) * HTB)
#define PG8_STAGE(bufoff, gbase, voff) do { const Src _g = (gbase); _Pragma("unroll") for (int _i = 0; _i < 2; ++_i) \
        __builtin_amdgcn_raw_ptr_buffer_load_lds(_g.r, (LAS unsigned*)(lds + (bufoff) + ldsw + _i * 8192), 16, (voff)[_i], _g.o, 0, 0); } while (0)
#define PG8_LDA(dst, b, h) do { _Pragma("unroll") for (int m = 0; m < 4; ++m) _Pragma("unroll") for (int k = 0; k < 2; ++k) dst[m][k] = *(const LAS bf16x8*)(lds + PG8_SA(b, h) + aoff + m * 2048 + k * 1024); } while (0)
#define PG8_LDB(dst, b, h) do { _Pragma("unroll") for (int n = 0; n < 2; ++n) _Pragma("unroll") for (int k = 0; k < 2; ++k) dst[n][k] = *(const LAS bf16x8*)(lds + PG8_SB(b, h) + boff + n * 2048 + k * 1024); } while (0)
#define PG8_MMA(ai, bj, At, Bt) do { __builtin_amdgcn_s_setprio(1); _Pragma("unroll") for (int m = 0; m < 4; ++m) _Pragma("unroll") for (int n = 0; n < 2; ++n) _Pragma("unroll") for (int k = 0; k < 2; ++k) \
        acc[ai][bj][m][n] = __builtin_amdgcn_mfma_f32_16x16x32_bf16(Bt[n][k], At[m][k], acc[ai][bj][m][n], 0, 0, 0); __builtin_amdgcn_s_setprio(0); } while (0)
#define PG8_WAIT_V(n) asm volatile("s_waitcnt vmcnt(" #n ")" ::: "memory")
#define PG8_WAIT_L(n) asm volatile("s_waitcnt lgkmcnt(" #n ")" ::: "memory")
#define PG8_TRIP_SP2(W12) do { \
            PG8_LDB(B0, 0, 0); PG8_LDB(B1, 0, 1); PG8_SCHED; PG8_LDA(At, 0, 0); PG8_STAGE(PG8_SA(1, 1), a1 + hstepA, voffA); \
            W12; PG8_WAIT_L(0); PG8_BAR; PG8_MMA(0, 0, At, B0); PG8_MMA(0, 1, At, B1); PG8_BAR; PG8_SCHED; \
            PG8_LDA(At, 0, 1); PG8_STAGE(PG8_SB(0, 0), b2, voffB); PG8_STAGE(PG8_SB(0, 1), b2 + hstep, voffB); PG8_STAGE(PG8_SA(0, 0), a2, voffA); \
            W12; PG8_WAIT_L(0); PG8_BAR; PG8_MMA(1, 0, At, B0); PG8_MMA(1, 1, At, B1); PG8_BAR; PG8_SCHED; \
            PG8_LDB(B0, 1, 0); PG8_LDB(B1, 1, 1); PG8_SCHED; PG8_LDA(At, 1, 0); PG8_STAGE(PG8_SA(0, 1), a2 + hstepA, voffA); \
            PG8_WAIT_V(8); PG8_WAIT_L(0); PG8_BAR; PG8_MMA(0, 0, At, B0); PG8_MMA(0, 1, At, B1); PG8_BAR; PG8_SCHED; \
            PG8_LDA(At, 1, 1); PG8_STAGE(PG8_SB(1, 0), b3, voffB); PG8_STAGE(PG8_SB(1, 1), b3 + hstep, voffB); PG8_STAGE(PG8_SA(1, 0), a3, voffA); \
            PG8_WAIT_V(8); PG8_WAIT_L(0); PG8_BAR; PG8_MMA(1, 0, At, B0); PG8_MMA(1, 1, At, B1); PG8_BAR; PG8_SCHED; } while (0)
#define PG8_BAR __builtin_amdgcn_s_barrier()
#define PG8_SCHED __builtin_amdgcn_sched_barrier(0)
    Unit cur, nxt; int ui = 0, rs_pm = -1, t0 = 0;
    if (!S.next(0, cur)) return;
    if (fresh) {
#pragma unroll
        for (int a = 0; a < 2; ++a)
#pragma unroll
            for (int b = 0; b < 2; ++b)
#pragma unroll
                for (int m = 0; m < 4; ++m)
#pragma unroll
                    for (int n = 0; n < 2; ++n) acc[a][b][m][n] = (f32x4){0.f, 0.f, 0.f, 0.f};
    }
    bf16x8 At[4][2], B0[2][2], B1[2][2];
    Src cA = make_src(selA(g, cur.seg), (size_t)cur.pm * tstepA), cB = make_src(selB(g, cur.seg), (size_t)cur.pn * tstep);
    if constexpr (SP2) {
        PG8_STAGE(PG8_SB(0, 0), cB, voffB); PG8_STAGE(PG8_SB(0, 1), cB + hstep, voffB); PG8_STAGE(PG8_SA(0, 0), cA, voffA); PG8_STAGE(PG8_SA(0, 1), cA + hstepA, voffA);
        if (wr == 1) PG8_BAR;
        PG8_WAIT_V(2); PG8_BAR;
        PG8_STAGE(PG8_SB(1, 0), cB + kstep, voffB); PG8_STAGE(PG8_SA(1, 0), cA + kstep, voffA); PG8_STAGE(PG8_SB(1, 1), cB + hstep + kstep, voffB);
        PG8_WAIT_V(6); PG8_BAR;
    } else {
        PG8_STAGE(PG8_SB(0, 0), cB, voffB); PG8_STAGE(PG8_SA(0, 0), cA, voffA); PG8_STAGE(PG8_SB(0, 1), cB + hstep, voffB); PG8_STAGE(PG8_SA(0, 1), cA + hstepA, voffA);
        if (wr == 1) PG8_BAR;
        PG8_WAIT_V(4); PG8_BAR;
        PG8_STAGE(PG8_SB(1, 0), cB + kstep, voffB); PG8_STAGE(PG8_SA(1, 0), cA + kstep, voffA); PG8_STAGE(PG8_SB(1, 1), cB + hstep + kstep, voffB);
        PG8_WAIT_V(6); PG8_BAR;
    }
    for (;;) {
        const bool has_next = S.next(ui + 1, nxt);
        const Src nA = has_next ? make_src(selA(g, nxt.seg), (size_t)nxt.pm * tstepA) : cA, nB = has_next ? make_src(selB(g, nxt.seg), (size_t)nxt.pn * tstep) : cB;
        for (int t = t0; t < nt; t += 2) {
            const bool last = (t == nt - 2);
            const Src a1 = cA + (size_t)(t + 1) * kstep;
            const Src a2 = last ? nA : cA + (size_t)(t + 2) * kstep, b2 = last ? nB : cB + (size_t)(t + 2) * kstep;
            const Src a3 = a2 + kstep, b3 = b2 + kstep;
            if (last && has_next) H(nxt);
            if constexpr (SP2) {
            PG8_TRIP_SP2(PG8_WAIT_V(8));
            } else {
            PG8_LDB(B0, 0, 0); PG8_SCHED; PG8_LDA(At, 0, 0); PG8_STAGE(PG8_SA(1, 1), a1 + hstepA, voffA);
            PG8_WAIT_L(8); PG8_BAR; PG8_WAIT_L(0); PG8_MMA(0, 0, At, B0); PG8_BAR; PG8_SCHED;
            PG8_LDB(B1, 0, 1); PG8_STAGE(PG8_SB(0, 0), b2, voffB);
            PG8_BAR; PG8_WAIT_L(0); PG8_MMA(0, 1, At, B1); PG8_BAR;
            PG8_LDA(At, 0, 1); PG8_STAGE(PG8_SA(0, 0), a2, voffA);
            PG8_BAR; PG8_WAIT_L(0); PG8_MMA(1, 0, At, B0); PG8_BAR; PG8_SCHED;
            PG8_STAGE(PG8_SB(0, 1), b2 + hstep, voffB);
            PG8_WAIT_V(6); PG8_BAR; PG8_MMA(1, 1, At, B1); PG8_BAR;
            PG8_LDB(B0, 1, 0); PG8_SCHED; PG8_LDA(At, 1, 0); PG8_STAGE(PG8_SA(0, 1), a2 + hstepA, voffA);
            PG8_WAIT_L(8); PG8_BAR; PG8_WAIT_L(0); PG8_MMA(0, 0, At, B0); PG8_BAR; PG8_SCHED;
            PG8_LDB(B1, 1, 1); PG8_STAGE(PG8_SB(1, 0), b3, voffB);
            PG8_BAR; PG8_WAIT_L(0); PG8_MMA(0, 1, At, B1); PG8_BAR;
            PG8_LDA(At, 1, 1); PG8_STAGE(PG8_SA(1, 0), a3, voffA);
            PG8_BAR; PG8_WAIT_L(0); PG8_MMA(1, 0, At, B0); PG8_BAR; PG8_SCHED;
            PG8_STAGE(PG8_SB(1, 1), b3 + hstep, voffB);
            PG8_WAIT_V(6); PG8_BAR; PG8_MMA(1, 1, At, B1); PG8_BAR;
            }
        }
        if constexpr (ALIGN_EPI) { if (wr == 0) PG8_BAR; }
        const int tid_ = opaque_tid(wave_id), fr_ = tid_ & 15, fq_ = (tid_ & 63) >> 4;
        const LAS float* rstab = (const LAS float*)(lds + RSTAB_OFF);
        if (Epi::NEEDS_RS && cur.pm != rs_pm) {
            rs_pm = cur.pm;
            const GAS f32x4* p = (const GAS f32x4*)(E.rowss + (size_t)(cur.pm * BM + (tid_ >> 1)) * 16) + (tid_ & 1) * 2; const f32x4 pa = p[0], pb = p[1];
            float t = ((pa[0] + pa[1]) + (pa[2] + pa[3])) + ((pb[0] + pb[1]) + (pb[2] + pb[3]));
            const float t2 = __shfl_xor(t, 1); t = (tid_ & 1) ? (t2 + t) : (t + t2);
            if ((tid_ & 1) == 0) ((LAS float*)(lds + RSTAB_OFF))[tid_ >> 1] = __builtin_amdgcn_rsqf(t * (1.0f / DM) + NORM_EPS);
            PG8_WAIT_L(0); PG8_BAR;
        }
        AMP_BEGIN(11);
        const bool reset = E(acc, cur, wr, wc, fr_, fq_, rstab);
        AMP_END(11);
        if (!has_next) break;
        if (reset) {
#pragma unroll
            for (int a = 0; a < 2; ++a)
#pragma unroll
                for (int b = 0; b < 2; ++b)
#pragma unroll
                    for (int m = 0; m < 4; ++m)
#pragma unroll
                        for (int n = 0; n < 2; ++n) acc[a][b][m][n] = (f32x4){0.f, 0.f, 0.f, 0.f};
        }
        cur = nxt; cA = nA; cB = nB; ++ui;
        if constexpr (ALIGN_EPI) { if (wr == 1) PG8_BAR; }
        if constexpr (SP2 && Epi::NSTORE > 0) {
            const Src a1 = cA + kstep, a2 = cA + 2 * kstep, b2 = cB + 2 * kstep, a3 = a2 + kstep, b3 = b2 + kstep;
            if constexpr (Epi::NSTORE == 16) PG8_TRIP_SP2(PG8_WAIT_V(24)); else PG8_TRIP_SP2(PG8_WAIT_V(16));
            t0 = 2;
        }
    }
    PG8_WAIT_V(0);
    if constexpr (!ALIGN_EPI) { if (wr == 0) PG8_BAR; }
    PG8_BAR;
#undef PG8_SA
#undef PG8_SB
#undef PG8_STAGE
#undef PG8_LDA
#undef PG8_LDB
#undef PG8_MMA
#undef PG8_WAIT_V
#undef PG8_TRIP_SP2
#undef PG8_WAIT_L
#undef PG8_BAR
#undef PG8_SCHED
}
}


#define XB_TMO      128
#define XB_XCNT(j)  (256  + 64 * (j))
#define XB_XSUB(j)  (1280 + 64 * (j))
#define XB_XGEN(j)  (2304 + 64 * (j))
#define XB_TOP      3328
#define XB_TOPGEN   3392
#define XCD_BAR_WORDS 3456
#define XB_SPIN_CAP (1u << 18)
__device__ __forceinline__ unsigned xb_ld(unsigned* p)              { return __hip_atomic_load(p, __ATOMIC_RELAXED, __HIP_MEMORY_SCOPE_AGENT); }
__device__ __forceinline__ unsigned xb_add(unsigned* p, unsigned v) { return __hip_atomic_fetch_add(p, v, __ATOMIC_RELAXED, __HIP_MEMORY_SCOPE_AGENT); }
__device__ __forceinline__ unsigned xb_xcc_id() { return (unsigned)__builtin_amdgcn_s_getreg((3 << 11) | 20) & 0xFu; }
#define XB_SPIN(cond, bar) do { unsigned _sp = 0; while (cond) { __builtin_amdgcn_s_sleep(1); \
    if ((++_sp & 255u) == 0u) { if (xb_ld(&(bar)[XB_TMO])) break; if (_sp > XB_SPIN_CAP) { atomicAdd(&(bar)[XB_TMO], 1u); break; } } } } while (0)
struct XcdBarrier { unsigned* bar; unsigned x; volatile LAS unsigned* st; int wave; bool local_ok; };
__device__ __forceinline__ bool xb_thread0(int wave) { unsigned z = 0u; asm volatile("" : "+v"(z), "+s"(wave)); return wave == 0 && __builtin_amdgcn_mbcnt_hi(~0u, __builtin_amdgcn_mbcnt_lo(~0u, z)) == 0u; }
__device__ __forceinline__ XcdBarrier xcd_barrier_post(unsigned* bar, volatile LAS unsigned* st, int wave) {
    XcdBarrier b; b.bar = bar; b.x = xb_xcc_id(); b.st = st; b.wave = wave; b.local_ok = false;
    if (xb_thread0(wave)) (void)xb_add(&bar[XB_XCNT(b.x)], 1u);
    return b;
}
__device__ __forceinline__ void xcd_barrier_complete(unsigned* bar, unsigned x, unsigned& nloc, unsigned& nx) {
    const unsigned G = gridDim.x * gridDim.y * gridDim.z;
    unsigned sum, cnt, mine, sp = 0u;
    for (;;) {
        sum = 0u; cnt = 0u; mine = 0u;
#pragma unroll
        for (unsigned j = 0; j < 16; ++j) { const unsigned c = xb_ld(&bar[XB_XCNT(j)]); sum += c; cnt += (c > 0u) ? 1u : 0u; mine = (j == x) ? c : mine; }
        if (sum == G) break;
        __builtin_amdgcn_s_sleep(1);
        if ((++sp & 255u) == 0u) { if (xb_ld(&bar[XB_TMO])) break; if (sp > XB_SPIN_CAP) { atomicAdd(&bar[XB_TMO], 1u); break; } }
    }
    nloc = mine > 0u ? mine : 1u; nx = cnt > 0u ? cnt : 1u;
}
#define XB_GSUB(g)  (4096 + 64 * (g))
#define XB_GGEN(g)  (8192 + 64 * (g))
__device__ __forceinline__ void xcd_barrier(const XcdBarrier& b, const int scope = 0) {
    const bool xcd_only = scope != 0;
    asm volatile("s_waitcnt vmcnt(0)" ::: "memory");
    __syncthreads();
    if (scope == 2 && b.local_ok) {
        if (xb_thread0(b.wave)) {
            unsigned* bar = b.bar;
            const unsigned g = (blockIdx.x & 7u) * 8u + ((blockIdx.x >> 3) & 7u);
            const unsigned old = xb_add(&bar[XB_GSUB(g)], 1u);
            const unsigned gen = old >> 2;
            if ((old & 3u) == 3u) xb_add(&bar[XB_GGEN(g)], 1u);
            else XB_SPIN(xb_ld(&bar[XB_GGEN(g)]) == gen, bar);
            __builtin_amdgcn_fence(__ATOMIC_ACQUIRE, "agent");
            asm volatile("s_waitcnt vmcnt(0)" ::: "memory");
        }
        __syncthreads();
        return;
    }
    if (xb_thread0(b.wave)) {
        unsigned* bar = b.bar;
        __builtin_amdgcn_s_waitcnt(0);
        unsigned nloc = b.st[0], nx = b.st[1];
        if (nloc == 0u) { xcd_barrier_complete(bar, b.x, nloc, nx); b.st[0] = nloc; b.st[1] = nx; }
        const unsigned old = xb_add(&bar[XB_XSUB(b.x)], 1u);
        const unsigned gen = old / nloc;
        if (old + 1u == (gen + 1u) * nloc) {
            if (!(xcd_only && b.local_ok)) {
                __builtin_amdgcn_fence(__ATOMIC_RELEASE, "agent");
                asm volatile("s_waitcnt vmcnt(0)" ::: "memory");
                const unsigned og = xb_add(&bar[XB_TOP], 1u);
                const unsigned tg = og / nx;
                if (og + 1u == (tg + 1u) * nx) xb_add(&bar[XB_TOPGEN], 1u);
                else XB_SPIN(xb_ld(&bar[XB_TOPGEN]) == tg, bar);
            }
            __builtin_amdgcn_fence(__ATOMIC_ACQUIRE, "agent");
            xb_add(&bar[XB_XGEN(b.x)], 1u);
            asm volatile("s_waitcnt vmcnt(0)" ::: "memory");
        } else {
            XB_SPIN(xb_ld(&bar[XB_XGEN(b.x)]) == gen, bar);
            __builtin_amdgcn_fence(__ATOMIC_ACQUIRE, "agent");
            asm volatile("s_waitcnt vmcnt(0)" ::: "memory");
        }
    }
    __syncthreads();
}

struct BarrierHook { const XcdBarrier* b; int at_seg; __device__ __forceinline__ void operator()(const pg8::Unit& nxt) const { if (nxt.seg == at_seg) xcd_barrier(*b, 2); } };


#define XB_WCNT 12416
#define XB_SCNT 12480
#define XB_DONE 12544
__device__ __forceinline__ void xb_signal(const XcdBarrier& b, int word) {
    asm volatile("s_waitcnt vmcnt(0)" ::: "memory");
    __syncthreads();
    if (xb_thread0(b.wave)) (void)xb_add(&b.bar[word], 1u);
}
__device__ __forceinline__ void xb_await(const XcdBarrier& b, int word, unsigned target) {
    if (xb_thread0(b.wave)) {
        unsigned* bar = b.bar;
        XB_SPIN(xb_ld(&bar[word]) < target, bar);
        __builtin_amdgcn_fence(__ATOMIC_ACQUIRE, "agent");
        asm volatile("s_waitcnt vmcnt(0)" ::: "memory");
    }
    __syncthreads();
}

struct EpiResidFinal {
    static constexpr bool NEEDS_RS = false;
    const float* rowss; const bf16_t* XB; float* OUT; float* ss; const float* gain; const XcdBarrier* bar;
    static constexpr int NSTORE = 0;
    __device__ __forceinline__ bool operator()(pg8::Acc& acc, const pg8::Unit& u, int wr, int wc, int fr, int fq, const LAS float* rstab) const {
        using namespace pg8;
        const int row0 = u.pm * BM + wr * 64 + fr, col0 = u.pn * BM + wc * 32 + 8 * fq;
        const bf16_t* xb0 = XB + (size_t)row0 * DM + col0;
#pragma unroll
        for (int ai = 0; ai < 2; ++ai) {
            u32x4 xv[4][2];
#pragma unroll
            for (int m = 0; m < 4; ++m)
#pragma unroll
                for (int bj = 0; bj < 2; ++bj) xv[m][bj] = gld<u32x4>(xb0 + (size_t)(ai * HALF + m * 16) * DM + bj * HALF);
#pragma unroll
            for (int m = 0; m < 4; ++m) {
                float ssq = 0.f;
#pragma unroll
                for (int bj = 0; bj < 2; ++bj) {
                    float h8[8]; unpack8(xv[m][bj], h8);
                    f32x4 x0, x1;
#pragma unroll
                    for (int e = 0; e < 4; ++e) { x0[e] = h8[e] + acc[ai][bj][m][0][e]; x1[e] = h8[4 + e] + acc[ai][bj][m][1][e]; }
                    acc[ai][bj][m][0] = x0; acc[ai][bj][m][1] = x1;
#pragma unroll
                    for (int e = 0; e < 4; ++e) ssq += x0[e] * x0[e];
#pragma unroll
                    for (int e = 0; e < 4; ++e) ssq += x1[e] * x1[e];
                }
                ssq += __shfl_xor(ssq, 16); ssq += __shfl_xor(ssq, 32);
                if (fq == 0) gst<float>(ss + (size_t)(row0 + ai * HALF + m * 16) * 16 + u.pn * 4 + wc, ssq);
            }
            asm volatile("" ::: "memory");
        }
        xcd_barrier(*bar, 2);
        {
            const int tid_ = ((wr * 4 + wc) * 64) + fq * 16 + fr;
            const GAS f32x4* p = (const GAS f32x4*)(ss + (size_t)(u.pm * BM + (tid_ >> 1)) * 16) + (tid_ & 1) * 2; const f32x4 pa = p[0], pb = p[1];
            float t = ((pa[0] + pa[1]) + (pa[2] + pa[3])) + ((pb[0] + pb[1]) + (pb[2] + pb[3]));
            const float t2 = __shfl_xor(t, 1); t = (tid_ & 1) ? (t2 + t) : (t + t2);
            if ((tid_ & 1) == 0) ((LAS float*)rstab)[tid_ >> 1] = __builtin_amdgcn_rsqf(t * (1.0f / DM) + NORM_EPS);
            asm volatile("s_waitcnt lgkmcnt(0)" ::: "memory"); __builtin_amdgcn_s_barrier(); asm volatile("" ::: "memory");
        }
        float* op0 = OUT + (size_t)row0 * DM + col0;
#pragma unroll
        for (int bj = 0; bj < 2; ++bj) {
            const f32x4 g0 = gld<f32x4>(gain + col0 + bj * HALF), g1 = gld<f32x4>(gain + col0 + bj * HALF + 4);
#pragma unroll
            for (int ai = 0; ai < 2; ++ai)
#pragma unroll
                for (int m = 0; m < 4; ++m) {
                    const float rs = rstab[ai * HALF + wr * 64 + m * 16 + fr];
                    float* op = op0 + (size_t)(ai * HALF + m * 16) * DM + bj * HALF;
                    __builtin_nontemporal_store(acc[ai][bj][m][0] * rs * g0, (GAS f32x4*)op); __builtin_nontemporal_store(acc[ai][bj][m][1] * rs * g1, (GAS f32x4*)(op + 4));
                }
        }
        return true;
    }
};

struct Args { const float* in[23]; float* out; unsigned char* ws; int ph_lo, ph_hi, li, pad; };
enum { I_X = 0, I_NMIX, I_WIN, I_BGATE, I_SINK, I_WAO, I_CONVW, I_WCO, I_ARE, I_AIM, I_BRE, I_BIM, I_CRE, I_CIM, I_SD, I_LOGDT, I_WGLU, I_WSO, I_WMIX, I_NFFN, I_WFI, I_WFO, I_NFIN };
constexpr int PH_PER_LAYER = 7, PH_L0 = 2, PH_FINAL = PH_L0 + DEPTH * PH_PER_LAYER, N_PHASES = PH_FINAL + 1;
constexpr int N_WITEMS = 8576;

struct Frame {
    LAS unsigned char* lds;
    int tid, lane, wave, G;
    unsigned char* ws;
};

__device__ __forceinline__ void transpose_item(const float* W, int K, int N, bf16_t* WT, int kb, int nb, int drow0, const float* kscale, LAS float* scr, int lane) {
    const int k0 = 64 * kb, n0 = 32 * nb, c = lane & 7;
    f32x4 s0 = {1.f, 1.f, 1.f, 1.f}, s1 = {1.f, 1.f, 1.f, 1.f};
    if (kscale) { s0 = *(const f32x4*)(kscale + k0 + 8 * c); s1 = *(const f32x4*)(kscale + k0 + 8 * c + 4); }
    const float* src = W + (size_t)(k0 + (lane >> 5)) * N + n0 + (lane & 31);
    float w[32];
#pragma unroll
    for (int i = 0; i < 32; ++i) w[i] = __builtin_nontemporal_load(src + (size_t)(2 * i) * N);
#pragma unroll
    for (int i = 0; i < 32; ++i) scr[(2 * i + (lane >> 5)) * 33 + (lane & 31)] = w[i];
    asm volatile("s_waitcnt lgkmcnt(0)" ::: "memory");
#pragma unroll
    for (int j = 0; j < 4; ++j) { const int n = (lane >> 3) + 8 * j; const LAS float* s = scr + (8 * c) * 33 + n;
        u32x4 o; o.x = pk2(s[0 * 33] * s0[0], s[1 * 33] * s0[1]); o.y = pk2(s[2 * 33] * s0[2], s[3 * 33] * s0[3]); o.z = pk2(s[4 * 33] * s1[0], s[5 * 33] * s1[1]); o.w = pk2(s[6 * 33] * s1[2], s[7 * 33] * s1[3]);
        gst_wt16(WT + (size_t)(drow0 + n) * K + k0 + 8 * c, o); }
    asm volatile("s_waitcnt lgkmcnt(0)" ::: "memory");
}

__device__ __forceinline__ void prep_global(Frame& F, const Args& a) {
    F.tid = opaque_tid(F.wave); F.lane = F.tid & 63;
    float* rc = (float*)(F.ws + WS_ROPE); float* rsn = rc + SEQ * 8;
    const int gt = blockIdx.x * NTHREADS + F.tid, NT = F.G * NTHREADS;
    for (int i = gt; i < SEQ * 8; i += NT) {
        const int pos = i >> 3, j = i & 7;
        const float invf = (float)exp(-(double)(2 * j) / 16.0 * log(500000.0));
        const float ang = (float)pos * invf;
        double s, c; sincos((double)ang, &s, &c);
        rc[i] = (float)c; rsn[i] = (float)s;
    }
    for (int it = gt; it < DEPTH * 32 * 64 * 17; it += NT) {
        const int i = it / 17, k = it - i * 17;
        const int l = i >> 11, gp = i & 2047, g = gp >> 6;
        const double dt = exp((double)a.in[I_LOGDT][l * 32 + g]);
        const double ar = (double)a.in[I_ARE][i], aim = (double)a.in[I_AIM][i];
        const double mg = exp(ar * dt * k); double s2, c2; sincos(aim * dt * k, &s2, &c2);
        float* pw = (float*)(F.ws + WS_SSM + (size_t)l * SO_LAYER + SO_POW) + (size_t)gp * 34;
        pw[2 * k] = (float)(mg * c2); pw[2 * k + 1] = (float)(mg * s2);
        if (k == 1) {
            const double lr = mg * c2, li = mg * s2;
            const double nr = lr - 1.0, ni = li, den = ar * ar + aim * aim;
            const double cr = (nr * ar + ni * aim) / den, ci = (ni * ar - nr * aim) / den;
            float* lam = (float*)(F.ws + WS_SSM + (size_t)l * SO_LAYER + SO_LAM); float* bb = (float*)(F.ws + WS_SSM + (size_t)l * SO_LAYER + SO_BBAR);
            lam[gp * 2] = (float)lr; lam[gp * 2 + 1] = (float)li;
            const float* bre = a.in[I_BRE] + (size_t)i * 16; const float* bim = a.in[I_BIM] + (size_t)i * 16;
            for (int h = 0; h < 16; ++h) { const double br = bre[h], bi = bim[h]; bb[(gp * 16 + h) * 2] = (float)(cr * br - ci * bi); bb[(gp * 16 + h) * 2 + 1] = (float)(cr * bi + ci * br); }
        }
    }
    const int gw = blockIdx.x * NWAVES + F.wave, NGW = F.G * NWAVES;
    const float* x = a.in[I_X]; bf16_t* xb = (bf16_t*)(F.ws + WS_XBF); float* ss = (float*)(F.ws + WS_ROWSS);
    for (int r0 = gw; r0 < MTOK; r0 += 4 * NGW) {
        f32x4 v[4][4];
#pragma unroll
        for (int q = 0; q < 4; ++q) { const int r = min(r0 + q * NGW, MTOK - 1); const f32x4* xr = (const f32x4*)(x + (size_t)r * DM) + F.lane;
#pragma unroll
            for (int j = 0; j < 4; ++j) v[q][j] = __builtin_nontemporal_load(xr + 64 * j); }
#pragma unroll
        for (int q = 0; q < 4; ++q) {
            const int r = r0 + q * NGW;
            if (r < MTOK) {
                u32x2* ob = (u32x2*)(xb + (size_t)r * DM) + F.lane;
                float s = 0.f;
#pragma unroll
                for (int j = 0; j < 4; ++j) { const f32x4 t = v[q][j]; s += t[0] * t[0] + t[1] * t[1] + t[2] * t[2] + t[3] * t[3]; u32x2 w; w.x = pk2(t[0], t[1]); w.y = pk2(t[2], t[3]); ob[64 * j] = w; }
                s = wave_sum(s);
                if (F.lane < 16) ss[(size_t)r * 16 + F.lane] = (F.lane == 0) ? s : 0.f;
            }
        }
    }
}

__device__ __forceinline__ void prep_weights(Frame& F, const Args& a, int l, int it_lo, int it_hi, int gw, int ngw) {
    F.tid = opaque_tid(F.wave); F.lane = F.tid & 63;
    bf16_t* W = (bf16_t*)(F.ws + WS_W + (size_t)(l & 1) * W_BUF);
    LAS float* scr = (LAS float*)(F.lds + F.wave * 16384);
    const float* w_in = a.in[I_WIN] + (size_t)l * DM * INCOLS; const float* w_ao = a.in[I_WAO] + (size_t)l * 512 * DM; const float* w_co = a.in[I_WCO] + (size_t)l * 512 * DM;
    const float* w_gl = a.in[I_WGLU] + (size_t)l * 512 * 512; const float* w_so = a.in[I_WSO] + (size_t)l * 512 * DM; const float* w_mx = a.in[I_WMIX] + (size_t)l * DM * DM;
    const float* w_fi = a.in[I_WFI] + (size_t)l * DM * FFN2; const float* w_fo = a.in[I_WFO] + (size_t)l * FFN * DM;
    const float* nmix = a.in[I_NMIX] + l * DM; const float* nffn = a.in[I_NFFN] + l * DM;
    constexpr int I0 = 16 * 184, I1 = 8 * 32, I2 = 8 * 32, I3 = 8 * 16, I4 = 8 * 32, I5 = 16 * 32, I6 = 16 * 176, I7 = 44 * 32;
    static_assert(I0 + I1 + I2 + I3 + I4 + I5 + I6 + I7 == N_WITEMS, "weight items");
    for (int it = it_lo + gw; it < it_hi; it += ngw) {
        int r = it;
        if (r < I0) { const int kb = r / 184, nb = r % 184, n0 = 32 * nb; int d0 = n0;
            if (n0 >= C_CC && n0 < C_CX) { const int c = n0 - C_CC; d0 = 256 * (5 + c / 128) + (c % 128); }
            else if (n0 >= C_CX && n0 < C_U) { const int c = n0 - C_CX; d0 = 256 * (5 + c / 128) + 128 + (c % 128); }
            else if (n0 >= C_G && n0 < C_G + 1024) { const int c = n0 - C_G; d0 = 256 * (11 + c / 128) + (c % 128); }
            else if (n0 >= C_G + 1024 && n0 < C_G + 2048) { const int c = n0 - C_G - 1024; d0 = 256 * (11 + c / 128) + 128 + (c % 128); }
            transpose_item(w_in, DM, INCOLS, W + WO_IN, kb, nb, d0, nmix, scr, F.lane); continue; } r -= I0;
        if (r < I1) { const int kb = r / 32, nb = r % 32; transpose_item(w_ao, 512, DM, W + WO_AO, kb, nb, 32 * nb, nullptr, scr, F.lane); continue; } r -= I1;
        if (r < I2) { const int kb = r / 32, nb = r % 32; transpose_item(w_co, 512, DM, W + WO_CO, kb, nb, 32 * nb, nullptr, scr, F.lane); continue; } r -= I2;
        if (r < I3) { const int kb = r / 16, nb = r % 16; transpose_item(w_gl, 512, 512, W + WO_GLU, kb, nb, 32 * nb, nullptr, scr, F.lane); continue; } r -= I3;
        if (r < I4) { const int kb = r / 32, nb = r % 32; transpose_item(w_so, 512, DM, W + WO_SO, kb, nb, 32 * nb, nullptr, scr, F.lane); continue; } r -= I4;
        if (r < I5) { const int kb = r / 32, nb = r % 32; transpose_item(w_mx, DM, DM, W + WO_MIX, kb, nb, 32 * nb, nullptr, scr, F.lane); continue; } r -= I5;
        if (r < I6) { const int kb = r / 176, nb = r % 176; const int n0 = 32 * nb; const int j0 = n0 < FFN ? n0 : n0 - FFN; const int drow0 = 256 * (j0 / 128) + (n0 < FFN ? 0 : 128) + (j0 % 128);
            transpose_item(w_fi, DM, FFN2, W + WO_FI, kb, nb, drow0, nffn, scr, F.lane); continue; } r -= I6;
        { const int kb = r / 32, nb = r % 32; transpose_item(w_fo, FFN, DM, W + WO_FO, kb, nb, 32 * nb, nullptr, scr, F.lane); }
    }
}

__device__ __forceinline__ void prep_ssm(Frame& F, const Args& a, int l, int item_lo, int item_step) {
    F.tid = opaque_tid(F.wave); F.lane = F.tid & 63;
    __syncthreads();
    {
        LAS float* pw = (LAS float*)(F.lds);
        LAS float* cC = pw + 64 * 34;
        LAS float* bB = cC + 16 * 64 * 2;
        LAS float* kd = bB + 64 * 16 * 2;
        unsigned char* smm = F.ws + WS_SSMM + (size_t)(l & 1) * SSMM_BUF;
        bf16_t* WY = (bf16_t*)(smm + SM_WY); bf16_t* GT = (bf16_t*)(smm + SM_GT); float* L16 = (float*)(smm + SM_L16);
        const int tid = F.tid;
        for (int item = item_lo; item < 256; item += item_step) {
            const int g = item >> 3, part = item & 7;
            const float* gpw = (const float*)(F.ws + WS_SSM + (size_t)l * SO_LAYER + SO_POW) + (size_t)g * 64 * 34;
            const float* gbb = (const float*)(F.ws + WS_SSM + (size_t)l * SO_LAYER + SO_BBAR) + (size_t)g * 64 * 32;
            const float* gcr = a.in[I_CRE] + (size_t)(l * 32 + g) * 1024; const float* gci = a.in[I_CIM] + (size_t)(l * 32 + g) * 1024;
            for (int i = tid; i < 64 * 34; i += NTHREADS) pw[i] = gpw[i];
            for (int i = tid; i < 2048; i += NTHREADS) bB[i] = gbb[i];
            for (int i = tid; i < 1024; i += NTHREADS) { cC[2 * i] = gcr[i]; cC[2 * i + 1] = gci[i]; }
            __syncthreads();
            {
                const int dd = tid >> 8, h = (tid >> 4) & 15, h2 = tid & 15, d = 2 * part + dd;
                float a0 = 0.f, a1 = 0.f, a2 = 0.f, a3 = 0.f;
#pragma unroll 4
                for (int p = 0; p < 64; p += 4) {
#pragma unroll
                    for (int u = 0; u < 4; ++u) {
                        const f32x2 c = *(const LAS f32x2*)(cC + (h * 64 + p + u) * 2), w = *(const LAS f32x2*)(pw + (p + u) * 34 + 2 * d), bv = *(const LAS f32x2*)(bB + ((p + u) * 16 + h2) * 2);
                        const float tr = c[0] * w[0] - c[1] * w[1], ti = c[0] * w[1] + c[1] * w[0];
                        const float t = tr * bv[0] - ti * bv[1];
                        if (u == 0) a0 += t; else if (u == 1) a1 += t; else if (u == 2) a2 += t; else a3 += t;
                    }
                }
                float acc = (a0 + a1) + (a2 + a3);
                if (d == 0 && h == h2) acc += a.in[I_SD][l * 512 + g * 16 + h];
                kd[tid] = acc;
            }
            __syncthreads();
            for (int dd = 0; dd < 2; ++dd) {
                const int d = 2 * part + dd, nblk = 16 - d;
                for (int it = tid; it < nblk * 32; it += NTHREADS) {
                    const int bi = it >> 5, r = (it >> 1) & 15, hc = it & 1, tau = d + bi, sI = bi;
                    float v[8];
#pragma unroll
                    for (int j = 0; j < 8; ++j) v[j] = kd[(dd * 16 + r) * 16 + hc * 8 + j];
                    gst_wt16(WY + ((size_t)g * 256 + tau * 16 + r) * 384 + sI * 16 + hc * 8, pack8(v));
                }
            }
            if (tid < 32) { const int r = tid >> 1, hc = tid & 1; unsigned zz = 0u; asm volatile("" : "+v"(zz)); u32x4 z; z.x = zz; z.y = zz; z.z = zz; z.w = zz;
                gst_wt16(WY + ((size_t)g * 256 + (2 * part) * 16 + r) * 384 + (2 * part + 1) * 16 + hc * 8, z); }
            {
                const int r = tid >> 4, kc = tid & 15, n = part * 32 + r, tau = n >> 4, h = n & 15, q = kc * 8; const bool im = q >= 64; const int p0 = im ? q - 64 : q;
                float v[8];
#pragma unroll
                for (int j = 0; j < 8; ++j) { const int p = p0 + j; const float cr = cC[(h * 64 + p) * 2], ci = cC[(h * 64 + p) * 2 + 1], pr = pw[p * 34 + 2 * (tau + 1)], pi = pw[p * 34 + 2 * (tau + 1) + 1];
                    v[j] = im ? -(cr * pi + ci * pr) : (cr * pr - ci * pi); }
                gst_wt16(WY + ((size_t)g * 256 + n) * 384 + 256 + q, pack8(v));
            }
            {
                const int r = tid >> 5, kc = tid & 31, k0 = kc * 8, n = part * 16 + r, sI = k0 >> 4, h0 = k0 & 15, p = n & 63; const bool im = n >= 64;
                const float pr = pw[p * 34 + 2 * (15 - sI)], pi = pw[p * 34 + 2 * (15 - sI) + 1];
                float v[8];
#pragma unroll
                for (int j = 0; j < 8; ++j) { const float br = bB[(p * 16 + h0 + j) * 2], bi = bB[(p * 16 + h0 + j) * 2 + 1]; v[j] = im ? (pr * bi + pi * br) : (pr * br - pi * bi); }
                gst_wt16(GT + ((size_t)g * 128 + n) * 256 + k0, pack8(v));
            }
            if (part == 0 && tid < 64) { gst_wt4(&L16[(g * 64 + tid) * 2], pw[tid * 34 + 32]); gst_wt4(&L16[(g * 64 + tid) * 2 + 1], pw[tid * 34 + 33]); }
            __syncthreads();
        }
    }
}


typedef float f32x16 __attribute__((ext_vector_type(16)));
constexpr int UX_PITCH = 784, SSM_S_OFF = 64 * UX_PITCH;

constexpr int AT_KPITCH = 144, AT_VPITCH = 520, AT_VT_OFF = 256 * AT_KPITCH;

constexpr int CONVW_OFF = RING_BYTES + 8192;
__device__ __forceinline__ void conv_item(const bf16_t* CB, const bf16_t* ZC, bf16_t* CA, const LAS float* cw, int it) {
    const int row = it >> 6, c0 = (it & 63) * 8, t = row & (SEQ - 1);
    const size_t o = (size_t)row * 512 + c0;
    const size_t o1 = (t >= 1) ? o - 512 : o, o2 = (t >= 2) ? o - 1024 : o;
    const u32x4 vb = *(const u32x4*)(CB + o), vz0 = *(const u32x4*)(ZC + o), vz1 = *(const u32x4*)(ZC + o1), vz2 = *(const u32x4*)(ZC + o2);
    float cb[8], z0[8], z1[8], z2[8];
    unpack8(vb, cb); unpack8(vz0, z0); unpack8(vz1, z1); unpack8(vz2, z2);
    const float m1 = (t >= 1) ? 1.f : 0.f, m2 = (t >= 2) ? 1.f : 0.f;
    float v[8];
#pragma unroll
    for (int e = 0; e < 8; ++e) v[e] = cb[e] * (cw[c0 + e] * (z2[e] * m2) + cw[512 + c0 + e] * (z1[e] * m1) + cw[1024 + c0 + e] * z0[e]);
    *(u32x4*)(CA + o) = pack8(v);
}

template <int NB>
__device__ __forceinline__ void conv_batch(const bf16_t* CB, const bf16_t* ZC, bf16_t* CA, const LAS float* cw, int it0, int stride, int it_end) {
    u32x4 vb[NB], vz[NB][3];
#pragma unroll
    for (int k = 0; k < NB; ++k) {
        const int it = min(it0 + k * stride, it_end - 1);
        const int row = it >> 6, c0 = (it & 63) * 8, t = row & (SEQ - 1);
        const size_t o = (size_t)row * 512 + c0, o1 = (t >= 1) ? o - 512 : o, o2 = (t >= 2) ? o - 1024 : o;
        vb[k] = *(const u32x4*)(CB + o);
        vz[k][0] = *(const u32x4*)(ZC + o); vz[k][1] = *(const u32x4*)(ZC + o1); vz[k][2] = *(const u32x4*)(ZC + o2);
    }
#pragma unroll
    for (int k = 0; k < NB; ++k) {
        const int it = it0 + k * stride;
        if (it < it_end) {
            const int row = it >> 6, c0 = (it & 63) * 8, t = row & (SEQ - 1);
            float cb[8], z0[8], z1[8], z2[8];
            unpack8(vb[k], cb); unpack8(vz[k][0], z0); unpack8(vz[k][1], z1); unpack8(vz[k][2], z2);
            const float m1 = (t >= 1) ? 1.f : 0.f, m2 = (t >= 2) ? 1.f : 0.f;
            float v[8];
#pragma unroll
            for (int e = 0; e < 8; ++e) v[e] = cb[e] * (cw[c0 + e] * (z2[e] * m2) + cw[512 + c0 + e] * (z1[e] * m1) + cw[1024 + c0 + e] * z0[e]);
            *(u32x4*)(CA + (size_t)row * 512 + c0) = pack8(v);
        }
    }
}
__device__ __forceinline__ void conv_phase(Frame& F, const Args& a, int l, int blk, int nblk) {
    F.tid = opaque_tid(F.wave); F.lane = F.tid & 63;
    const bf16_t* CB = (const bf16_t*)(F.ws + WS_CB); const bf16_t* ZC = (const bf16_t*)(F.ws + WS_ZC);
    bf16_t* CA = (bf16_t*)(F.ws + WS_CA);
    LAS float* cw = (LAS float*)(F.lds + CONVW_OFF);
    for (int i = F.tid; i < 1536; i += NTHREADS) cw[i] = a.in[I_CONVW][l * 1536 + i];
    __syncthreads();
    const int per = (MTOK * 64 + nblk - 1) / nblk, lo = blk * per, hi = min(lo + per, MTOK * 64);
    for (int it0 = lo + F.tid; it0 < hi; it0 += 4 * NTHREADS) conv_batch<4>(CB, ZC, CA, cw, it0, NTHREADS, hi);
}

__device__ __forceinline__ void mixers_phase(Frame& F, const Args& a, int l, const bool do_conv) {
    F.tid = opaque_tid(F.wave); F.lane = F.tid & 63;
    const int tid = F.tid, lane = F.lane, wave = F.wave, l31 = lane & 31, hi = lane >> 5;
    const bf16_t* Q = (const bf16_t*)(F.ws + WS_Q); const bf16_t* Kb = (const bf16_t*)(F.ws + WS_K); const bf16_t* Vb = (const bf16_t*)(F.ws + WS_V);
    const bf16_t* CB = (const bf16_t*)(F.ws + WS_CB); const bf16_t* CC = (const bf16_t*)(F.ws + WS_ZC);
    const bf16_t* U = (const bf16_t*)(F.ws + WS_U);
    bf16_t* AO = (bf16_t*)(F.ws + WS_AO); bf16_t* YS = (bf16_t*)(F.ws + WS_YS); bf16_t* CA = (bf16_t*)(F.ws + WS_CA);
    const unsigned char* smm = F.ws + WS_SSMM + (size_t)(l & 1) * SSMM_BUF;
    const bf16_t* WY = (const bf16_t*)(smm + SM_WY); const bf16_t* GT = (const bf16_t*)(smm + SM_GT); const float* L16 = (const float*)(smm + SM_L16);
    LAS unsigned char* kl = F.lds; LAS unsigned char* vt = F.lds + AT_VT_OFF;
    LAS unsigned char* ux = F.lds; LAS float* S = (LAS float*)(F.lds + SSM_S_OFF);
    LAS float* cw = (LAS float*)(F.lds + CONVW_OFF);
    if (do_conv) for (int i = tid; i < 1536; i += NTHREADS) cw[i] = a.in[I_CONVW][l * 1536 + i];
    const int conv_per_blk = (MTOK * 64 + F.G - 1) / F.G;
    int conv_next = do_conv ? blockIdx.x * conv_per_blk : MTOK * 64; const int conv_end = do_conv ? min(conv_next + conv_per_blk, MTOK * 64) : MTOK * 64;
    const int n_units = (BATCH * 32 - (int)blockIdx.x + F.G - 1) / F.G;
    const int conv_per_slot = (conv_per_blk + 2 * n_units - 1) / (2 * n_units);
    for (int unit = blockIdx.x; unit < BATCH * 32; unit += F.G) {
        AMP_BEGIN(9);
        {
            const int b = unit & 7, n = unit >> 4, kvh = (unit >> 3) & 1;
            const int rowq0 = b * SEQ + n * 128, rowk0 = rowq0 - 128;
            const int hq = kvh * 4 + (wave >> 1);
            u32x4 kv[4], vv[4];
#pragma unroll
            for (int i = 0; i < 4; ++i) {
                const int v = tid + i * NTHREADS, key = v >> 3, dc = v & 7;
                const int rk = (n == 0 && key < 128) ? rowq0 : rowk0 + key;
                kv[i] = *(const u32x4*)(Kb + (size_t)rk * 128 + kvh * 64 + dc * 8);
                vv[i] = *(const u32x4*)(Vb + (size_t)rk * 128 + kvh * 64 + dc * 8);
            }
            bf16x8 qf[2][4];
#pragma unroll
            for (int sb = 0; sb < 2; ++sb)
#pragma unroll
                for (int ks = 0; ks < 4; ++ks) qf[sb][ks] = *(const bf16x8*)(Q + (size_t)(rowq0 + (wave & 1) * 64 + sb * 32 + l31) * 512 + hq * 64 + ks * 16 + hi * 8);
            const float sl = a.in[I_SINK][l * 8 + hq] * LOG2E;
#pragma unroll
            for (int i = 0; i < 4; ++i) {
                const int v = tid + i * NTHREADS, key = v >> 3, dc = v & 7;
                *(LAS u32x4*)(kl + key * AT_KPITCH + dc * 16) = kv[i];
                LAS bf16_t* vp = (LAS bf16_t*)(vt + (dc * 8) * AT_VPITCH + key * 2);
                vp[0 * (AT_VPITCH / 2)] = (bf16_t)(vv[i].x & 0xffffu); vp[1 * (AT_VPITCH / 2)] = (bf16_t)(vv[i].x >> 16);
                vp[2 * (AT_VPITCH / 2)] = (bf16_t)(vv[i].y & 0xffffu); vp[3 * (AT_VPITCH / 2)] = (bf16_t)(vv[i].y >> 16);
                vp[4 * (AT_VPITCH / 2)] = (bf16_t)(vv[i].z & 0xffffu); vp[5 * (AT_VPITCH / 2)] = (bf16_t)(vv[i].z >> 16);
                vp[6 * (AT_VPITCH / 2)] = (bf16_t)(vv[i].w & 0xffffu); vp[7 * (AT_VPITCH / 2)] = (bf16_t)(vv[i].w >> 16);
            }
            __syncthreads();
#pragma unroll
            for (int sb = 0; sb < 2; ++sb) {
                const int q0 = (wave & 1) * 64 + sb * 32;
                const size_t qrow = (size_t)(rowq0 + q0 + l31);
                f32x16 sc[5];
#pragma unroll
                for (int kt = 0; kt < 5; ++kt) {
                    f32x16 acc = {};
                    const LAS unsigned char* kp = kl + (q0 + 32 * kt + l31) * AT_KPITCH + hi * 16;
#pragma unroll
                    for (int ks = 0; ks < 4; ++ks) acc = __builtin_amdgcn_mfma_f32_32x32x16_bf16(*(const LAS bf16x8*)(kp + ks * 32), qf[sb][ks], acc, 0, 0, 0);
                    sc[kt] = acc;
                }
                const int dlt = l31 - 4 * hi;
                float mx = -1e30f;
#pragma unroll
                for (int kt = 0; kt < 5; ++kt) {
                    const bool tile_ok = (n > 0) || (q0 + 32 * kt >= 128);
#pragma unroll
                    for (int r = 0; r < 16; ++r) {
                        const int c0 = (r & 3) + 8 * (r >> 2);
                        const bool ok = (kt == 0) ? (tile_ok && c0 > dlt) : ((kt == 4) ? (tile_ok && c0 <= dlt) : tile_ok);
                        const float v = ok ? sc[kt][r] : -1e30f;
                        sc[kt][r] = v; mx = fmaxf(mx, v);
                    }
                }
                mx = fmaxf(mx, __shfl_xor(mx, 32));
                mx = fmaxf(mx, sl);
                float ls = 0.f;
#pragma unroll
                for (int kt = 0; kt < 5; ++kt)
#pragma unroll
                    for (int r = 0; r < 16; ++r) { const float p = __builtin_amdgcn_exp2f(sc[kt][r] - mx); sc[kt][r] = p; ls += p; }
                ls += __shfl_xor(ls, 32);
                ls += __builtin_amdgcn_exp2f(sl - mx);
                f32x16 o0 = {}, o1 = {};
#pragma unroll
                for (int kt = 0; kt < 5; ++kt)
#pragma unroll
                    for (int s2 = 0; s2 < 2; ++s2) {
                        u32x4 pw; pw.x = pk2(sc[kt][8 * s2 + 0], sc[kt][8 * s2 + 1]); pw.y = pk2(sc[kt][8 * s2 + 2], sc[kt][8 * s2 + 3]); pw.z = pk2(sc[kt][8 * s2 + 4], sc[kt][8 * s2 + 5]); pw.w = pk2(sc[kt][8 * s2 + 6], sc[kt][8 * s2 + 7]);
                        const bf16x8 pf = __builtin_bit_cast(bf16x8, pw);
                        const int col = q0 + 32 * kt + 16 * s2 + 4 * hi;
                        const LAS unsigned char* vp0 = vt + l31 * AT_VPITCH + col * 2;
                        const LAS unsigned char* vp1 = vp0 + 32 * AT_VPITCH;
                        const u32x2 a0 = *(const LAS u32x2*)(vp0), a1 = *(const LAS u32x2*)(vp0 + 16);
                        const u32x2 c0 = *(const LAS u32x2*)(vp1), c1 = *(const LAS u32x2*)(vp1 + 16);
                        u32x4 va; va.x = a0.x; va.y = a0.y; va.z = a1.x; va.w = a1.y;
                        u32x4 vc; vc.x = c0.x; vc.y = c0.y; vc.z = c1.x; vc.w = c1.y;
                        o0 = __builtin_amdgcn_mfma_f32_32x32x16_bf16(__builtin_bit_cast(bf16x8, va), pf, o0, 0, 0, 0);
                        o1 = __builtin_amdgcn_mfma_f32_32x32x16_bf16(__builtin_bit_cast(bf16x8, vc), pf, o1, 0, 0, 0);
                    }
                const float inv = __builtin_amdgcn_rcpf(ls);
                bf16_t* op = AO + qrow * 512 + hq * 64 + 4 * hi;
#pragma unroll
                for (int qd = 0; qd < 4; ++qd) {
                    u32x2 w0; w0.x = pk2(o0[4 * qd] * inv, o0[4 * qd + 1] * inv); w0.y = pk2(o0[4 * qd + 2] * inv, o0[4 * qd + 3] * inv);
                    u32x2 w1; w1.x = pk2(o1[4 * qd] * inv, o1[4 * qd + 1] * inv); w1.y = pk2(o1[4 * qd + 2] * inv, o1[4 * qd + 3] * inv);
                    *(u32x2*)(op + 8 * qd) = w0; *(u32x2*)(op + 32 + 8 * qd) = w1;
                }
            }
        }
        AMP_END(9);
        AMP_BEGIN(10);
        {
            const int b = unit & 7, g = unit >> 3;
            const bf16_t* ug = U + (size_t)(b * 32 + g) * SEQ * 16;
            const bf16_t* wy = WY + (size_t)g * 256 * 384; const bf16_t* gt = GT + (size_t)g * 128 * 256;
            u32x4 ur[4];
#pragma unroll
            for (int i = 0; i < 4; ++i) ur[i] = ((const u32x4*)ug)[tid + i * NTHREADS];
            const int rb = wave >> 2, cb = wave & 3;
            float xr = 0.f, xi = 0.f, lr = 0.f, li = 0.f;
            if (wave == 0) { lr = L16[(g * 64 + lane) * 2]; li = L16[(g * 64 + lane) * 2 + 1]; }
            __syncthreads();
#pragma unroll 1
            for (int half = 0; half < 2; ++half) {
                bf16x8 gfr[16];
                { const bf16_t* bp = gt + (size_t)(cb * 32 + l31) * 256 + hi * 8;
#pragma unroll
                  for (int ks = 0; ks < 16; ++ks) gfr[ks] = *(const bf16x8*)(bp + ks * 16); }
#pragma unroll
                for (int i = 0; i < 4; ++i) { const int v = tid + i * NTHREADS, c = v >> 5, kc = v & 31; *(LAS u32x4*)(ux + c * UX_PITCH + kc * 16) = ur[i]; }
                if (half == 0) {
#pragma unroll
                    for (int i = 0; i < 4; ++i) ur[i] = ((const u32x4*)(ug + (size_t)1024 * 16))[tid + i * NTHREADS];
                }
                __syncthreads();
                {
                    f32x16 acc = {};
                    const LAS unsigned char* ap = ux + (rb * 32 + l31) * UX_PITCH + hi * 16;
#pragma unroll
                    for (int ks = 0; ks < 16; ++ks) acc = __builtin_amdgcn_mfma_f32_32x32x16_bf16(*(const LAS bf16x8*)(ap + ks * 32), gfr[ks], acc, 0, 0, 0);
#pragma unroll
                    for (int r = 0; r < 16; ++r) S[(rb * 32 + (r & 3) + 8 * (r >> 2) + 4 * hi) * 128 + cb * 32 + l31] = acc[r];
                }
                bf16x8 afr[24];
                { const bf16_t* ap = wy + (size_t)(wave * 32 + l31) * 384 + hi * 8;
#pragma unroll
                  for (int ks = 0; ks < 24; ++ks) if (ks >= 16 || ks <= 2 * wave + 1) afr[ks] = *(const bf16x8*)(ap + ks * 16); else afr[ks] = (bf16x8){0, 0, 0, 0, 0, 0, 0, 0}; }
                __syncthreads();
                if (wave == 0) {
                    f32x2 X = {xr, xi}; const f32x2 L1 = {lr, lr}, L2 = {-li, li};
                    f32x2 sn[8];
#pragma unroll
                    for (int q = 0; q < 8; ++q) { sn[q][0] = S[q * 128 + lane]; sn[q][1] = S[q * 128 + 64 + lane]; }
#pragma unroll 1
                    for (int c0 = 0; c0 < 64; c0 += 8) {
                        f32x2 sv[8];
#pragma unroll
                        for (int q = 0; q < 8; ++q) sv[q] = sn[q];
                        const int cn = (c0 + 8) & 63;
#pragma unroll
                        for (int q = 0; q < 8; ++q) { sn[q][0] = S[(cn + q) * 128 + lane]; sn[q][1] = S[(cn + q) * 128 + 64 + lane]; }
#pragma unroll
                        for (int q = 0; q < 8; ++q) {
                            const unsigned w = pk2(X[0], X[1]);
                            *(LAS bf16_t*)(ux + (c0 + q) * UX_PITCH + (256 + lane) * 2) = (bf16_t)(w & 0xffffu);
                            *(LAS bf16_t*)(ux + (c0 + q) * UX_PITCH + (320 + lane) * 2) = (bf16_t)(w >> 16);
                            const f32x2 Xs = __builtin_shufflevector(X, X, 1, 0);
                            X = L1 * X + sv[q];
                            X = L2 * Xs + X;
                        }
                    }
                    xr = X[0]; xi = X[1];
                } else {
                    const int slot_end = min(conv_next + conv_per_slot, conv_end);
                    for (int it = conv_next + (tid - 64); it < slot_end; it += NTHREADS - 64) conv_item(CB, CC, CA, cw, it);
                }
                conv_next = min(conv_next + conv_per_slot, conv_end);
                __syncthreads();
                {
                    f32x16 acc0 = {}, acc1 = {};
                    const LAS unsigned char* bp0 = ux + l31 * UX_PITCH + hi * 16;
                    const LAS unsigned char* bp1 = bp0 + 32 * UX_PITCH;
#pragma unroll
                    for (int ks = 0; ks < 24; ++ks) {
                        if (ks < 16 && ks > 2 * wave + 1) continue;
                        const bf16x8 b0 = *(const LAS bf16x8*)(bp0 + ks * 32);
                        const bf16x8 b1 = *(const LAS bf16x8*)(bp1 + ks * 32);
                        acc0 = __builtin_amdgcn_mfma_f32_32x32x16_bf16(afr[ks], b0, acc0, 0, 0, 0);
                        acc1 = __builtin_amdgcn_mfma_f32_32x32x16_bf16(afr[ks], b1, acc1, 0, 0, 0);
                    }
#pragma unroll
                    for (int cbk = 0; cbk < 2; ++cbk) {
                        unsigned wx[4], wy[4];
#pragma unroll
                        for (int q = 0; q < 4; ++q) {
                            float y0, y1, y2, y3;
                            if (cbk == 0) { y0 = acc0[4 * q]; y1 = acc0[4 * q + 1]; y2 = acc0[4 * q + 2]; y3 = acc0[4 * q + 3]; } else { y0 = acc1[4 * q]; y1 = acc1[4 * q + 1]; y2 = acc1[4 * q + 2]; y3 = acc1[4 * q + 3]; }
                            wx[q] = pk2(gelu_tanh(y0), gelu_tanh(y1)); wy[q] = pk2(gelu_tanh(y2), gelu_tanh(y3));
                        }
                        const auto s0x = __builtin_amdgcn_permlane32_swap(wx[0], wx[2], false, false), s0y = __builtin_amdgcn_permlane32_swap(wy[0], wy[2], false, false);
                        const auto s1x = __builtin_amdgcn_permlane32_swap(wx[1], wx[3], false, false), s1y = __builtin_amdgcn_permlane32_swap(wy[1], wy[3], false, false);
                        u32x4 lo4, hi4; lo4.x = s0x[0]; lo4.y = s0y[0]; lo4.z = s0x[1]; lo4.w = s0y[1]; hi4.x = s1x[0]; hi4.y = s1y[0]; hi4.z = s1x[1]; hi4.w = s1y[1];
                        const size_t row = (size_t)b * SEQ + half * 1024 + 16 * (cbk * 32 + l31) + 2 * wave + hi;
                        *(u32x4*)(YS + row * 512 + g * 16) = lo4; *(u32x4*)(YS + row * 512 + g * 16 + 8) = hi4;
                    }
                }
                __syncthreads();
            }
        }
        AMP_END(10);
    }
    for (int it = conv_next + tid; it < conv_end; it += NTHREADS) conv_item(CB, CC, CA, cw, it);
}

__device__ __forceinline__ void final_norm(Frame& F, const Args& a) {
    F.tid = opaque_tid(F.wave); F.lane = F.tid & 63;
    const int gw = blockIdx.x * NWAVES + F.wave, NGW = F.G * NWAVES;
    const float* ss = (const float*)(F.ws + WS_ROWSS); const float* gn = a.in[I_NFIN];
    const bf16_t* XB = (const bf16_t*)(F.ws + WS_XBF);
    for (int r = gw; r < MTOK; r += NGW) {
        const float rs = row_rs(ss, r);
        u32x2 hv[4];
#pragma unroll
        for (int j = 0; j < 4; ++j) hv[j] = *(const u32x2*)(XB + (size_t)r * DM + 256 * j + 4 * F.lane);
        f32x4* xr = (f32x4*)(a.out + (size_t)r * DM) + F.lane; const f32x4* gp = (const f32x4*)gn + F.lane;
#pragma unroll
        for (int j = 0; j < 4; ++j) { const f32x4 gg = gp[64 * j]; f32x4 v; v[0] = bflo(hv[j].x); v[1] = bfhi(hv[j].x); v[2] = bflo(hv[j].y); v[3] = bfhi(hv[j].y);
            xr[64 * j] = v * rs * gg; }
    }
}

#ifndef REP_INPROJ
#define REP_INPROJ 1
#endif
#ifndef REP_MIXERS
#define REP_MIXERS 1
#endif
#ifndef REP_FFNIN
#define REP_FFNIN 1
#endif
#ifndef REP_BAR
#define REP_BAR 1
#endif
#ifndef REP_MIXO
#define REP_MIXO 1
#endif
#ifndef REP_FFNOUT
#define REP_FFNOUT 1
#endif
#ifndef REP_MERGE
#define REP_MERGE 1
#endif
#define RUN_GEMM(g, S, E, acc, fresh) pg8::gemm_phase<decltype(E), true, true, pg8::NoHook>(F.lds, g, S, E, acc, fresh, pg8::NoHook{}, F.wave)
__global__ void __launch_bounds__(NTHREADS, 2) fwd_kernel(Args args) {
    extern __shared__ __attribute__((aligned(16))) unsigned char lds[];
    Frame F;
    F.lds = (LAS unsigned char*)lds; F.tid = threadIdx.x; F.lane = F.tid & 63; F.wave = __builtin_amdgcn_readfirstlane(F.tid >> 6); F.G = gridDim.x; F.ws = args.ws;
    const int lo = args.ph_lo, hi = args.ph_hi;
#define IN(k) (lo <= (k) && (k) < hi)
#define SEAM(k) do { if (IN(k) && IN((k) + 1)) { for (int rb_ = 0; rb_ < REP_BAR; ++rb_) xcd_barrier(bar); } } while (0)
#define SEAM_X(k) do { if (IN(k) && IN((k) + 1)) { for (int rb_ = 0; rb_ < REP_BAR; ++rb_) xcd_barrier(bar, 1); } } while (0)
#define SEAM_G(k) do { if (IN(k) && IN((k) + 1)) { for (int rb_ = 0; rb_ < REP_BAR; ++rb_) xcd_barrier(bar, 2); } } while (0)
#define REPEAT(n) for (int rep_ = 0; rep_ < (n); ++rep_, (rep_ < (n) ? xcd_barrier(bar) : (void)0))
    for (int u = F.tid; u < (LDS_BYTES - RING_BYTES) / 4; u += NTHREADS) ((LAS unsigned*)(F.lds + RING_BYTES))[u] = 0u;
    __syncthreads();
    XcdBarrier bar; bar.bar = (unsigned*)(args.ws + WS_CTL) + 4096; bar.x = 0; bar.st = (volatile LAS unsigned*)(F.lds + MISC_OFF); bar.wave = F.wave;
    if (hi - lo > 1) bar = xcd_barrier_post((unsigned*)(args.ws + WS_CTL) + 4096, (volatile LAS unsigned*)(F.lds + MISC_OFF), F.wave);
    unsigned char* ws0 = args.ws;
    unsigned* xcc_tbl = (unsigned*)(args.ws + WS_CTL) + 1024;
    if (hi - lo > 1 && xb_thread0(F.wave)) __hip_atomic_store(&xcc_tbl[blockIdx.x], xb_xcc_id() + 1u, __ATOMIC_RELAXED, __HIP_MEMORY_SCOPE_AGENT);
    const int gwave = blockIdx.x * NWAVES + F.wave, ngwave = F.G * NWAVES;
    { AMP_BEGIN(0); if (IN(0)) { prep_global(F, args); prep_weights(F, args, 0, 0, N_WITEMS, gwave, ngwave); } AMP_END(0); }
    SEAM(0);
    if (IN(0) && IN(1) && F.G == 256 && lo == 0 && hi == N_PHASES) {
        const int ln = (int)__builtin_amdgcn_mbcnt_hi(~0u, __builtin_amdgcn_mbcnt_lo(~0u, 0u));
        const unsigned head = __hip_atomic_load(&xcc_tbl[ln & 7], __ATOMIC_RELAXED, __HIP_MEMORY_SCOPE_AGENT);
        bool ok = head != 0u;
#pragma unroll
        for (int k = 0; k < 4; ++k) ok = ok && (__hip_atomic_load(&xcc_tbl[64 * k + ln], __ATOMIC_RELAXED, __HIP_MEMORY_SCOPE_AGENT) == head);
        bar.local_ok = __builtin_amdgcn_readfirstlane((int)(__builtin_amdgcn_ballot_w64(ok) == ~0ull)) != 0;
    }
    if (IN(1)) { prep_ssm(F, args, 0, (int)blockIdx.x, F.G); __syncthreads(); }
    SEAM(1);

#pragma unroll 1
    for (int l = 0; l < DEPTH; ++l) {
        const int pb = PH_L0 + l * PH_PER_LAYER;
        unsigned char* ws = ws0; asm volatile("" : "+s"(ws));
        bf16_t* W = (bf16_t*)(ws + WS_W + (size_t)(l & 1) * W_BUF);
        bf16_t* XB = (bf16_t*)(ws + WS_XBF);
        float* ROWSS = (float*)(ws + WS_ROWSS);
        bf16_t* Q = (bf16_t*)(ws + WS_Q); bf16_t* Kb = (bf16_t*)(ws + WS_K); bf16_t* Vb = (bf16_t*)(ws + WS_V);
        bf16_t* CB = (bf16_t*)(ws + WS_CB); bf16_t* CC = (bf16_t*)(ws + WS_ZC); bf16_t* U = (bf16_t*)(ws + WS_U);
        bf16_t* MG = (bf16_t*)(ws + WS_MG); bf16_t* Z = (bf16_t*)(ws + WS_Z);
        bf16_t* GT = (bf16_t*)(ws + WS_GT); bf16_t* HD = (bf16_t*)(ws + WS_HD);
        bf16_t* AO = (bf16_t*)(ws + WS_AO); bf16_t* YS = (bf16_t*)(ws + WS_YS); bf16_t* CA = (bf16_t*)(ws + WS_CA);
        int bid = blockIdx.x, Gv = F.G; asm volatile("" : "+s"(bid), "+s"(Gv));
        const bool split = (Gv == 256) && IN(pb + 2) && IN(pb + 3);
        AMP_BEGIN(1);
        if (IN(pb + 0)) {
            pg8::Gemm g{XB, XB, XB, W + WO_IN, W + WO_IN, W + WO_IN, DM, 0}; pg8::StaticOrder S; S.init(MTOK, INCOLS, F.G, (int)blockIdx.x, 1);
            pg8::EpiInProj E{ROWSS, (const float*)(ws + WS_ROPE), (const float*)(ws + WS_ROPE) + SEQ * 8, args.in[I_BGATE] + l * 3072, Q, Kb, Vb, CB, CC, U, GT};
            if (bar.local_ok && l > 0) xb_await(bar, XB_WCNT, 128u * (unsigned)l);
            if (l + 1 < DEPTH) { if (Gv == 256) { if (bid >= 192) { if (bar.local_ok) xb_await(bar, XB_DONE, 256u * (unsigned)l); prep_ssm(F, args, l + 1, bid - 192, 64); __syncthreads(); if (bar.local_ok) xb_signal(bar, XB_SCNT); } } else { prep_ssm(F, args, l + 1, bid, Gv); __syncthreads(); } }
            REPEAT(REP_INPROJ) { pg8::Acc acc; RUN_GEMM(g, S, E, acc, true); }
        }
        AMP_END(1);
        SEAM_X(pb + 0);
        AMP_BEGIN(2);
        if (IN(pb + 1)) { if (bar.local_ok && l > 0) xb_await(bar, XB_SCNT, 64u * (unsigned)l);
            REPEAT(REP_MIXERS) { mixers_phase(F, args, l, !split); } }
        AMP_END(2);
        SEAM_X(pb + 1);
#define GLU_UNITS() do { \
            {     \
                pg8::Gemm g{YS, YS, YS, W + WO_GLU, W + WO_GLU, W + WO_GLU, 512, 0}; pg8::StaticOrder S; S.init(MTOK, 512, F.G, (int)blockIdx.x, 1); \
                pg8::EpiGlu E{nullptr, YS, Z}; \
                pg8::Acc acc; RUN_GEMM(g, S, E, acc, true); \
            } \
            if (split) { if (bid >= 128) { conv_phase(F, args, l, (bid & 7) * 16 + (((bid >> 3) & 7) * 2 + ((bid - 128) >> 6)), 128);        __syncthreads(); } }     \
            } while (0)
        if (split) REPEAT(REP_MERGE) {
            { AMP_BEGIN(3); GLU_UNITS(); AMP_END(3); }
            AMP_BEGIN(4);
            pg8::Gemm g{AO, CA, Z, W + WO_AO, W + WO_CO, W + WO_SO, 512, 0}; pg8::StaticOrder S; S.init(MTOK, DM, F.G, (int)blockIdx.x, 3);
            pg8::EpiMerge E{nullptr, GT, MG, 0};
            const BarrierHook H{&bar, 1};
            pg8::Acc acc; pg8::gemm_phase<pg8::EpiMerge, true, true, BarrierHook>(F.lds, g, S, E, acc, true, H, F.wave);
            AMP_END(4);
        } else {
            if (IN(pb + 2)) GLU_UNITS();
            SEAM(pb + 2);
            if (IN(pb + 3)) {
                pg8::Gemm g{AO, CA, Z, W + WO_AO, W + WO_CO, W + WO_SO, 512, 0}; pg8::StaticOrder S; S.init(MTOK, DM, F.G, (int)blockIdx.x, 3);
                pg8::EpiMerge E{nullptr, GT, MG, 0};
                pg8::Acc acc; RUN_GEMM(g, S, E, acc, true);
            }
        }
#undef GLU_UNITS
        SEAM_G(pb + 3);
        AMP_BEGIN(5);
        if (IN(pb + 4)) {
            pg8::Gemm g{MG, MG, MG, W + WO_MIX, W + WO_MIX, W + WO_MIX, DM, 0}; pg8::StaticOrder S; S.init(MTOK, DM, F.G, (int)blockIdx.x, 1);
            REPEAT(REP_MIXO) { pg8::EpiResid E{nullptr, args.in[I_X], XB, ROWSS + (size_t)MTOK * 16, l == 0 && rep_ == 0, rep_ + 1 < REP_MIXO}; pg8::Acc acc; RUN_GEMM(g, S, E, acc, true); }
        }
        AMP_END(5);
        SEAM_G(pb + 4);
        AMP_BEGIN(6);
        if (IN(pb + 5)) {
            pg8::Gemm g{XB, XB, XB, W + WO_FI, W + WO_FI, W + WO_FI, DM, 0}; pg8::StaticOrder S; S.init(MTOK, FFN2, F.G, (int)blockIdx.x, 1);
            pg8::EpiFfnIn E{ROWSS + (size_t)MTOK * 16, HD};
            if (l + 1 < DEPTH) {
                if (Gv == 256) { if (bid >= 128) { if (bar.local_ok) xb_await(bar, XB_DONE, 256u * (unsigned)l); prep_weights(F, args, l + 1, 0, N_WITEMS, bid * NWAVES + F.wave - 1024, 1024); __syncthreads(); if (bar.local_ok) xb_signal(bar, XB_WCNT); } } else { prep_weights(F, args, l + 1, 0, N_WITEMS, bid * NWAVES + F.wave, Gv * NWAVES); __syncthreads(); }
            }
            REPEAT(REP_FFNIN) { pg8::Acc acc; RUN_GEMM(g, S, E, acc, true); }
        }
        AMP_END(6);
        SEAM_G(pb + 5);
        AMP_BEGIN(7);
        const bool fuse_final = (l == DEPTH - 1) && IN(pb + 6) && IN(PH_FINAL) && (Gv == 256);
        if (IN(pb + 6)) {
            pg8::Gemm g{HD, HD, HD, W + WO_FO, W + WO_FO, W + WO_FO, FFN, HD_PITCH}; pg8::StaticOrder S; S.init(MTOK, DM, F.G, (int)blockIdx.x, 1);
            if (fuse_final) {
                EpiResidFinal E{nullptr, XB, args.out, ROWSS, args.in[I_NFIN], &bar};
                pg8::Acc acc; RUN_GEMM(g, S, E, acc, true);
            } else {
                REPEAT(REP_FFNOUT) { pg8::EpiResid E{nullptr, args.in[I_X], XB, ROWSS, false, rep_ + 1 < REP_FFNOUT}; pg8::Acc acc; RUN_GEMM(g, S, E, acc, true); }
            }
        }
        AMP_END(7);
        if (!fuse_final) {
            if (bar.local_ok) {
                if (IN(pb + 6) && IN(pb + 7)) { xcd_barrier(bar, 2); if (xb_thread0(F.wave)) (void)xb_add(&bar.bar[XB_DONE], 1u); }
            } else SEAM(pb + 6);
        }
    }
    { AMP_BEGIN(8); const bool final_fused = IN(PH_L0 + (DEPTH - 1) * PH_PER_LAYER + 6) && IN(PH_FINAL) && (F.G == 256); if (IN(PH_FINAL) && !final_fused) final_norm(F, args); AMP_END(8); }
#undef IN
}

extern "C" void kernel_launch(void* const* d_in, const int* in_sizes, int n_in, void* d_out, int out_size, void* d_ws, size_t ws_size, hipStream_t stream) {
    static int grid = 0;
    if (grid == 0) {
        if (n_in != 23 || out_size != MTOK * DM || ws_size < WS_END) { fprintf(stderr, "kernel_launch: unexpected shapes (n_in %d out %d ws %zu)\n", n_in, out_size, ws_size); grid = -1; return; }
        if (hipFuncSetAttribute((const void*)fwd_kernel, hipFuncAttributeMaxDynamicSharedMemorySize, LDS_BYTES) != hipSuccess) { fprintf(stderr, "hipFuncSetAttribute failed\n"); grid = -1; return; }
        int dev = 0, cus = 0, per_cu = 0; (void)hipGetDevice(&dev); (void)hipDeviceGetAttribute(&cus, hipDeviceAttributeMultiprocessorCount, dev);
        if (hipOccupancyMaxActiveBlocksPerMultiprocessor(&per_cu, (const void*)fwd_kernel, NTHREADS, LDS_BYTES) != hipSuccess || per_cu < 1) { fprintf(stderr, "occupancy query failed (%d)\n", per_cu); (void)hipGetLastError(); per_cu = 1; }
        grid = cus > 0 ? cus : 256;
    }
    if (grid < 0) return;
    (void)hipMemsetAsync((char*)d_ws, 0, ZERO_BYTES, stream);
    Args a{};
    for (int i = 0; i < 23; ++i) a.in[i] = (const float*)d_in[i];
    a.out = (float*)d_out; a.ws = (unsigned char*)d_ws;
#if N_LAUNCH_MODE == 1
    a.ph_lo = 0; a.ph_hi = N_PHASES; a.li = 0;
    void* kargs[] = {&a};
    hipError_t e = hipLaunchCooperativeKernel((const void*)fwd_kernel, dim3(grid), dim3(NTHREADS), kargs, LDS_BYTES, stream);
    if (e != hipSuccess) fprintf(stderr, "cooperative launch failed: %s (grid %d)\n", hipGetErrorString(e), grid);
#else
    for (int p = 0; p < N_PHASES; ++p) {
        a.ph_lo = p; a.ph_hi = p + 1; a.li = 0;
        hipLaunchKernelGGL(fwd_kernel, dim3(grid), dim3(NTHREADS), LDS_BYTES, stream, a);
    }
#endif
}
```

```cpp
#include <hip/hip_runtime.h>
#include <cstdio>
#include <cstdint>

#ifndef FAST_GEMM
#define FAST_GEMM 1
#endif
#ifndef N_LAUNCH_MODE
#define N_LAUNCH_MODE 1
#endif

#define LAS __attribute__((address_space(3)))
#define GAS __attribute__((address_space(1)))
typedef unsigned short bf16_t;
typedef short bf16x8 __attribute__((ext_vector_type(8)));
typedef float f32x4 __attribute__((ext_vector_type(4)));
typedef float f32x2 __attribute__((ext_vector_type(2)));
typedef unsigned u32x4 __attribute__((ext_vector_type(4)));
typedef unsigned u32x2 __attribute__((ext_vector_type(2)));

constexpr int DM = 1024, BATCH = 8, SEQ = 2048, DEPTH = 4, MTOK = BATCH * SEQ;
constexpr int INCOLS = 5888, FFN = 2816, FFN2 = 5632;
constexpr int C_Q = 0, C_K = 512, C_V = 640, C_CB = 768, C_CC = 1280, C_CX = 1792, C_U = 2304, C_G = 2816;
constexpr float NORM_EPS = 1e-6f;
constexpr float LOG2E = 1.4426950408889634f;
constexpr float QSCALE = 0.125f * LOG2E;

constexpr size_t MiB = 1u << 20;
constexpr size_t WS_CTL = 0;
constexpr size_t ZERO_BYTES = 1 * MiB;
constexpr size_t WS_SSM = 1 * MiB;
constexpr size_t WS_ROPE = 4 * MiB;
constexpr size_t WS_ROWSS = 5 * MiB;
constexpr size_t WS_W = 7 * MiB;
constexpr size_t W_BUF = 34 * MiB;
constexpr size_t WS_XBF = 75 * MiB;
constexpr size_t WS_R1 = 107 * MiB;
constexpr size_t WS_R2 = 195 * MiB;
constexpr size_t WS_R3 = 291 * MiB;
constexpr size_t WS_Q = WS_R1, WS_K = WS_R1 + 16 * MiB, WS_V = WS_R1 + 20 * MiB, WS_CB = WS_R1 + 24 * MiB, WS_ZC = WS_R1 + 40 * MiB, WS_MG = WS_R1 + 56 * MiB;
constexpr size_t WS_GT = WS_R2, WS_HD = WS_R2, WS_U = WS_R3, WS_Z = WS_R3, WS_YS = WS_R3 + 16 * MiB, WS_CA = WS_R3 + 32 * MiB, WS_AO = WS_Q;
constexpr int HD_PITCH = 3072;
constexpr size_t WS_SSMM = 339 * MiB;
constexpr size_t SSMM_BUF = 9 * MiB;
constexpr size_t WS_END = 357 * MiB;
constexpr size_t SM_WY = 0, SM_GT = 6 * MiB, SM_L16 = 8 * MiB;
constexpr size_t WO_IN = 0, WO_AO = WO_IN + (size_t)INCOLS * DM, WO_CO = WO_AO + 1024 * 512, WO_GLU = WO_CO + 1024 * 512, WO_SO = WO_GLU + 512 * 512,
                 WO_MIX = WO_SO + 1024 * 512, WO_FI = WO_MIX + 1024 * 1024, WO_FO = WO_FI + (size_t)FFN2 * DM, WO_END = WO_FO + (size_t)DM * FFN;
static_assert(WO_END * 2 <= 34 * MiB, "weights fit");
constexpr size_t SO_LAM = 0;
constexpr size_t SO_BBAR = 64 * 1024;
constexpr size_t SO_POW = SO_BBAR + 32 * 64 * 16 * 2 * 4;
constexpr size_t SO_LAYER = 768 * 1024;

constexpr int RING_BYTES = 131072;
constexpr int MISC_OFF = RING_BYTES + 320;
constexpr int RSTAB_OFF = RING_BYTES + 4096;
constexpr int LDS_BYTES = 147456;
constexpr int NWAVES = 8, NTHREADS = 512;

__device__ __forceinline__ unsigned f2bf(float f) { unsigned u = __builtin_bit_cast(unsigned, f); return (u + 0x7fffu + ((u >> 16) & 1u)) >> 16; }
typedef __bf16 bf16x2_hw __attribute__((ext_vector_type(2)));
__device__ __forceinline__ unsigned pk2(float lo, float hi) { const f32x2 v = {lo, hi}; const bf16x2_hw b = __builtin_convertvector(v, bf16x2_hw); return __builtin_bit_cast(unsigned, b); }
__device__ __forceinline__ float bf2f(unsigned short b) { return __builtin_bit_cast(float, (unsigned)b << 16); }
__device__ __forceinline__ float bflo(unsigned w) { return __builtin_bit_cast(float, w << 16); }
__device__ __forceinline__ float bfhi(unsigned w) { return __builtin_bit_cast(float, w & 0xffff0000u); }
__device__ __forceinline__ void unpack8(const u32x4 w, float (&v)[8]) { v[0] = bflo(w.x); v[1] = bfhi(w.x); v[2] = bflo(w.y); v[3] = bfhi(w.y); v[4] = bflo(w.z); v[5] = bfhi(w.z); v[6] = bflo(w.w); v[7] = bfhi(w.w); }
__device__ __forceinline__ u32x4 pack8(const float (&v)[8]) { u32x4 w; w.x = pk2(v[0], v[1]); w.y = pk2(v[2], v[3]); w.z = pk2(v[4], v[5]); w.w = pk2(v[6], v[7]); return w; }
__device__ __forceinline__ float sigmoidf_(float x) { return __builtin_amdgcn_rcpf(1.0f + __builtin_amdgcn_exp2f(-LOG2E * x)); }
__device__ __forceinline__ float gelu_tanh(float y) { const float t = (1.5957691216057308f * LOG2E) * (y + 0.044715f * y * y * y); return y * __builtin_amdgcn_rcpf(1.0f + __builtin_amdgcn_exp2f(-t)); }
template <class T> __device__ __forceinline__ T gld(const void* p) { return *(const GAS T*)p; }
template <class T> __device__ __forceinline__ void gst(void* p, const T v) { *(GAS T*)p = v; }
__device__ __forceinline__ float wave_sum(float v) {
#pragma unroll
    for (int o = 1; o < 64; o <<= 1) v += __shfl_xor(v, o);
    return v;
}

#ifndef PROBE_AMP
#define PROBE_AMP -1
#endif
#define AMP_BEGIN(id) unsigned long long amp_t0_##id = 0; if (PROBE_AMP == (id)) amp_t0_##id = __builtin_amdgcn_s_memrealtime()
#define AMP_END(id) do { if (PROBE_AMP == (id)) { const unsigned long long t1_ = __builtin_amdgcn_s_memrealtime(); const unsigned long long tgt_ = t1_ + 3ull * (t1_ - amp_t0_##id); while (__builtin_amdgcn_s_memrealtime() < tgt_) __builtin_amdgcn_s_sleep(8); } } while (0)
__device__ __forceinline__ int opaque_tid(int wave) { unsigned z = 0u; asm volatile("" : "+v"(z)); return wave * 64 + (int)__builtin_amdgcn_mbcnt_hi(~0u, __builtin_amdgcn_mbcnt_lo(~0u, z)); }
__device__ __forceinline__ float row_rs(const float* ss, int row) {
    const f32x4* p = (const f32x4*)(ss + (size_t)row * 16); const f32x4 a = p[0], b = p[1], c = p[2], d = p[3];
    const float t = ((a[0] + a[1]) + (a[2] + a[3])) + ((b[0] + b[1]) + (b[2] + b[3])) + (((c[0] + c[1]) + (c[2] + c[3])) + ((d[0] + d[1]) + (d[2] + d[3])));
    return __builtin_amdgcn_rsqf(t * (1.0f / DM) + NORM_EPS);
}
namespace pg8 {
constexpr int BM = 256, BK = 64, HALF = 128, HTB = HALF * BK * 2, STAGE_BYTES = 8 * HTB, NXCD = 8, WGM = 8;
struct Unit { int pm, pn, seg; };
struct Gemm { const bf16_t* A0; const bf16_t* A1; const bf16_t* A2; const bf16_t* B0; const bf16_t* B1; const bf16_t* B2; int K; int lda; };
__device__ __forceinline__ const bf16_t* sel3(const bf16_t* p0, const bf16_t* p1, const bf16_t* p2, int s) {
    unsigned long long a = (unsigned long long)p0, b = (unsigned long long)p1, c = (unsigned long long)p2;
    asm volatile("" : "+s"(a), "+s"(b), "+s"(c));
    return (const bf16_t*)(s == 0 ? a : (s == 1 ? b : c)); }
__device__ __forceinline__ const bf16_t* selA(const Gemm& g, int s) { return sel3(g.A0, g.A1, g.A2, s); }
__device__ __forceinline__ const bf16_t* selB(const Gemm& g, int s) { return sel3(g.B0, g.B1, g.B2, s); }

struct StaticOrder {
    int nM, nN, nwg, G, c, nseg;
    __device__ void init(int M, int N, int G_, int c_, int nseg_) { nM = M / BM; nN = N / BM; nwg = nM * nN; G = G_; c = c_; nseg = nseg_; }
    __device__ bool next(int i, Unit& u) const {
        const int ti = i / nseg; u.seg = i - ti * nseg;
        const long L = (long)ti * G + c; if (L >= nwg) return false;
        int wgid = (int)L; { const int q = nwg / NXCD, r = nwg % NXCD, xcd = wgid % NXCD, off = wgid / NXCD; wgid = (xcd < r ? xcd * (q + 1) : r * (q + 1) + (xcd - r) * q) + off; }
        const int nig = WGM * nN, gid = wgid / nig, fm = gid * WGM, gsz = (nM - fm) < WGM ? (nM - fm) : WGM;
        u.pm = fm + ((wgid % nig) % gsz); u.pn = (wgid % nig) / gsz; return true;
    }
};

typedef f32x4 Acc[2][2][4][2];

struct EpiInProj {
    static constexpr bool NEEDS_RS = true;
    const float* rowss; const float* ropec; const float* ropes; const float* bgate;
    bf16_t *Q, *Kb, *Vb, *CB, *ZC, *U, *Gt;
    static constexpr int NSTORE = 16;
    __device__ __forceinline__ bool operator()(Acc& acc, const Unit& u, int wr, int wc, int fr, int fq, const LAS float* rstab) const {
        const int cl = wc * 32 + 8 * fq;
        const int rowb = u.pm * BM + wr * 64 + fr;
        const LAS float* rsp = rstab + wr * 64 + fr;
        if (u.pn >= 5 && u.pn < 9) {
            bf16_t* p0 = ZC + (size_t)rowb * 512 + (u.pn - 5) * HALF + cl;
#pragma unroll
            for (int ai = 0; ai < 2; ++ai)
#pragma unroll
                for (int m = 0; m < 4; ++m) {
                    const float rs = rsp[ai * HALF + m * 16], rs2 = rs * rs;
                    float v[8];
#pragma unroll
                    for (int e = 0; e < 4; ++e) { v[e] = acc[ai][0][m][0][e] * acc[ai][1][m][0][e] * rs2; v[4 + e] = acc[ai][0][m][1][e] * acc[ai][1][m][1][e] * rs2; }
                    { const u32x4 pz = pack8(v); u32x2 z0; z0.x = pz.x; z0.y = pz.y; u32x2 z1; z1.x = pz.z; z1.y = pz.w;
                      gst<u32x2>(p0 + (ai * HALF + m * 16) * 512, z0); gst<u32x2>(p0 + (ai * HALF + m * 16) * 512 + 4, z1); }
                    asm volatile("" ::: "memory");
                }
            return true;
        }
#pragma unroll
        for (int bj = 0; bj < 2; ++bj) {
            const int colt = u.pn * BM + bj * HALF;
            if (colt >= C_G) {
                const int pl = (u.pn < 19) ? bj : 2, go = (u.pn < 19) ? (u.pn - 11) * HALF : colt - (C_G + 2048);
                bf16_t* p0 = Gt + (size_t)rowb * 3072 + pl * 1024 + go + cl;
                float bg[8];
                { const f32x4 b0 = gld<f32x4>(bgate + pl * 1024 + go + cl), b1 = gld<f32x4>(bgate + pl * 1024 + go + cl + 4);
#pragma unroll
                  for (int e = 0; e < 4; ++e) { bg[e] = -LOG2E * b0[e]; bg[4 + e] = -LOG2E * b1[e]; } }
#pragma unroll
                for (int ai = 0; ai < 2; ++ai)
#pragma unroll
                    for (int m = 0; m < 4; ++m) {
                        const float nrs = -LOG2E * rsp[ai * HALF + m * 16];
                        float v[8];
#pragma unroll
                        for (int e = 0; e < 4; ++e) {
                            v[e] = 1.0f + __builtin_amdgcn_exp2f(fminf(__builtin_fmaf(acc[ai][bj][m][0][e], nrs, bg[e]), 86.f));
                            v[4 + e] = 1.0f + __builtin_amdgcn_exp2f(fminf(__builtin_fmaf(acc[ai][bj][m][1][e], nrs, bg[4 + e]), 86.f));
                        }
                        gst<u32x4>(p0 + (ai * HALF + m * 16) * 3072, pack8(v));
                        asm volatile("" ::: "memory");
                    }
            } else {
                bf16_t* p0; int pitch; float scale = 1.0f; bool rope = false;
                if (colt < C_K) { p0 = Q + (size_t)rowb * 512 + colt + cl; pitch = 512; scale = QSCALE; rope = (wc & 1) == 0; }
                else if (colt < C_V) { p0 = Kb + (size_t)rowb * 128 + cl; pitch = 128; rope = (wc & 1) == 0; }
                else if (colt < C_CB) { p0 = Vb + (size_t)rowb * 128 + cl; pitch = 128; }
                else if (colt < C_CC) { p0 = CB + (size_t)rowb * 512 + (colt - C_CB) + cl; pitch = 512; }
                else { const int cu = (colt - C_U) + cl; p0 = U + (size_t)(cu >> 4) * SEQ * 16 + (cu & 15) + ((size_t)(rowb >> 11) * 32 * SEQ + (rowb & (SEQ - 1))) * 16; pitch = 16; }
                if (rope) {
                    const float sgn = (fq == 0) ? -1.f : 1.f;
#pragma unroll
                    for (int ai = 0; ai < 2; ++ai)
#pragma unroll
                        for (int m = 0; m < 4; ++m) {
                            const float rs = rsp[ai * HALF + m * 16] * scale;
                            const int pos = (rowb + ai * HALF + m * 16) & (SEQ - 1);
                            const f32x4 c0 = gld<f32x4>(ropec + pos * 8), c1 = gld<f32x4>(ropec + pos * 8 + 4);
                            const f32x4 s0 = gld<f32x4>(ropes + pos * 8), s1 = gld<f32x4>(ropes + pos * 8 + 4);
                            float v[8];
#pragma unroll
                            for (int e = 0; e < 4; ++e) { v[e] = acc[ai][bj][m][0][e] * rs; v[4 + e] = acc[ai][bj][m][1][e] * rs; }
#pragma unroll
                            for (int e = 0; e < 8; ++e) {
                                const float p = __shfl_xor(v[e], 16);
                                const float cs = e < 4 ? c0[e & 3] : c1[e & 3], sn = e < 4 ? s0[e & 3] : s1[e & 3];
                                const float r = v[e] * cs + sgn * p * sn;
                                v[e] = (fq < 2) ? r : v[e];
                            }
                            gst<u32x4>(p0 + (ai * HALF + m * 16) * pitch, pack8(v));
                            asm volatile("" ::: "memory");
                        }
                } else {
#pragma unroll
                    for (int ai = 0; ai < 2; ++ai)
#pragma unroll
                        for (int m = 0; m < 4; ++m) {
                            const float rs = rsp[ai * HALF + m * 16] * scale;
                            float v[8];
#pragma unroll
                            for (int e = 0; e < 4; ++e) { v[e] = acc[ai][bj][m][0][e] * rs; v[4 + e] = acc[ai][bj][m][1][e] * rs; }
                            gst<u32x4>(p0 + (ai * HALF + m * 16) * pitch, pack8(v));
                            asm volatile("" ::: "memory");
                        }
                }
            }
        }
        return true;
    }
};

struct EpiGlu {
    static constexpr bool NEEDS_RS = false;
    const float* rowss; const bf16_t* YS; bf16_t* Z;
    static constexpr int NSTORE = 0;
    __device__ __forceinline__ bool operator()(Acc& acc, const Unit& u, int wr, int wc, int fr, int fq, const LAS float*) const {
        const size_t o0 = (size_t)(u.pm * BM + wr * 64 + fr) * 512 + u.pn * BM + wc * 32 + 8 * fq; const bf16_t* yp = YS + o0; bf16_t* zp = Z + o0;
        u32x4 yv[2][4][2];
#pragma unroll
        for (int ai = 0; ai < 2; ++ai)
#pragma unroll
            for (int m = 0; m < 4; ++m)
#pragma unroll
                for (int bj = 0; bj < 2; ++bj) yv[ai][m][bj] = gld<u32x4>(yp + (ai * HALF + m * 16) * 512 + bj * HALF);
#pragma unroll
        for (int ai = 0; ai < 2; ++ai) {
#pragma unroll
            for (int m = 0; m < 4; ++m)
#pragma unroll
                for (int bj = 0; bj < 2; ++bj) {
                    float y[8]; unpack8(yv[ai][m][bj], y);
                    float v[8];
#pragma unroll
                    for (int e = 0; e < 4; ++e) { v[e] = y[e] * sigmoidf_(acc[ai][bj][m][0][e]); v[4 + e] = y[4 + e] * sigmoidf_(acc[ai][bj][m][1][e]); }
                    gst<u32x4>(zp + (ai * HALF + m * 16) * 512 + bj * HALF, pack8(v));
                }
            asm volatile("" ::: "memory");
        }
        return true;
    }
};

struct EpiMerge {
    static constexpr bool NEEDS_RS = false;
    const float* rowss; const bf16_t* Gt; bf16_t* Mg; int seg_base;  static constexpr int NSTORE = 0;
    __device__ __forceinline__ bool operator()(Acc& acc, const Unit& u, int wr, int wc, int fr, int fq, const LAS float*) const {
        const int s = u.seg + seg_base;
        const bf16_t* gp = Gt + (size_t)(u.pm * BM + wr * 64 + fr) * 3072 + u.pn * BM + wc * 32 + 8 * fq;
        const bf16_t* pd = gp + (s == 0 ? 0 : (s == 1 ? 1024 : 2048));
        const bf16_t* pn_ = gp + (s == 0 ? 1024 : 2048);
        bf16_t* mp = Mg + (size_t)(u.pm * BM + wr * 64 + fr) * DM + u.pn * BM + wc * 32 + 8 * fq;
#pragma unroll
        for (int ai = 0; ai < 2; ++ai) {
            u32x4 ga[4][2], gb[4][2];
#pragma unroll
            for (int m = 0; m < 4; ++m)
#pragma unroll
                for (int bj = 0; bj < 2; ++bj) {
                    const size_t o = (size_t)(ai * HALF + m * 16) * 3072 + bj * HALF;
                    gb[m][bj] = gld<u32x4>(pd + o);
                    ga[m][bj] = (s < 2) ? gld<u32x4>(pn_ + o) : gb[m][bj];
                }
#pragma unroll
            for (int m = 0; m < 4; ++m)
#pragma unroll
                for (int bj = 0; bj < 2; ++bj) {
                    float fa[8], fb[8], f[8]; unpack8(ga[m][bj], fa); unpack8(gb[m][bj], fb);
#pragma unroll
                    for (int e = 0; e < 8; ++e) { const float r = __builtin_amdgcn_rcpf(fb[e]); f[e] = (s < 2) ? fa[e] * r : r; }
                    if (s < 2) {
#pragma unroll
                        for (int e = 0; e < 4; ++e) { acc[ai][bj][m][0][e] *= f[e]; acc[ai][bj][m][1][e] *= f[4 + e]; }
                    } else {
                        float v[8];
#pragma unroll
                        for (int e = 0; e < 4; ++e) { v[e] = acc[ai][bj][m][0][e] * f[e]; v[4 + e] = acc[ai][bj][m][1][e] * f[4 + e]; }
                        gst<u32x4>(mp + (size_t)(ai * HALF + m * 16) * DM + bj * HALF, pack8(v));
                    }
                }
            asm volatile("" ::: "memory");
        }
        return s == 2;
    }
};

struct EpiResid {
    static constexpr bool NEEDS_RS = false;
    const float* rowss; const float* Xin; bf16_t* XB; float* ss_next; bool first; bool dry;  static constexpr int NSTORE = 0;
    __device__ __forceinline__ void row_group(Acc& acc, const int ai, const int m, const float (&xo0)[8], const float (&xo1)[8], bf16_t* xb0, const int row0, const int pn, const int wc, const int fq) const {
        float ssq = 0.f;
#pragma unroll
        for (int bj = 0; bj < 2; ++bj) {
            float v[8];
#pragma unroll
            for (int e = 0; e < 4; ++e) { const float a0 = bj ? xo1[e] : xo0[e], a1 = bj ? xo1[4 + e] : xo0[4 + e]; v[e] = dry ? a0 : a0 + acc[ai][bj][m][0][e]; v[4 + e] = dry ? a1 : a1 + acc[ai][bj][m][1][e]; }
#pragma unroll
            for (int e = 0; e < 8; ++e) ssq += v[e] * v[e];
            gst<u32x4>(xb0 + (size_t)(ai * HALF + m * 16) * DM + bj * HALF, pack8(v));
        }
        ssq += __shfl_xor(ssq, 16); ssq += __shfl_xor(ssq, 32);
        if (fq == 0) gst<float>(ss_next + (size_t)(row0 + ai * HALF + m * 16) * 16 + pn * 4 + wc, ssq);
    }
    __device__ __forceinline__ bool operator()(Acc& acc, const Unit& u, int wr, int wc, int fr, int fq, const LAS float*) const {
        const int row0 = u.pm * BM + wr * 64 + fr, col0 = u.pn * BM + wc * 32 + 8 * fq;
        bf16_t* xb0 = XB + (size_t)row0 * DM + col0; const float* xi0 = Xin + (size_t)row0 * DM + col0;
        if (first) {
#pragma unroll
            for (int ai = 0; ai < 2; ++ai)
#pragma unroll
            for (int mh = 0; mh < 2; ++mh) {
                f32x4 xv[4][2][2];
#pragma unroll
                for (int m = 2 * mh; m < 2 * mh + 2; ++m)
#pragma unroll
                    for (int bj = 0; bj < 2; ++bj) { const float* xp = xi0 + (size_t)(ai * HALF + m * 16) * DM + bj * HALF; xv[m][bj][0] = __builtin_nontemporal_load((const GAS f32x4*)xp); xv[m][bj][1] = __builtin_nontemporal_load((const GAS f32x4*)(xp + 4)); }
#pragma unroll
                for (int m = 2 * mh; m < 2 * mh + 2; ++m) {
                    float x0[8], x1[8];
#pragma unroll
                    for (int e = 0; e < 4; ++e) { x0[e] = xv[m][0][0][e]; x0[4 + e] = xv[m][0][1][e]; x1[e] = xv[m][1][0][e]; x1[4 + e] = xv[m][1][1][e]; }
                    row_group(acc, ai, m, x0, x1, xb0, row0, u.pn, wc, fq);
                }
                asm volatile("" ::: "memory");
            }
        } else {
#pragma unroll
            for (int ai = 0; ai < 2; ++ai) {
                u32x4 xv[4][2];
#pragma unroll
                for (int m = 0; m < 4; ++m)
#pragma unroll
                    for (int bj = 0; bj < 2; ++bj) xv[m][bj] = gld<u32x4>(xb0 + (size_t)(ai * HALF + m * 16) * DM + bj * HALF);
#pragma unroll
                for (int m = 0; m < 4; ++m) {
                    float x0[8], x1[8]; unpack8(xv[m][0], x0); unpack8(xv[m][1], x1);
                    row_group(acc, ai, m, x0, x1, xb0, row0, u.pn, wc, fq);
                }
                asm volatile("" ::: "memory");
            }
        }
        return true;
    }
};

struct EpiFfnIn {
    static constexpr bool NEEDS_RS = true;
    const float* rowss; bf16_t* H;
    static constexpr int NSTORE = 8;
    __device__ __forceinline__ bool operator()(Acc& acc, const Unit& u, int wr, int wc, int fr, int fq, const LAS float* rstab) const {
        bf16_t* p0 = H + (size_t)(u.pm * BM + wr * 64 + fr) * HD_PITCH + u.pn * HALF + wc * 32 + 8 * fq;
        const LAS float* rsp = rstab + wr * 64 + fr;
#pragma unroll
        for (int ai = 0; ai < 2; ++ai)
#pragma unroll
            for (int m = 0; m < 4; ++m) {
                const float rs = rsp[ai * HALF + m * 16], nrs = -LOG2E * rs, rs2 = rs * rs;
                float v[8];
#pragma unroll
                for (int n = 0; n < 2; ++n)
#pragma unroll
                    for (int e = 0; e < 4; ++e) {
                        const float g = acc[ai][0][m][n][e], up = acc[ai][1][m][n][e];
                        v[4 * n + e] = (g * up * rs2) * __builtin_amdgcn_rcpf(1.0f + __builtin_amdgcn_exp2f(g * nrs));
                    }
                gst<u32x4>(p0 + (ai * HALF + m * 16) * HD_PITCH, pack8(v));
                asm volatile("" ::: "memory");
            }
        return true;
    }
};


__host__ __device__ __forceinline__ int lds_byte(int r, int c) { const int st = (r >> 4) * 2 + (c >> 5), rr = r & 15, cc = c & 31, ob = rr * 64 + cc * 2; return st * 1024 + (ob ^ (((ob >> 9) & 1) << 5)); }
__host__ __device__ __forceinline__ void stage_rc(int b, int& R, int& C) { const int st = b / 1024, sb = b % 1024, swz = sb ^ (((sb >> 9) & 1) << 5); R = (st >> 1) * 16 + swz / 64; C = (st & 1) * 32 + (swz % 64) / 2; }
__host__ __device__ __forceinline__ int perm32(int rho) { const int n = rho >> 4, i = rho & 15; return 8 * (i >> 2) + 4 * n + (i & 3); }

struct NoHook { __device__ __forceinline__ void operator()(const Unit&) const {} };
struct Src { __amdgpu_buffer_rsrc_t r; unsigned o; };
__device__ __forceinline__ Src operator+(Src s_, size_t d) { s_.o += (unsigned)d; return s_; }
__device__ __forceinline__ Src make_src(const bf16_t* p, size_t off) { Src s_; s_.r = __builtin_amdgcn_make_buffer_rsrc((void*)p, (short)0, 0x7fffffff, 0x00020000); s_.o = (unsigned)off; return s_; }
template <class Epi, bool ALIGN_EPI, bool SP2, class Hook>
__device__ __forceinline__ void gemm_phase(LAS unsigned char* lds, const Gemm g, const StaticOrder& S, const Epi& E, Acc& acc, const bool fresh, const Hook& H, const int wave_id) {
    const int tid = opaque_tid(wave_id), wid = wave_id, lane = tid & 63, wr = wid >> 2, wc = wid & 3, fr = lane & 15, fq = lane >> 4;
    const int K = g.K, nt = K / BK, lda = g.lda ? g.lda : K;
    unsigned voffA[2], voffB[2];
#pragma unroll
    for (int i = 0; i < 2; ++i) { int R, C; stage_rc(tid * 16 + i * 8192, R, C); const int Rb = (R & ~31) + perm32(R & 31);
        voffA[i] = (unsigned)(R * lda + C) * 2u; voffB[i] = (unsigned)(Rb * K + C) * 2u; }
    const size_t kstep = (size_t)(BK * 2);
    const size_t hstep = (size_t)HALF * K * 2, hstepA = (size_t)HALF * lda * 2;
    const size_t tstep = 2 * hstep, tstepA = 2 * hstepA;
    const unsigned ldsw = (unsigned)wid * 1024u;
    const int aoff = lds_byte(wr * 64 + fr, fq * 8), boff = lds_byte(wc * 32 + fr, fq * 8);
#define PG8_SA(b, h) (((b) * 2 + (h)) * HTB)
#define PG8_SB(b, h) ((4 + (b) * 2 + (h)) * HTB)
#define PG8_STAGE(bufoff, gbase, voff) do { const Src _g = (gbase); _Pragma("unroll") for (int _i = 0; _i < 2; ++_i) \
        __builtin_amdgcn_raw_ptr_buffer_load_lds(_g.r, (LAS unsigned*)(lds + (bufoff) + ldsw + _i * 8192), 16, (voff)[_i], _g.o, 0, 0); } while (0)
#define PG8_LDA(dst, b, h) do { _Pragma("unroll") for (int m = 0; m < 4; ++m) _Pragma("unroll") for (int k = 0; k < 2; ++k) dst[m][k] = *(const LAS bf16x8*)(lds + PG8_SA(b, h) + aoff + m * 2048 + k * 1024); } while (0)
#define PG8_LDB(dst, b, h) do { _Pragma("unroll") for (int n = 0; n < 2; ++n) _Pragma("unroll") for (int k = 0; k < 2; ++k) dst[n][k] = *(const LAS bf16x8*)(lds + PG8_SB(b, h) + boff + n * 2048 + k * 1024); } while (0)
#define PG8_MMA(ai, bj, At, Bt) do { __builtin_amdgcn_s_setprio(1); _Pragma("unroll") for (int m = 0; m < 4; ++m) _Pragma("unroll") for (int n = 0; n < 2; ++n) _Pragma("unroll") for (int k = 0; k < 2; ++k) \
        acc[ai][bj][m][n] = __builtin_amdgcn_mfma_f32_16x16x32_bf16(Bt[n][k], At[m][k], acc[ai][bj][m][n], 0, 0, 0); __builtin_amdgcn_s_setprio(0); } while (0)
#define PG8_WAIT_V(n) asm volatile("s_waitcnt vmcnt(" #n ")" ::: "memory")
#define PG8_WAIT_L(n) asm volatile("s_waitcnt lgkmcnt(" #n ")" ::: "memory")
#define PG8_TRIP_SP2(W12) do { \
            PG8_LDB(B0, 0, 0); PG8_LDB(B1, 0, 1); PG8_SCHED; PG8_LDA(At, 0, 0); PG8_STAGE(PG8_SA(1, 1), a1 + hstepA, voffA); \
            W12; PG8_WAIT_L(0); PG8_BAR; PG8_MMA(0, 0, At, B0); PG8_MMA(0, 1, At, B1); PG8_BAR; PG8_SCHED; \
            PG8_LDA(At, 0, 1); PG8_STAGE(PG8_SB(0, 0), b2, voffB); PG8_STAGE(PG8_SB(0, 1), b2 + hstep, voffB); PG8_STAGE(PG8_SA(0, 0), a2, voffA); \
            W12; PG8_WAIT_L(0); PG8_BAR; PG8_MMA(1, 0, At, B0); PG8_MMA(1, 1, At, B1); PG8_BAR; PG8_SCHED; \
            PG8_LDB(B0, 1, 0); PG8_LDB(B1, 1, 1); PG8_SCHED; PG8_LDA(At, 1, 0); PG8_STAGE(PG8_SA(0, 1), a2 + hstepA, voffA); \
            PG8_WAIT_V(8); PG8_WAIT_L(0); PG8_BAR; PG8_MMA(0, 0, At, B0); PG8_MMA(0, 1, At, B1); PG8_BAR; PG8_SCHED; \
            PG8_LDA(At, 1, 1); PG8_STAGE(PG8_SB(1, 0), b3, voffB); PG8_STAGE(PG8_SB(1, 1), b3 + hstep, voffB); PG8_STAGE(PG8_SA(1, 0), a3, voffA); \
            PG8_WAIT_V(8); PG8_WAIT_L(0); PG8_BAR; PG8_MMA(1, 0, At, B0); PG8_MMA(1, 1, At, B1); PG8_BAR; PG8_SCHED; } while (0)
#define PG8_BAR __builtin_amdgcn_s_barrier()
#define PG8_SCHED __builtin_amdgcn_sched_barrier(0)
    Unit cur, nxt; int ui = 0, rs_pm = -1, t0 = 0;
    if (!S.next(0, cur)) return;
    if (fresh) {
#pragma unroll
        for (int a = 0; a < 2; ++a)
#pragma unroll
            for (int b = 0; b < 2; ++b)
#pragma unroll
                for (int m = 0; m < 4; ++m)
#pragma unroll
                    for (int n = 0; n < 2; ++n) acc[a][b][m][n] = (f32x4){0.f, 0.f, 0.f, 0.f};
    }
    bf16x8 At[4][2], B0[2][2], B1[2][2];
    Src cA = make_src(selA(g, cur.seg), (size_t)cur.pm * tstepA), cB = make_src(selB(g, cur.seg), (size_t)cur.pn * tstep);
    if constexpr (SP2) {
        PG8_STAGE(PG8_SB(0, 0), cB, voffB); PG8_STAGE(PG8_SB(0, 1), cB + hstep, voffB); PG8_STAGE(PG8_SA(0, 0), cA, voffA); PG8_STAGE(PG8_SA(0, 1), cA + hstepA, voffA);
        if (wr == 1) PG8_BAR;
        PG8_WAIT_V(2); PG8_BAR;
        PG8_STAGE(PG8_SB(1, 0), cB + kstep, voffB); PG8_STAGE(PG8_SA(1, 0), cA + kstep, voffA); PG8_STAGE(PG8_SB(1, 1), cB + hstep + kstep, voffB);
        PG8_WAIT_V(6); PG8_BAR;
    } else {
        PG8_STAGE(PG8_SB(0, 0), cB, voffB); PG8_STAGE(PG8_SA(0, 0), cA, voffA); PG8_STAGE(PG8_SB(0, 1), cB + hstep, voffB); PG8_STAGE(PG8_SA(0, 1), cA + hstepA, voffA);
        if (wr == 1) PG8_BAR;
        PG8_WAIT_V(4); PG8_BAR;
        PG8_STAGE(PG8_SB(1, 0), cB + kstep, voffB); PG8_STAGE(PG8_SA(1, 0), cA + kstep, voffA); PG8_STAGE(PG8_SB(1, 1), cB + hstep + kstep, voffB);
        PG8_WAIT_V(6); PG8_BAR;
    }
    for (;;) {
        const bool has_next = S.next(ui + 1, nxt);
        const Src nA = has_next ? make_src(selA(g, nxt.seg), (size_t)nxt.pm * tstepA) : cA, nB = has_next ? make_src(selB(g, nxt.seg), (size_t)nxt.pn * tstep) : cB;
        for (int t = t0; t < nt; t += 2) {
            const bool last = (t == nt - 2);
            const Src a1 = cA + (size_t)(t + 1) * kstep;
            const Src a2 = last ? nA : cA + (size_t)(t + 2) * kstep, b2 = last ? nB : cB + (size_t)(t + 2) * kstep;
            const Src a3 = a2 + kstep, b3 = b2 + kstep;
            if (last && has_next) H(nxt);
            if constexpr (SP2) {
            PG8_TRIP_SP2(PG8_WAIT_V(8));
            } else {
            PG8_LDB(B0, 0, 0); PG8_SCHED; PG8_LDA(At, 0, 0); PG8_STAGE(PG8_SA(1, 1), a1 + hstepA, voffA);
            PG8_WAIT_L(8); PG8_BAR; PG8_WAIT_L(0); PG8_MMA(0, 0, At, B0); PG8_BAR; PG8_SCHED;
            PG8_LDB(B1, 0, 1); PG8_STAGE(PG8_SB(0, 0), b2, voffB);
            PG8_BAR; PG8_WAIT_L(0); PG8_MMA(0, 1, At, B1); PG8_BAR;
            PG8_LDA(At, 0, 1); PG8_STAGE(PG8_SA(0, 0), a2, voffA);
            PG8_BAR; PG8_WAIT_L(0); PG8_MMA(1, 0, At, B0); PG8_BAR; PG8_SCHED;
            PG8_STAGE(PG8_SB(0, 1), b2 + hstep, voffB);
            PG8_WAIT_V(6); PG8_BAR; PG8_MMA(1, 1, At, B1); PG8_BAR;
            PG8_LDB(B0, 1, 0); PG8_SCHED; PG8_LDA(At, 1, 0); PG8_STAGE(PG8_SA(0, 1), a2 + hstepA, voffA);
            PG8_WAIT_L(8); PG8_BAR; PG8_WAIT_L(0); PG8_MMA(0, 0, At, B0); PG8_BAR; PG8_SCHED;
            PG8_LDB(B1, 1, 1); PG8_STAGE(PG8_SB(1, 0), b3, voffB);
            PG8_BAR; PG8_WAIT_L(0); PG8_MMA(0, 1, At, B1); PG8_BAR;
            PG8_LDA(At, 1, 1); PG8_STAGE(PG8_SA(1, 0), a3, voffA);
            PG8_BAR; PG8_WAIT_L(0); PG8_MMA(1, 0, At, B0); PG8_BAR; PG8_SCHED;
            PG8_STAGE(PG8_SB(1, 1), b3 + hstep, voffB);
            PG8_WAIT_V(6); PG8_BAR; PG8_MMA(1, 1, At, B1); PG8_BAR;
            }
        }
        if constexpr (ALIGN_EPI) { if (wr == 0) PG8_BAR; }
        const int tid_ = opaque_tid(wave_id), fr_ = tid_ & 15, fq_ = (tid_ & 63) >> 4;
        const LAS float* rstab = (const LAS float*)(lds + RSTAB_OFF);
        if (Epi::NEEDS_RS && cur.pm != rs_pm) {
            rs_pm = cur.pm;
            const GAS f32x4* p = (const GAS f32x4*)(E.rowss + (size_t)(cur.pm * BM + (tid_ >> 1)) * 16) + (tid_ & 1) * 2; const f32x4 pa = p[0], pb = p[1];
            float t = ((pa[0] + pa[1]) + (pa[2] + pa[3])) + ((pb[0] + pb[1]) + (pb[2] + pb[3]));
            const float t2 = __shfl_xor(t, 1); t = (tid_ & 1) ? (t2 + t) : (t + t2);
            if ((tid_ & 1) == 0) ((LAS float*)(lds + RSTAB_OFF))[tid_ >> 1] = __builtin_amdgcn_rsqf(t * (1.0f / DM) + NORM_EPS);
            PG8_WAIT_L(0); PG8_BAR;
        }
        AMP_BEGIN(11);
        const bool reset = E(acc, cur, wr, wc, fr_, fq_, rstab);
        AMP_END(11);
        if (!has_next) break;
        if (reset) {
#pragma unroll
            for (int a = 0; a < 2; ++a)
#pragma unroll
                for (int b = 0; b < 2; ++b)
#pragma unroll
                    for (int m = 0; m < 4; ++m)
#pragma unroll
                        for (int n = 0; n < 2; ++n) acc[a][b][m][n] = (f32x4){0.f, 0.f, 0.f, 0.f};
        }
        cur = nxt; cA = nA; cB = nB; ++ui;
        if constexpr (ALIGN_EPI) { if (wr == 1) PG8_BAR; }
        if constexpr (SP2 && Epi::NSTORE > 0) {
            const Src a1 = cA + kstep, a2 = cA + 2 * kstep, b2 = cB + 2 * kstep, a3 = a2 + kstep, b3 = b2 + kstep;
            if constexpr (Epi::NSTORE == 16) PG8_TRIP_SP2(PG8_WAIT_V(24)); else PG8_TRIP_SP2(PG8_WAIT_V(16));
            t0 = 2;
        }
    }
    PG8_WAIT_V(0);
    if constexpr (!ALIGN_EPI) { if (wr == 0) PG8_BAR; }
    PG8_BAR;
#undef PG8_SA
#undef PG8_SB
#undef PG8_STAGE
#undef PG8_LDA
#undef PG8_LDB
#undef PG8_MMA
#undef PG8_WAIT_V
#undef PG8_TRIP_SP2
#undef PG8_WAIT_L
#undef PG8_BAR
#undef PG8_SCHED
}
}


#define XB_TMO      128
#define XB_XCNT(j)  (256  + 64 * (j))
#define XB_XSUB(j)  (1280 + 64 * (j))
#define XB_XGEN(j)  (2304 + 64 * (j))
#define XB_TOP      3328
#define XB_TOPGEN   3392
#define XCD_BAR_WORDS 3456
#define XB_SPIN_CAP (1u << 18)
__device__ __forceinline__ unsigned xb_ld(unsigned* p)              { return __hip_atomic_load(p, __ATOMIC_RELAXED, __HIP_MEMORY_SCOPE_AGENT); }
__device__ __forceinline__ unsigned xb_add(unsigned* p, unsigned v) { return __hip_atomic_fetch_add(p, v, __ATOMIC_RELAXED, __HIP_MEMORY_SCOPE_AGENT); }
__device__ __forceinline__ unsigned xb_xcc_id() { return (unsigned)__builtin_amdgcn_s_getreg((3 << 11) | 20) & 0xFu; }
#define XB_SPIN(cond, bar) do { unsigned _sp = 0; while (cond) { __builtin_amdgcn_s_sleep(1); \
    if ((++_sp & 255u) == 0u) { if (xb_ld(&(bar)[XB_TMO])) break; if (_sp > XB_SPIN_CAP) { atomicAdd(&(bar)[XB_TMO], 1u); break; } } } } while (0)
struct XcdBarrier { unsigned* bar; unsigned x; volatile LAS unsigned* st; int wave; bool local_ok; };
__device__ __forceinline__ bool xb_thread0(int wave) { unsigned z = 0u; asm volatile("" : "+v"(z)); return wave == 0 && __builtin_amdgcn_mbcnt_hi(~0u, __builtin_amdgcn_mbcnt_lo(~0u, z)) == 0u; }
__device__ __forceinline__ XcdBarrier xcd_barrier_post(unsigned* bar, volatile LAS unsigned* st, int wave) {
    XcdBarrier b; b.bar = bar; b.x = xb_xcc_id(); b.st = st; b.wave = wave; b.local_ok = false;
    if (xb_thread0(wave)) (void)xb_add(&bar[XB_XCNT(b.x)], 1u);
    return b;
}
__device__ __forceinline__ void xcd_barrier_complete(unsigned* bar, unsigned x, unsigned& nloc, unsigned& nx) {
    const unsigned G = gridDim.x * gridDim.y * gridDim.z;
    unsigned sum, cnt, mine, sp = 0u;
    for (;;) {
        sum = 0u; cnt = 0u; mine = 0u;
#pragma unroll
        for (unsigned j = 0; j < 16; ++j) { const unsigned c = xb_ld(&bar[XB_XCNT(j)]); sum += c; cnt += (c > 0u) ? 1u : 0u; mine = (j == x) ? c : mine; }
        if (sum == G) break;
        __builtin_amdgcn_s_sleep(1);
        if ((++sp & 255u) == 0u) { if (xb_ld(&bar[XB_TMO])) break; if (sp > XB_SPIN_CAP) { atomicAdd(&bar[XB_TMO], 1u); break; } }
    }
    nloc = mine > 0u ? mine : 1u; nx = cnt > 0u ? cnt : 1u;
}
#define XB_GSUB(g)  (4096 + 64 * (g))
#define XB_GGEN(g)  (8192 + 64 * (g))
__device__ __forceinline__ void xcd_barrier(const XcdBarrier& b, const int scope = 0) {
    const bool xcd_only = scope != 0;
    asm volatile("s_waitcnt vmcnt(0)" ::: "memory");
    __syncthreads();
    if (scope == 2 && b.local_ok) {
        if (xb_thread0(b.wave)) {
            unsigned* bar = b.bar;
            const unsigned g = (blockIdx.x & 7u) * 8u + ((blockIdx.x >> 3) & 7u);
            const unsigned old = xb_add(&bar[XB_GSUB(g)], 1u);
            const unsigned gen = old >> 2;
            if ((old & 3u) == 3u) xb_add(&bar[XB_GGEN(g)], 1u);
            else XB_SPIN(xb_ld(&bar[XB_GGEN(g)]) == gen, bar);
            __builtin_amdgcn_fence(__ATOMIC_ACQUIRE, "agent");
            asm volatile("s_waitcnt vmcnt(0)" ::: "memory");
        }
        __syncthreads();
        return;
    }
    if (xb_thread0(b.wave)) {
        unsigned* bar = b.bar;
        __builtin_amdgcn_s_waitcnt(0);
        unsigned nloc = b.st[0], nx = b.st[1];
        if (nloc == 0u) { xcd_barrier_complete(bar, b.x, nloc, nx); b.st[0] = nloc; b.st[1] = nx; }
        const unsigned old = xb_add(&bar[XB_XSUB(b.x)], 1u);
        const unsigned gen = old / nloc;
        if (old + 1u == (gen + 1u) * nloc) {
            if (!(xcd_only && b.local_ok)) {
                __builtin_amdgcn_fence(__ATOMIC_RELEASE, "agent");
                asm volatile("s_waitcnt vmcnt(0)" ::: "memory");
                const unsigned og = xb_add(&bar[XB_TOP], 1u);
                const unsigned tg = og / nx;
                if (og + 1u == (tg + 1u) * nx) xb_add(&bar[XB_TOPGEN], 1u);
                else XB_SPIN(xb_ld(&bar[XB_TOPGEN]) == tg, bar);
            }
            __builtin_amdgcn_fence(__ATOMIC_ACQUIRE, "agent");
            xb_add(&bar[XB_XGEN(b.x)], 1u);
            asm volatile("s_waitcnt vmcnt(0)" ::: "memory");
        } else {
            XB_SPIN(xb_ld(&bar[XB_XGEN(b.x)]) == gen, bar);
            __builtin_amdgcn_fence(__ATOMIC_ACQUIRE, "agent");
            asm volatile("s_waitcnt vmcnt(0)" ::: "memory");
        }
    }
    __syncthreads();
}

struct BarrierHook { const XcdBarrier* b; int at_seg; __device__ __forceinline__ void operator()(const pg8::Unit& nxt) const { if (nxt.seg == at_seg) xcd_barrier(*b, 2); } };


struct EpiResidFinal {
    static constexpr bool NEEDS_RS = false;
    const float* rowss; const bf16_t* XB; float* OUT; float* ss; const float* gain; const XcdBarrier* bar;
    static constexpr int NSTORE = 0;
    __device__ __forceinline__ bool operator()(pg8::Acc& acc, const pg8::Unit& u, int wr, int wc, int fr, int fq, const LAS float* rstab) const {
        using namespace pg8;
        const int row0 = u.pm * BM + wr * 64 + fr, col0 = u.pn * BM + wc * 32 + 8 * fq;
        const bf16_t* xb0 = XB + (size_t)row0 * DM + col0;
#pragma unroll
        for (int ai = 0; ai < 2; ++ai) {
            u32x4 xv[4][2];
#pragma unroll
            for (int m = 0; m < 4; ++m)
#pragma unroll
                for (int bj = 0; bj < 2; ++bj) xv[m][bj] = gld<u32x4>(xb0 + (size_t)(ai * HALF + m * 16) * DM + bj * HALF);
#pragma unroll
            for (int m = 0; m < 4; ++m) {
                float ssq = 0.f;
#pragma unroll
                for (int bj = 0; bj < 2; ++bj) {
                    float h8[8]; unpack8(xv[m][bj], h8);
                    f32x4 x0, x1;
#pragma unroll
                    for (int e = 0; e < 4; ++e) { x0[e] = h8[e] + acc[ai][bj][m][0][e]; x1[e] = h8[4 + e] + acc[ai][bj][m][1][e]; }
                    acc[ai][bj][m][0] = x0; acc[ai][bj][m][1] = x1;
#pragma unroll
                    for (int e = 0; e < 4; ++e) ssq += x0[e] * x0[e];
#pragma unroll
                    for (int e = 0; e < 4; ++e) ssq += x1[e] * x1[e];
                }
                ssq += __shfl_xor(ssq, 16); ssq += __shfl_xor(ssq, 32);
                if (fq == 0) gst<float>(ss + (size_t)(row0 + ai * HALF + m * 16) * 16 + u.pn * 4 + wc, ssq);
            }
            asm volatile("" ::: "memory");
        }
        xcd_barrier(*bar, 2);
        {
            const int tid_ = ((wr * 4 + wc) * 64) + fq * 16 + fr;
            const GAS f32x4* p = (const GAS f32x4*)(ss + (size_t)(u.pm * BM + (tid_ >> 1)) * 16) + (tid_ & 1) * 2; const f32x4 pa = p[0], pb = p[1];
            float t = ((pa[0] + pa[1]) + (pa[2] + pa[3])) + ((pb[0] + pb[1]) + (pb[2] + pb[3]));
            const float t2 = __shfl_xor(t, 1); t = (tid_ & 1) ? (t2 + t) : (t + t2);
            if ((tid_ & 1) == 0) ((LAS float*)rstab)[tid_ >> 1] = __builtin_amdgcn_rsqf(t * (1.0f / DM) + NORM_EPS);
            asm volatile("s_waitcnt lgkmcnt(0)" ::: "memory"); __builtin_amdgcn_s_barrier(); asm volatile("" ::: "memory");
        }
        float* op0 = OUT + (size_t)row0 * DM + col0;
#pragma unroll
        for (int bj = 0; bj < 2; ++bj) {
            const f32x4 g0 = gld<f32x4>(gain + col0 + bj * HALF), g1 = gld<f32x4>(gain + col0 + bj * HALF + 4);
#pragma unroll
            for (int ai = 0; ai < 2; ++ai)
#pragma unroll
                for (int m = 0; m < 4; ++m) {
                    const float rs = rstab[ai * HALF + wr * 64 + m * 16 + fr];
                    float* op = op0 + (size_t)(ai * HALF + m * 16) * DM + bj * HALF;
                    __builtin_nontemporal_store(acc[ai][bj][m][0] * rs * g0, (GAS f32x4*)op); __builtin_nontemporal_store(acc[ai][bj][m][1] * rs * g1, (GAS f32x4*)(op + 4));
                }
        }
        return true;
    }
};

struct Args { const float* in[23]; float* out; unsigned char* ws; int ph_lo, ph_hi, li, pad; };
enum { I_X = 0, I_NMIX, I_WIN, I_BGATE, I_SINK, I_WAO, I_CONVW, I_WCO, I_ARE, I_AIM, I_BRE, I_BIM, I_CRE, I_CIM, I_SD, I_LOGDT, I_WGLU, I_WSO, I_WMIX, I_NFFN, I_WFI, I_WFO, I_NFIN };
constexpr int PH_PER_LAYER = 7, PH_L0 = 2, PH_FINAL = PH_L0 + DEPTH * PH_PER_LAYER, N_PHASES = PH_FINAL + 1;
constexpr int N_WITEMS = 8576;

struct Frame {
    LAS unsigned char* lds;
    int tid, lane, wave, G;
    unsigned char* ws;
};

__device__ __forceinline__ void transpose_item(const float* W, int K, int N, bf16_t* WT, int kb, int nb, int drow0, const float* kscale, LAS float* scr, int lane) {
    const int k0 = 64 * kb, n0 = 32 * nb, c = lane & 7;
    f32x4 s0 = {1.f, 1.f, 1.f, 1.f}, s1 = {1.f, 1.f, 1.f, 1.f};
    if (kscale) { s0 = *(const f32x4*)(kscale + k0 + 8 * c); s1 = *(const f32x4*)(kscale + k0 + 8 * c + 4); }
    const float* src = W + (size_t)(k0 + (lane >> 5)) * N + n0 + (lane & 31);
    float w[32];
#pragma unroll
    for (int i = 0; i < 32; ++i) w[i] = __builtin_nontemporal_load(src + (size_t)(2 * i) * N);
#pragma unroll
    for (int i = 0; i < 32; ++i) scr[(2 * i + (lane >> 5)) * 33 + (lane & 31)] = w[i];
    asm volatile("s_waitcnt lgkmcnt(0)" ::: "memory");
#pragma unroll
    for (int j = 0; j < 4; ++j) { const int n = (lane >> 3) + 8 * j; const LAS float* s = scr + (8 * c) * 33 + n;
        u32x4 o; o.x = pk2(s[0 * 33] * s0[0], s[1 * 33] * s0[1]); o.y = pk2(s[2 * 33] * s0[2], s[3 * 33] * s0[3]); o.z = pk2(s[4 * 33] * s1[0], s[5 * 33] * s1[1]); o.w = pk2(s[6 * 33] * s1[2], s[7 * 33] * s1[3]);
        *(u32x4*)(WT + (size_t)(drow0 + n) * K + k0 + 8 * c) = o; }
    asm volatile("s_waitcnt lgkmcnt(0)" ::: "memory");
}

__device__ __forceinline__ void prep_global(Frame& F, const Args& a) {
    F.tid = opaque_tid(F.wave); F.lane = F.tid & 63;
    float* rc = (float*)(F.ws + WS_ROPE); float* rsn = rc + SEQ * 8;
    const int gt = blockIdx.x * NTHREADS + F.tid, NT = F.G * NTHREADS;
    for (int i = gt; i < SEQ * 8; i += NT) {
        const int pos = i >> 3, j = i & 7;
        const float invf = (float)exp(-(double)(2 * j) / 16.0 * log(500000.0));
        const float ang = (float)pos * invf;
        double s, c; sincos((double)ang, &s, &c);
        rc[i] = (float)c; rsn[i] = (float)s;
    }
    for (int it = gt; it < DEPTH * 32 * 64 * 17; it += NT) {
        const int i = it / 17, k = it - i * 17;
        const int l = i >> 11, gp = i & 2047, g = gp >> 6;
        const double dt = exp((double)a.in[I_LOGDT][l * 32 + g]);
        const double ar = (double)a.in[I_ARE][i], aim = (double)a.in[I_AIM][i];
        const double mg = exp(ar * dt * k); double s2, c2; sincos(aim * dt * k, &s2, &c2);
        float* pw = (float*)(F.ws + WS_SSM + (size_t)l * SO_LAYER + SO_POW) + (size_t)gp * 34;
        pw[2 * k] = (float)(mg * c2); pw[2 * k + 1] = (float)(mg * s2);
        if (k == 1) {
            const double lr = mg * c2, li = mg * s2;
            const double nr = lr - 1.0, ni = li, den = ar * ar + aim * aim;
            const double cr = (nr * ar + ni * aim) / den, ci = (ni * ar - nr * aim) / den;
            float* lam = (float*)(F.ws + WS_SSM + (size_t)l * SO_LAYER + SO_LAM); float* bb = (float*)(F.ws + WS_SSM + (size_t)l * SO_LAYER + SO_BBAR);
            lam[gp * 2] = (float)lr; lam[gp * 2 + 1] = (float)li;
            const float* bre = a.in[I_BRE] + (size_t)i * 16; const float* bim = a.in[I_BIM] + (size_t)i * 16;
            for (int h = 0; h < 16; ++h) { const double br = bre[h], bi = bim[h]; bb[(gp * 16 + h) * 2] = (float)(cr * br - ci * bi); bb[(gp * 16 + h) * 2 + 1] = (float)(cr * bi + ci * br); }
        }
    }
    const int gw = blockIdx.x * NWAVES + F.wave, NGW = F.G * NWAVES;
    const float* x = a.in[I_X]; bf16_t* xb = (bf16_t*)(F.ws + WS_XBF); float* ss = (float*)(F.ws + WS_ROWSS);
    for (int r0 = gw; r0 < MTOK; r0 += 4 * NGW) {
        f32x4 v[4][4];
#pragma unroll
        for (int q = 0; q < 4; ++q) { const int r = min(r0 + q * NGW, MTOK - 1); const f32x4* xr = (const f32x4*)(x + (size_t)r * DM) + F.lane;
#pragma unroll
            for (int j = 0; j < 4; ++j) v[q][j] = __builtin_nontemporal_load(xr + 64 * j); }
#pragma unroll
        for (int q = 0; q < 4; ++q) {
            const int r = r0 + q * NGW;
            if (r < MTOK) {
                u32x2* ob = (u32x2*)(xb + (size_t)r * DM) + F.lane;
                float s = 0.f;
#pragma unroll
                for (int j = 0; j < 4; ++j) { const f32x4 t = v[q][j]; s += t[0] * t[0] + t[1] * t[1] + t[2] * t[2] + t[3] * t[3]; u32x2 w; w.x = pk2(t[0], t[1]); w.y = pk2(t[2], t[3]); ob[64 * j] = w; }
                s = wave_sum(s);
                if (F.lane < 16) ss[(size_t)r * 16 + F.lane] = (F.lane == 0) ? s : 0.f;
            }
        }
    }
}

__device__ __forceinline__ void prep_weights(Frame& F, const Args& a, int l, int it_lo, int it_hi, int gw, int ngw) {
    F.tid = opaque_tid(F.wave); F.lane = F.tid & 63;
    bf16_t* W = (bf16_t*)(F.ws + WS_W + (size_t)(l & 1) * W_BUF);
    LAS float* scr = (LAS float*)(F.lds + F.wave * 16384);
    const float* w_in = a.in[I_WIN] + (size_t)l * DM * INCOLS; const float* w_ao = a.in[I_WAO] + (size_t)l * 512 * DM; const float* w_co = a.in[I_WCO] + (size_t)l * 512 * DM;
    const float* w_gl = a.in[I_WGLU] + (size_t)l * 512 * 512; const float* w_so = a.in[I_WSO] + (size_t)l * 512 * DM; const float* w_mx = a.in[I_WMIX] + (size_t)l * DM * DM;
    const float* w_fi = a.in[I_WFI] + (size_t)l * DM * FFN2; const float* w_fo = a.in[I_WFO] + (size_t)l * FFN * DM;
    const float* nmix = a.in[I_NMIX] + l * DM; const float* nffn = a.in[I_NFFN] + l * DM;
    constexpr int I0 = 16 * 184, I1 = 8 * 32, I2 = 8 * 32, I3 = 8 * 16, I4 = 8 * 32, I5 = 16 * 32, I6 = 16 * 176, I7 = 44 * 32;
    static_assert(I0 + I1 + I2 + I3 + I4 + I5 + I6 + I7 == N_WITEMS, "weight items");
    for (int it = it_lo + gw; it < it_hi; it += ngw) {
        int r = it;
        if (r < I0) { const int kb = r / 184, nb = r % 184, n0 = 32 * nb; int d0 = n0;
            if (n0 >= C_CC && n0 < C_CX) { const int c = n0 - C_CC; d0 = 256 * (5 + c / 128) + (c % 128); }
            else if (n0 >= C_CX && n0 < C_U) { const int c = n0 - C_CX; d0 = 256 * (5 + c / 128) + 128 + (c % 128); }
            else if (n0 >= C_G && n0 < C_G + 1024) { const int c = n0 - C_G; d0 = 256 * (11 + c / 128) + (c % 128); }
            else if (n0 >= C_G + 1024 && n0 < C_G + 2048) { const int c = n0 - C_G - 1024; d0 = 256 * (11 + c / 128) + 128 + (c % 128); }
            transpose_item(w_in, DM, INCOLS, W + WO_IN, kb, nb, d0, nmix, scr, F.lane); continue; } r -= I0;
        if (r < I1) { const int kb = r / 32, nb = r % 32; transpose_item(w_ao, 512, DM, W + WO_AO, kb, nb, 32 * nb, nullptr, scr, F.lane); continue; } r -= I1;
        if (r < I2) { const int kb = r / 32, nb = r % 32; transpose_item(w_co, 512, DM, W + WO_CO, kb, nb, 32 * nb, nullptr, scr, F.lane); continue; } r -= I2;
        if (r < I3) { const int kb = r / 16, nb = r % 16; transpose_item(w_gl, 512, 512, W + WO_GLU, kb, nb, 32 * nb, nullptr, scr, F.lane); continue; } r -= I3;
        if (r < I4) { const int kb = r / 32, nb = r % 32; transpose_item(w_so, 512, DM, W + WO_SO, kb, nb, 32 * nb, nullptr, scr, F.lane); continue; } r -= I4;
        if (r < I5) { const int kb = r / 32, nb = r % 32; transpose_item(w_mx, DM, DM, W + WO_MIX, kb, nb, 32 * nb, nullptr, scr, F.lane); continue; } r -= I5;
        if (r < I6) { const int kb = r / 176, nb = r % 176; const int n0 = 32 * nb; const int j0 = n0 < FFN ? n0 : n0 - FFN; const int drow0 = 256 * (j0 / 128) + (n0 < FFN ? 0 : 128) + (j0 % 128);
            transpose_item(w_fi, DM, FFN2, W + WO_FI, kb, nb, drow0, nffn, scr, F.lane); continue; } r -= I6;
        { const int kb = r / 32, nb = r % 32; transpose_item(w_fo, FFN, DM, W + WO_FO, kb, nb, 32 * nb, nullptr, scr, F.lane); }
    }
}

__device__ __forceinline__ void prep_ssm(Frame& F, const Args& a, int l, int item_lo, int item_step) {
    F.tid = opaque_tid(F.wave); F.lane = F.tid & 63;
    __syncthreads();
    {
        LAS float* pw = (LAS float*)(F.lds);
        LAS float* cC = pw + 64 * 34;
        LAS float* bB = cC + 16 * 64 * 2;
        LAS float* kd = bB + 64 * 16 * 2;
        unsigned char* smm = F.ws + WS_SSMM + (size_t)(l & 1) * SSMM_BUF;
        bf16_t* WY = (bf16_t*)(smm + SM_WY); bf16_t* GT = (bf16_t*)(smm + SM_GT); float* L16 = (float*)(smm + SM_L16);
        const int tid = F.tid;
        for (int item = item_lo; item < 256; item += item_step) {
            const int g = item >> 3, part = item & 7;
            const float* gpw = (const float*)(F.ws + WS_SSM + (size_t)l * SO_LAYER + SO_POW) + (size_t)g * 64 * 34;
            const float* gbb = (const float*)(F.ws + WS_SSM + (size_t)l * SO_LAYER + SO_BBAR) + (size_t)g * 64 * 32;
            const float* gcr = a.in[I_CRE] + (size_t)(l * 32 + g) * 1024; const float* gci = a.in[I_CIM] + (size_t)(l * 32 + g) * 1024;
            for (int i = tid; i < 64 * 34; i += NTHREADS) pw[i] = gpw[i];
            for (int i = tid; i < 2048; i += NTHREADS) bB[i] = gbb[i];
            for (int i = tid; i < 1024; i += NTHREADS) { cC[2 * i] = gcr[i]; cC[2 * i + 1] = gci[i]; }
            __syncthreads();
            {
                const int dd = tid >> 8, h = (tid >> 4) & 15, h2 = tid & 15, d = 2 * part + dd;
                float a0 = 0.f, a1 = 0.f, a2 = 0.f, a3 = 0.f;
#pragma unroll 4
                for (int p = 0; p < 64; p += 4) {
#pragma unroll
                    for (int u = 0; u < 4; ++u) {
                        const f32x2 c = *(const LAS f32x2*)(cC + (h * 64 + p + u) * 2), w = *(const LAS f32x2*)(pw + (p + u) * 34 + 2 * d), bv = *(const LAS f32x2*)(bB + ((p + u) * 16 + h2) * 2);
                        const float tr = c[0] * w[0] - c[1] * w[1], ti = c[0] * w[1] + c[1] * w[0];
                        const float t = tr * bv[0] - ti * bv[1];
                        if (u == 0) a0 += t; else if (u == 1) a1 += t; else if (u == 2) a2 += t; else a3 += t;
                    }
                }
                float acc = (a0 + a1) + (a2 + a3);
                if (d == 0 && h == h2) acc += a.in[I_SD][l * 512 + g * 16 + h];
                kd[tid] = acc;
            }
            __syncthreads();
            for (int dd = 0; dd < 2; ++dd) {
                const int d = 2 * part + dd, nblk = 16 - d;
                for (int it = tid; it < nblk * 32; it += NTHREADS) {
                    const int bi = it >> 5, r = (it >> 1) & 15, hc = it & 1, tau = d + bi, sI = bi;
                    float v[8];
#pragma unroll
                    for (int j = 0; j < 8; ++j) v[j] = kd[(dd * 16 + r) * 16 + hc * 8 + j];
                    *(u32x4*)(WY + ((size_t)g * 256 + tau * 16 + r) * 384 + sI * 16 + hc * 8) = pack8(v);
                }
            }
            if (tid < 32) { const int r = tid >> 1, hc = tid & 1; unsigned zz = 0u; asm volatile("" : "+v"(zz)); u32x4 z; z.x = zz; z.y = zz; z.z = zz; z.w = zz;
                *(u32x4*)(WY + ((size_t)g * 256 + (2 * part) * 16 + r) * 384 + (2 * part + 1) * 16 + hc * 8) = z; }
            {
                const int r = tid >> 4, kc = tid & 15, n = part * 32 + r, tau = n >> 4, h = n & 15, q = kc * 8; const bool im = q >= 64; const int p0 = im ? q - 64 : q;
                float v[8];
#pragma unroll
                for (int j = 0; j < 8; ++j) { const int p = p0 + j; const float cr = cC[(h * 64 + p) * 2], ci = cC[(h * 64 + p) * 2 + 1], pr = pw[p * 34 + 2 * (tau + 1)], pi = pw[p * 34 + 2 * (tau + 1) + 1];
                    v[j] = im ? -(cr * pi + ci * pr) : (cr * pr - ci * pi); }
                *(u32x4*)(WY + ((size_t)g * 256 + n) * 384 + 256 + q) = pack8(v);
            }
            {
                const int r = tid >> 5, kc = tid & 31, k0 = kc * 8, n = part * 16 + r, sI = k0 >> 4, h0 = k0 & 15, p = n & 63; const bool im = n >= 64;
                const float pr = pw[p * 34 + 2 * (15 - sI)], pi = pw[p * 34 + 2 * (15 - sI) + 1];
                float v[8];
#pragma unroll
                for (int j = 0; j < 8; ++j) { const float br = bB[(p * 16 + h0 + j) * 2], bi = bB[(p * 16 + h0 + j) * 2 + 1]; v[j] = im ? (pr * bi + pi * br) : (pr * br - pi * bi); }
                *(u32x4*)(GT + ((size_t)g * 128 + n) * 256 + k0) = pack8(v);
            }
            if (part == 0 && tid < 64) { L16[(g * 64 + tid) * 2] = pw[tid * 34 + 32]; L16[(g * 64 + tid) * 2 + 1] = pw[tid * 34 + 33]; }
            __syncthreads();
        }
    }
}


typedef float f32x16 __attribute__((ext_vector_type(16)));
constexpr int UX_PITCH = 784, SSM_S_OFF = 64 * UX_PITCH;

constexpr int AT_KPITCH = 144, AT_VPITCH = 520, AT_VT_OFF = 256 * AT_KPITCH;

constexpr int CONVW_OFF = RING_BYTES + 8192;
__device__ __forceinline__ void conv_item(const bf16_t* CB, const bf16_t* ZC, bf16_t* CA, const LAS float* cw, int it) {
    const int row = it >> 6, c0 = (it & 63) * 8, t = row & (SEQ - 1);
    const size_t o = (size_t)row * 512 + c0;
    const size_t o1 = (t >= 1) ? o - 512 : o, o2 = (t >= 2) ? o - 1024 : o;
    const u32x4 vb = *(const u32x4*)(CB + o), vz0 = *(const u32x4*)(ZC + o), vz1 = *(const u32x4*)(ZC + o1), vz2 = *(const u32x4*)(ZC + o2);
    float cb[8], z0[8], z1[8], z2[8];
    unpack8(vb, cb); unpack8(vz0, z0); unpack8(vz1, z1); unpack8(vz2, z2);
    const float m1 = (t >= 1) ? 1.f : 0.f, m2 = (t >= 2) ? 1.f : 0.f;
    float v[8];
#pragma unroll
    for (int e = 0; e < 8; ++e) v[e] = cb[e] * (cw[c0 + e] * (z2[e] * m2) + cw[512 + c0 + e] * (z1[e] * m1) + cw[1024 + c0 + e] * z0[e]);
    *(u32x4*)(CA + o) = pack8(v);
}

template <int NB>
__device__ __forceinline__ void conv_batch(const bf16_t* CB, const bf16_t* ZC, bf16_t* CA, const LAS float* cw, int it0, int stride, int it_end) {
    u32x4 vb[NB], vz[NB][3];
#pragma unroll
    for (int k = 0; k < NB; ++k) {
        const int it = min(it0 + k * stride, it_end - 1);
        const int row = it >> 6, c0 = (it & 63) * 8, t = row & (SEQ - 1);
        const size_t o = (size_t)row * 512 + c0, o1 = (t >= 1) ? o - 512 : o, o2 = (t >= 2) ? o - 1024 : o;
        vb[k] = *(const u32x4*)(CB + o);
        vz[k][0] = *(const u32x4*)(ZC + o); vz[k][1] = *(const u32x4*)(ZC + o1); vz[k][2] = *(const u32x4*)(ZC + o2);
    }
#pragma unroll
    for (int k = 0; k < NB; ++k) {
        const int it = it0 + k * stride;
        if (it < it_end) {
            const int row = it >> 6, c0 = (it & 63) * 8, t = row & (SEQ - 1);
            float cb[8], z0[8], z1[8], z2[8];
            unpack8(vb[k], cb); unpack8(vz[k][0], z0); unpack8(vz[k][1], z1); unpack8(vz[k][2], z2);
            const float m1 = (t >= 1) ? 1.f : 0.f, m2 = (t >= 2) ? 1.f : 0.f;
            float v[8];
#pragma unroll
            for (int e = 0; e < 8; ++e) v[e] = cb[e] * (cw[c0 + e] * (z2[e] * m2) + cw[512 + c0 + e] * (z1[e] * m1) + cw[1024 + c0 + e] * z0[e]);
            *(u32x4*)(CA + (size_t)row * 512 + c0) = pack8(v);
        }
    }
}
__device__ __forceinline__ void conv_phase(Frame& F, const Args& a, int l, int blk, int nblk) {
    F.tid = opaque_tid(F.wave); F.lane = F.tid & 63;
    const bf16_t* CB = (const bf16_t*)(F.ws + WS_CB); const bf16_t* ZC = (const bf16_t*)(F.ws + WS_ZC);
    bf16_t* CA = (bf16_t*)(F.ws + WS_CA);
    LAS float* cw = (LAS float*)(F.lds + CONVW_OFF);
    for (int i = F.tid; i < 1536; i += NTHREADS) cw[i] = a.in[I_CONVW][l * 1536 + i];
    __syncthreads();
    const int per = (MTOK * 64 + nblk - 1) / nblk, lo = blk * per, hi = min(lo + per, MTOK * 64);
    for (int it0 = lo + F.tid; it0 < hi; it0 += 4 * NTHREADS) conv_batch<4>(CB, ZC, CA, cw, it0, NTHREADS, hi);
}

__device__ __forceinline__ void mixers_phase(Frame& F, const Args& a, int l, const bool do_conv) {
    F.tid = opaque_tid(F.wave); F.lane = F.tid & 63;
    const int tid = F.tid, lane = F.lane, wave = F.wave, l31 = lane & 31, hi = lane >> 5;
    const bf16_t* Q = (const bf16_t*)(F.ws + WS_Q); const bf16_t* Kb = (const bf16_t*)(F.ws + WS_K); const bf16_t* Vb = (const bf16_t*)(F.ws + WS_V);
    const bf16_t* CB = (const bf16_t*)(F.ws + WS_CB); const bf16_t* CC = (const bf16_t*)(F.ws + WS_ZC);
    const bf16_t* U = (const bf16_t*)(F.ws + WS_U);
    bf16_t* AO = (bf16_t*)(F.ws + WS_AO); bf16_t* YS = (bf16_t*)(F.ws + WS_YS); bf16_t* CA = (bf16_t*)(F.ws + WS_CA);
    const unsigned char* smm = F.ws + WS_SSMM + (size_t)(l & 1) * SSMM_BUF;
    const bf16_t* WY = (const bf16_t*)(smm + SM_WY); const bf16_t* GT = (const bf16_t*)(smm + SM_GT); const float* L16 = (const float*)(smm + SM_L16);
    LAS unsigned char* kl = F.lds; LAS unsigned char* vt = F.lds + AT_VT_OFF;
    LAS unsigned char* ux = F.lds; LAS float* S = (LAS float*)(F.lds + SSM_S_OFF);
    LAS float* cw = (LAS float*)(F.lds + CONVW_OFF);
    if (do_conv) for (int i = tid; i < 1536; i += NTHREADS) cw[i] = a.in[I_CONVW][l * 1536 + i];
    const int conv_per_blk = (MTOK * 64 + F.G - 1) / F.G;
    int conv_next = do_conv ? blockIdx.x * conv_per_blk : MTOK * 64; const int conv_end = do_conv ? min(conv_next + conv_per_blk, MTOK * 64) : MTOK * 64;
    const int n_units = (BATCH * 32 - (int)blockIdx.x + F.G - 1) / F.G;
    const int conv_per_slot = (conv_per_blk + 2 * n_units - 1) / (2 * n_units);
    for (int unit = blockIdx.x; unit < BATCH * 32; unit += F.G) {
        AMP_BEGIN(9);
        {
            const int b = unit & 7, n = unit >> 4, kvh = (unit >> 3) & 1;
            const int rowq0 = b * SEQ + n * 128, rowk0 = rowq0 - 128;
            const int hq = kvh * 4 + (wave >> 1);
            u32x4 kv[4], vv[4];
#pragma unroll
            for (int i = 0; i < 4; ++i) {
                const int v = tid + i * NTHREADS, key = v >> 3, dc = v & 7;
                const int rk = (n == 0 && key < 128) ? rowq0 : rowk0 + key;
                kv[i] = *(const u32x4*)(Kb + (size_t)rk * 128 + kvh * 64 + dc * 8);
                vv[i] = *(const u32x4*)(Vb + (size_t)rk * 128 + kvh * 64 + dc * 8);
            }
            bf16x8 qf[2][4];
#pragma unroll
            for (int sb = 0; sb < 2; ++sb)
#pragma unroll
                for (int ks = 0; ks < 4; ++ks) qf[sb][ks] = *(const bf16x8*)(Q + (size_t)(rowq0 + (wave & 1) * 64 + sb * 32 + l31) * 512 + hq * 64 + ks * 16 + hi * 8);
            const float sl = a.in[I_SINK][l * 8 + hq] * LOG2E;
#pragma unroll
            for (int i = 0; i < 4; ++i) {
                const int v = tid + i * NTHREADS, key = v >> 3, dc = v & 7;
                *(LAS u32x4*)(kl + key * AT_KPITCH + dc * 16) = kv[i];
                LAS bf16_t* vp = (LAS bf16_t*)(vt + (dc * 8) * AT_VPITCH + key * 2);
                vp[0 * (AT_VPITCH / 2)] = (bf16_t)(vv[i].x & 0xffffu); vp[1 * (AT_VPITCH / 2)] = (bf16_t)(vv[i].x >> 16);
                vp[2 * (AT_VPITCH / 2)] = (bf16_t)(vv[i].y & 0xffffu); vp[3 * (AT_VPITCH / 2)] = (bf16_t)(vv[i].y >> 16);
                vp[4 * (AT_VPITCH / 2)] = (bf16_t)(vv[i].z & 0xffffu); vp[5 * (AT_VPITCH / 2)] = (bf16_t)(vv[i].z >> 16);
                vp[6 * (AT_VPITCH / 2)] = (bf16_t)(vv[i].w & 0xffffu); vp[7 * (AT_VPITCH / 2)] = (bf16_t)(vv[i].w >> 16);
            }
            __syncthreads();
#pragma unroll
            for (int sb = 0; sb < 2; ++sb) {
                const int q0 = (wave & 1) * 64 + sb * 32;
                const size_t qrow = (size_t)(rowq0 + q0 + l31);
                f32x16 sc[5];
#pragma unroll
                for (int kt = 0; kt < 5; ++kt) {
                    f32x16 acc = {};
                    const LAS unsigned char* kp = kl + (q0 + 32 * kt + l31) * AT_KPITCH + hi * 16;
#pragma unroll
                    for (int ks = 0; ks < 4; ++ks) acc = __builtin_amdgcn_mfma_f32_32x32x16_bf16(*(const LAS bf16x8*)(kp + ks * 32), qf[sb][ks], acc, 0, 0, 0);
                    sc[kt] = acc;
                }
                const int dlt = l31 - 4 * hi;
                float mx = -1e30f;
#pragma unroll
                for (int kt = 0; kt < 5; ++kt) {
                    const bool tile_ok = (n > 0) || (q0 + 32 * kt >= 128);
#pragma unroll
                    for (int r = 0; r < 16; ++r) {
                        const int c0 = (r & 3) + 8 * (r >> 2);
                        const bool ok = (kt == 0) ? (tile_ok && c0 > dlt) : ((kt == 4) ? (tile_ok && c0 <= dlt) : tile_ok);
                        const float v = ok ? sc[kt][r] : -1e30f;
                        sc[kt][r] = v; mx = fmaxf(mx, v);
                    }
                }
                mx = fmaxf(mx, __shfl_xor(mx, 32));
                mx = fmaxf(mx, sl);
                float ls = 0.f;
#pragma unroll
                for (int kt = 0; kt < 5; ++kt)
#pragma unroll
                    for (int r = 0; r < 16; ++r) { const float p = __builtin_amdgcn_exp2f(sc[kt][r] - mx); sc[kt][r] = p; ls += p; }
                ls += __shfl_xor(ls, 32);
                ls += __builtin_amdgcn_exp2f(sl - mx);
                f32x16 o0 = {}, o1 = {};
#pragma unroll
                for (int kt = 0; kt < 5; ++kt)
#pragma unroll
                    for (int s2 = 0; s2 < 2; ++s2) {
                        u32x4 pw; pw.x = pk2(sc[kt][8 * s2 + 0], sc[kt][8 * s2 + 1]); pw.y = pk2(sc[kt][8 * s2 + 2], sc[kt][8 * s2 + 3]); pw.z = pk2(sc[kt][8 * s2 + 4], sc[kt][8 * s2 + 5]); pw.w = pk2(sc[kt][8 * s2 + 6], sc[kt][8 * s2 + 7]);
                        const bf16x8 pf = __builtin_bit_cast(bf16x8, pw);
                        const int col = q0 + 32 * kt + 16 * s2 + 4 * hi;
                        const LAS unsigned char* vp0 = vt + l31 * AT_VPITCH + col * 2;
                        const LAS unsigned char* vp1 = vp0 + 32 * AT_VPITCH;
                        const u32x2 a0 = *(const LAS u32x2*)(vp0), a1 = *(const LAS u32x2*)(vp0 + 16);
                        const u32x2 c0 = *(const LAS u32x2*)(vp1), c1 = *(const LAS u32x2*)(vp1 + 16);
                        u32x4 va; va.x = a0.x; va.y = a0.y; va.z = a1.x; va.w = a1.y;
                        u32x4 vc; vc.x = c0.x; vc.y = c0.y; vc.z = c1.x; vc.w = c1.y;
                        o0 = __builtin_amdgcn_mfma_f32_32x32x16_bf16(__builtin_bit_cast(bf16x8, va), pf, o0, 0, 0, 0);
                        o1 = __builtin_amdgcn_mfma_f32_32x32x16_bf16(__builtin_bit_cast(bf16x8, vc), pf, o1, 0, 0, 0);
                    }
                const float inv = __builtin_amdgcn_rcpf(ls);
                bf16_t* op = AO + qrow * 512 + hq * 64 + 4 * hi;
#pragma unroll
                for (int qd = 0; qd < 4; ++qd) {
                    u32x2 w0; w0.x = pk2(o0[4 * qd] * inv, o0[4 * qd + 1] * inv); w0.y = pk2(o0[4 * qd + 2] * inv, o0[4 * qd + 3] * inv);
                    u32x2 w1; w1.x = pk2(o1[4 * qd] * inv, o1[4 * qd + 1] * inv); w1.y = pk2(o1[4 * qd + 2] * inv, o1[4 * qd + 3] * inv);
                    *(u32x2*)(op + 8 * qd) = w0; *(u32x2*)(op + 32 + 8 * qd) = w1;
                }
            }
        }
        AMP_END(9);
        AMP_BEGIN(10);
        {
            const int b = unit & 7, g = unit >> 3;
            const bf16_t* ug = U + (size_t)(b * 32 + g) * SEQ * 16;
            const bf16_t* wy = WY + (size_t)g * 256 * 384; const bf16_t* gt = GT + (size_t)g * 128 * 256;
            u32x4 ur[4];
#pragma unroll
            for (int i = 0; i < 4; ++i) ur[i] = ((const u32x4*)ug)[tid + i * NTHREADS];
            const int rb = wave >> 2, cb = wave & 3;
            float xr = 0.f, xi = 0.f, lr = 0.f, li = 0.f;
            if (wave == 0) { lr = L16[(g * 64 + lane) * 2]; li = L16[(g * 64 + lane) * 2 + 1]; }
            __syncthreads();
#pragma unroll 1
            for (int half = 0; half < 2; ++half) {
                bf16x8 gfr[16];
                { const bf16_t* bp = gt + (size_t)(cb * 32 + l31) * 256 + hi * 8;
#pragma unroll
                  for (int ks = 0; ks < 16; ++ks) gfr[ks] = *(const bf16x8*)(bp + ks * 16); }
#pragma unroll
                for (int i = 0; i < 4; ++i) { const int v = tid + i * NTHREADS, c = v >> 5, kc = v & 31; *(LAS u32x4*)(ux + c * UX_PITCH + kc * 16) = ur[i]; }
                if (half == 0) {
#pragma unroll
                    for (int i = 0; i < 4; ++i) ur[i] = ((const u32x4*)(ug + (size_t)1024 * 16))[tid + i * NTHREADS];
                }
                __syncthreads();
                {
                    f32x16 acc = {};
                    const LAS unsigned char* ap = ux + (rb * 32 + l31) * UX_PITCH + hi * 16;
#pragma unroll
                    for (int ks = 0; ks < 16; ++ks) acc = __builtin_amdgcn_mfma_f32_32x32x16_bf16(*(const LAS bf16x8*)(ap + ks * 32), gfr[ks], acc, 0, 0, 0);
#pragma unroll
                    for (int r = 0; r < 16; ++r) S[(rb * 32 + (r & 3) + 8 * (r >> 2) + 4 * hi) * 128 + cb * 32 + l31] = acc[r];
                }
                bf16x8 afr[24];
                { const bf16_t* ap = wy + (size_t)(wave * 32 + l31) * 384 + hi * 8;
#pragma unroll
                  for (int ks = 0; ks < 24; ++ks) if (ks >= 16 || ks <= 2 * wave + 1) afr[ks] = *(const bf16x8*)(ap + ks * 16); else afr[ks] = (bf16x8){0, 0, 0, 0, 0, 0, 0, 0}; }
                __syncthreads();
                if (wave == 0) {
                    f32x2 X = {xr, xi}; const f32x2 L1 = {lr, lr}, L2 = {-li, li};
                    f32x2 sn[8];
#pragma unroll
                    for (int q = 0; q < 8; ++q) { sn[q][0] = S[q * 128 + lane]; sn[q][1] = S[q * 128 + 64 + lane]; }
#pragma unroll 1
                    for (int c0 = 0; c0 < 64; c0 += 8) {
                        f32x2 sv[8];
#pragma unroll
                        for (int q = 0; q < 8; ++q) sv[q] = sn[q];
                        const int cn = (c0 + 8) & 63;
#pragma unroll
                        for (int q = 0; q < 8; ++q) { sn[q][0] = S[(cn + q) * 128 + lane]; sn[q][1] = S[(cn + q) * 128 + 64 + lane]; }
#pragma unroll
                        for (int q = 0; q < 8; ++q) {
                            const unsigned w = pk2(X[0], X[1]);
                            *(LAS bf16_t*)(ux + (c0 + q) * UX_PITCH + (256 + lane) * 2) = (bf16_t)(w & 0xffffu);
                            *(LAS bf16_t*)(ux + (c0 + q) * UX_PITCH + (320 + lane) * 2) = (bf16_t)(w >> 16);
                            const f32x2 Xs = __builtin_shufflevector(X, X, 1, 0);
                            X = L1 * X + sv[q];
                            X = L2 * Xs + X;
                        }
                    }
                    xr = X[0]; xi = X[1];
                } else {
                    const int slot_end = min(conv_next + conv_per_slot, conv_end);
                    for (int it = conv_next + (tid - 64); it < slot_end; it += NTHREADS - 64) conv_item(CB, CC, CA, cw, it);
                }
                conv_next = min(conv_next + conv_per_slot, conv_end);
                __syncthreads();
                {
                    f32x16 acc0 = {}, acc1 = {};
                    const LAS unsigned char* bp0 = ux + l31 * UX_PITCH + hi * 16;
                    const LAS unsigned char* bp1 = bp0 + 32 * UX_PITCH;
#pragma unroll
                    for (int ks = 0; ks < 24; ++ks) {
                        if (ks < 16 && ks > 2 * wave + 1) continue;
                        const bf16x8 b0 = *(const LAS bf16x8*)(bp0 + ks * 32);
                        const bf16x8 b1 = *(const LAS bf16x8*)(bp1 + ks * 32);
                        acc0 = __builtin_amdgcn_mfma_f32_32x32x16_bf16(afr[ks], b0, acc0, 0, 0, 0);
                        acc1 = __builtin_amdgcn_mfma_f32_32x32x16_bf16(afr[ks], b1, acc1, 0, 0, 0);
                    }
#pragma unroll
                    for (int cbk = 0; cbk < 2; ++cbk) {
                        unsigned wx[4], wy[4];
#pragma unroll
                        for (int q = 0; q < 4; ++q) {
                            float y0, y1, y2, y3;
                            if (cbk == 0) { y0 = acc0[4 * q]; y1 = acc0[4 * q + 1]; y2 = acc0[4 * q + 2]; y3 = acc0[4 * q + 3]; } else { y0 = acc1[4 * q]; y1 = acc1[4 * q + 1]; y2 = acc1[4 * q + 2]; y3 = acc1[4 * q + 3]; }
                            wx[q] = pk2(gelu_tanh(y0), gelu_tanh(y1)); wy[q] = pk2(gelu_tanh(y2), gelu_tanh(y3));
                        }
                        const auto s0x = __builtin_amdgcn_permlane32_swap(wx[0], wx[2], false, false), s0y = __builtin_amdgcn_permlane32_swap(wy[0], wy[2], false, false);
                        const auto s1x = __builtin_amdgcn_permlane32_swap(wx[1], wx[3], false, false), s1y = __builtin_amdgcn_permlane32_swap(wy[1], wy[3], false, false);
                        u32x4 lo4, hi4; lo4.x = s0x[0]; lo4.y = s0y[0]; lo4.z = s0x[1]; lo4.w = s0y[1]; hi4.x = s1x[0]; hi4.y = s1y[0]; hi4.z = s1x[1]; hi4.w = s1y[1];
                        const size_t row = (size_t)b * SEQ + half * 1024 + 16 * (cbk * 32 + l31) + 2 * wave + hi;
                        *(u32x4*)(YS + row * 512 + g * 16) = lo4; *(u32x4*)(YS + row * 512 + g * 16 + 8) = hi4;
                    }
                }
                __syncthreads();
            }
        }
        AMP_END(10);
    }
    for (int it = conv_next + tid; it < conv_end; it += NTHREADS) conv_item(CB, CC, CA, cw, it);
}

__device__ __forceinline__ void final_norm(Frame& F, const Args& a) {
    F.tid = opaque_tid(F.wave); F.lane = F.tid & 63;
    const int gw = blockIdx.x * NWAVES + F.wave, NGW = F.G * NWAVES;
    const float* ss = (const float*)(F.ws + WS_ROWSS); const float* gn = a.in[I_NFIN];
    const bf16_t* XB = (const bf16_t*)(F.ws + WS_XBF);
    for (int r = gw; r < MTOK; r += NGW) {
        const float rs = row_rs(ss, r);
        u32x2 hv[4];
#pragma unroll
        for (int j = 0; j < 4; ++j) hv[j] = *(const u32x2*)(XB + (size_t)r * DM + 256 * j + 4 * F.lane);
        f32x4* xr = (f32x4*)(a.out + (size_t)r * DM) + F.lane; const f32x4* gp = (const f32x4*)gn + F.lane;
#pragma unroll
        for (int j = 0; j < 4; ++j) { const f32x4 gg = gp[64 * j]; f32x4 v; v[0] = bflo(hv[j].x); v[1] = bfhi(hv[j].x); v[2] = bflo(hv[j].y); v[3] = bfhi(hv[j].y);
            xr[64 * j] = v * rs * gg; }
    }
}

#ifndef REP_INPROJ
#define REP_INPROJ 1
#endif
#ifndef REP_MIXERS
#define REP_MIXERS 1
#endif
#ifndef REP_FFNIN
#define REP_FFNIN 1
#endif
#ifndef REP_BAR
#define REP_BAR 1
#endif
#ifndef REP_MIXO
#define REP_MIXO 1
#endif
#ifndef REP_FFNOUT
#define REP_FFNOUT 1
#endif
#ifndef REP_MERGE
#define REP_MERGE 1
#endif
#define RUN_GEMM(g, S, E, acc, fresh) pg8::gemm_phase<decltype(E), true, true, pg8::NoHook>(F.lds, g, S, E, acc, fresh, pg8::NoHook{}, F.wave)
__global__ void __launch_bounds__(NTHREADS, 2) fwd_kernel(Args args) {
    extern __shared__ __attribute__((aligned(16))) unsigned char lds[];
    Frame F;
    F.lds = (LAS unsigned char*)lds; F.tid = threadIdx.x; F.lane = F.tid & 63; F.wave = __builtin_amdgcn_readfirstlane(F.tid >> 6); F.G = gridDim.x; F.ws = args.ws;
    const int lo = args.ph_lo, hi = args.ph_hi;
#define IN(k) (lo <= (k) && (k) < hi)
#define SEAM(k) do { if (IN(k) && IN((k) + 1)) { for (int rb_ = 0; rb_ < REP_BAR; ++rb_) xcd_barrier(bar); } } while (0)
#define SEAM_X(k) do { if (IN(k) && IN((k) + 1)) { for (int rb_ = 0; rb_ < REP_BAR; ++rb_) xcd_barrier(bar, 1); } } while (0)
#define SEAM_G(k) do { if (IN(k) && IN((k) + 1)) { for (int rb_ = 0; rb_ < REP_BAR; ++rb_) xcd_barrier(bar, 2); } } while (0)
#define REPEAT(n) for (int rep_ = 0; rep_ < (n); ++rep_, (rep_ < (n) ? xcd_barrier(bar) : (void)0))
    for (int u = F.tid; u < (LDS_BYTES - RING_BYTES) / 4; u += NTHREADS) ((LAS unsigned*)(F.lds + RING_BYTES))[u] = 0u;
    __syncthreads();
    XcdBarrier bar; bar.bar = (unsigned*)(args.ws + WS_CTL) + 4096; bar.x = 0; bar.st = (volatile LAS unsigned*)(F.lds + MISC_OFF); bar.wave = F.wave;
    if (hi - lo > 1) bar = xcd_barrier_post((unsigned*)(args.ws + WS_CTL) + 4096, (volatile LAS unsigned*)(F.lds + MISC_OFF), F.wave);
    unsigned char* ws0 = args.ws;
    unsigned* xcc_tbl = (unsigned*)(args.ws + WS_CTL) + 1024;
    if (hi - lo > 1 && xb_thread0(F.wave)) __hip_atomic_store(&xcc_tbl[blockIdx.x], xb_xcc_id() + 1u, __ATOMIC_RELAXED, __HIP_MEMORY_SCOPE_AGENT);
    const int gwave = blockIdx.x * NWAVES + F.wave, ngwave = F.G * NWAVES;
    { AMP_BEGIN(0); if (IN(0)) { prep_global(F, args); prep_weights(F, args, 0, 0, N_WITEMS, gwave, ngwave); } AMP_END(0); }
    SEAM(0);
    if (IN(0) && IN(1) && F.G == 256 && lo == 0 && hi == N_PHASES) {
        const int ln = (int)__builtin_amdgcn_mbcnt_hi(~0u, __builtin_amdgcn_mbcnt_lo(~0u, 0u));
        const unsigned head = __hip_atomic_load(&xcc_tbl[ln & 7], __ATOMIC_RELAXED, __HIP_MEMORY_SCOPE_AGENT);
        bool ok = head != 0u;
#pragma unroll
        for (int k = 0; k < 4; ++k) ok = ok && (__hip_atomic_load(&xcc_tbl[64 * k + ln], __ATOMIC_RELAXED, __HIP_MEMORY_SCOPE_AGENT) == head);
        bar.local_ok = __builtin_amdgcn_readfirstlane((int)(__builtin_amdgcn_ballot_w64(ok) == ~0ull)) != 0;
    }
    if (IN(1)) { prep_ssm(F, args, 0, (int)blockIdx.x, F.G); __syncthreads(); }
    SEAM(1);

#pragma unroll 1
    for (int l = 0; l < DEPTH; ++l) {
        const int pb = PH_L0 + l * PH_PER_LAYER;
        unsigned char* ws = ws0; asm volatile("" : "+s"(ws));
        bf16_t* W = (bf16_t*)(ws + WS_W + (size_t)(l & 1) * W_BUF);
        bf16_t* XB = (bf16_t*)(ws + WS_XBF);
        float* ROWSS = (float*)(ws + WS_ROWSS);
        bf16_t* Q = (bf16_t*)(ws + WS_Q); bf16_t* Kb = (bf16_t*)(ws + WS_K); bf16_t* Vb = (bf16_t*)(ws + WS_V);
        bf16_t* CB = (bf16_t*)(ws + WS_CB); bf16_t* CC = (bf16_t*)(ws + WS_ZC); bf16_t* U = (bf16_t*)(ws + WS_U);
        bf16_t* MG = (bf16_t*)(ws + WS_MG); bf16_t* Z = (bf16_t*)(ws + WS_Z);
        bf16_t* GT = (bf16_t*)(ws + WS_GT); bf16_t* HD = (bf16_t*)(ws + WS_HD);
        bf16_t* AO = (bf16_t*)(ws + WS_AO); bf16_t* YS = (bf16_t*)(ws + WS_YS); bf16_t* CA = (bf16_t*)(ws + WS_CA);
        int bid = blockIdx.x, Gv = F.G; asm volatile("" : "+s"(bid), "+s"(Gv));
        const bool split = (Gv == 256) && IN(pb + 2) && IN(pb + 3);
        AMP_BEGIN(1);
        if (IN(pb + 0)) {
            pg8::Gemm g{XB, XB, XB, W + WO_IN, W + WO_IN, W + WO_IN, DM, 0}; pg8::StaticOrder S; S.init(MTOK, INCOLS, F.G, (int)blockIdx.x, 1);
            pg8::EpiInProj E{ROWSS, (const float*)(ws + WS_ROPE), (const float*)(ws + WS_ROPE) + SEQ * 8, args.in[I_BGATE] + l * 3072, Q, Kb, Vb, CB, CC, U, GT};
            if (l + 1 < DEPTH) { if (Gv == 256) { if (bid >= 192) { prep_ssm(F, args, l + 1, bid - 192, 64); __syncthreads(); } } else { prep_ssm(F, args, l + 1, bid, Gv); __syncthreads(); } }
            REPEAT(REP_INPROJ) { pg8::Acc acc; RUN_GEMM(g, S, E, acc, true); }
        }
        AMP_END(1);
        SEAM_X(pb + 0);
        AMP_BEGIN(2);
        if (IN(pb + 1)) REPEAT(REP_MIXERS) { mixers_phase(F, args, l, !split); }
        AMP_END(2);
        SEAM_X(pb + 1);
#define GLU_UNITS() do { \
            {     \
                pg8::Gemm g{YS, YS, YS, W + WO_GLU, W + WO_GLU, W + WO_GLU, 512, 0}; pg8::StaticOrder S; S.init(MTOK, 512, F.G, (int)blockIdx.x, 1); \
                pg8::EpiGlu E{nullptr, YS, Z}; \
                pg8::Acc acc; RUN_GEMM(g, S, E, acc, true); \
            } \
            if (split) { if (bid >= 128) { conv_phase(F, args, l, (bid & 7) * 16 + (((bid >> 3) & 7) * 2 + ((bid - 128) >> 6)), 128);        __syncthreads(); } }     \
            } while (0)
        if (split) REPEAT(REP_MERGE) {
            { AMP_BEGIN(3); GLU_UNITS(); AMP_END(3); }
            AMP_BEGIN(4);
            pg8::Gemm g{AO, CA, Z, W + WO_AO, W + WO_CO, W + WO_SO, 512, 0}; pg8::StaticOrder S; S.init(MTOK, DM, F.G, (int)blockIdx.x, 3);
            pg8::EpiMerge E{nullptr, GT, MG, 0};
            const BarrierHook H{&bar, 1};
            pg8::Acc acc; pg8::gemm_phase<pg8::EpiMerge, true, true, BarrierHook>(F.lds, g, S, E, acc, true, H, F.wave);
            AMP_END(4);
        } else {
            if (IN(pb + 2)) GLU_UNITS();
            SEAM(pb + 2);
            if (IN(pb + 3)) {
                pg8::Gemm g{AO, CA, Z, W + WO_AO, W + WO_CO, W + WO_SO, 512, 0}; pg8::StaticOrder S; S.init(MTOK, DM, F.G, (int)blockIdx.x, 3);
                pg8::EpiMerge E{nullptr, GT, MG, 0};
                pg8::Acc acc; RUN_GEMM(g, S, E, acc, true);
            }
        }
#undef GLU_UNITS
        SEAM_G(pb + 3);
        AMP_BEGIN(5);
        if (IN(pb + 4)) {
            pg8::Gemm g{MG, MG, MG, W + WO_MIX, W + WO_MIX, W + WO_MIX, DM, 0}; pg8::StaticOrder S; S.init(MTOK, DM, F.G, (int)blockIdx.x, 1);
            REPEAT(REP_MIXO) { pg8::EpiResid E{nullptr, args.in[I_X], XB, ROWSS + (size_t)MTOK * 16, l == 0 && rep_ == 0, rep_ + 1 < REP_MIXO}; pg8::Acc acc; RUN_GEMM(g, S, E, acc, true); }
        }
        AMP_END(5);
        SEAM_G(pb + 4);
        AMP_BEGIN(6);
        if (IN(pb + 5)) {
            pg8::Gemm g{XB, XB, XB, W + WO_FI, W + WO_FI, W + WO_FI, DM, 0}; pg8::StaticOrder S; S.init(MTOK, FFN2, F.G, (int)blockIdx.x, 1);
            pg8::EpiFfnIn E{ROWSS + (size_t)MTOK * 16, HD};
            if (l + 1 < DEPTH) {
                if (Gv == 256) { if (bid >= 128) { prep_weights(F, args, l + 1, 0, N_WITEMS, bid * NWAVES + F.wave - 1024, 1024); __syncthreads(); } } else { prep_weights(F, args, l + 1, 0, N_WITEMS, bid * NWAVES + F.wave, Gv * NWAVES); __syncthreads(); }
            }
            REPEAT(REP_FFNIN) { pg8::Acc acc; RUN_GEMM(g, S, E, acc, true); }
        }
        AMP_END(6);
        SEAM_G(pb + 5);
        AMP_BEGIN(7);
        const bool fuse_final = (l == DEPTH - 1) && IN(pb + 6) && IN(PH_FINAL) && (Gv == 256);
        if (IN(pb + 6)) {
            pg8::Gemm g{HD, HD, HD, W + WO_FO, W + WO_FO, W + WO_FO, FFN, HD_PITCH}; pg8::StaticOrder S; S.init(MTOK, DM, F.G, (int)blockIdx.x, 1);
            if (fuse_final) {
                EpiResidFinal E{nullptr, XB, args.out, ROWSS, args.in[I_NFIN], &bar};
                pg8::Acc acc; RUN_GEMM(g, S, E, acc, true);
            } else {
                REPEAT(REP_FFNOUT) { pg8::EpiResid E{nullptr, args.in[I_X], XB, ROWSS, false, rep_ + 1 < REP_FFNOUT}; pg8::Acc acc; RUN_GEMM(g, S, E, acc, true); }
            }
        }
        AMP_END(7);
        if (!fuse_final) SEAM(pb + 6);
    }
    { AMP_BEGIN(8); const bool final_fused = IN(PH_L0 + (DEPTH - 1) * PH_PER_LAYER + 6) && IN(PH_FINAL) && (F.G == 256); if (IN(PH_FINAL) && !final_fused) final_norm(F, args); AMP_END(8); }
#undef IN
}

extern "C" void kernel_launch(void* const* d_in, const int* in_sizes, int n_in, void* d_out, int out_size, void* d_ws, size_t ws_size, hipStream_t stream) {
    static int grid = 0;
    if (grid == 0) {
        if (n_in != 23 || out_size != MTOK * DM || ws_size < WS_END) { fprintf(stderr, "kernel_launch: unexpected shapes (n_in %d out %d ws %zu)\n", n_in, out_size, ws_size); grid = -1; return; }
        if (hipFuncSetAttribute((const void*)fwd_kernel, hipFuncAttributeMaxDynamicSharedMemorySize, LDS_BYTES) != hipSuccess) { fprintf(stderr, "hipFuncSetAttribute failed\n"); grid = -1; return; }
        int dev = 0, cus = 0, per_cu = 0; (void)hipGetDevice(&dev); (void)hipDeviceGetAttribute(&cus, hipDeviceAttributeMultiprocessorCount, dev);
        if (hipOccupancyMaxActiveBlocksPerMultiprocessor(&per_cu, (const void*)fwd_kernel, NTHREADS, LDS_BYTES) != hipSuccess || per_cu < 1) { fprintf(stderr, "occupancy query failed (%d)\n", per_cu); (void)hipGetLastError(); per_cu = 1; }
        grid = cus > 0 ? cus : 256;
    }
    if (grid < 0) return;
    (void)hipMemsetAsync((char*)d_ws, 0, ZERO_BYTES, stream);
    Args a{};
    for (int i = 0; i < 23; ++i) a.in[i] = (const float*)d_in[i];
    a.out = (float*)d_out; a.ws = (unsigned char*)d_ws;
#if N_LAUNCH_MODE == 1
    a.ph_lo = 0; a.ph_hi = N_PHASES; a.li = 0;
    void* kargs[] = {&a};
    hipError_t e = hipLaunchCooperativeKernel((const void*)fwd_kernel, dim3(grid), dim3(NTHREADS), kargs, LDS_BYTES, stream);
    if (e != hipSuccess) fprintf(stderr, "cooperative launch failed: %s (grid %d)\n", hipGetErrorString(e), grid);
#else
    for (int p = 0; p < N_PHASES; ++p) {
        a.ph_lo = p; a.ph_hi = p + 1; a.li = 0;
        hipLaunchKernelGGL(fwd_kernel, dim3(grid), dim3(NTHREADS), LDS_BYTES, stream, a);
    }
#endif
}
```

```cpp
#include <hip/hip_runtime.h>
#include <cstdio>
#include <cstdint>

#ifndef FAST_GEMM
#define FAST_GEMM 1
#endif
#ifndef N_LAUNCH_MODE
#define N_LAUNCH_MODE 1
#endif

#define LAS __attribute__((address_space(3)))
#define GAS __attribute__((address_space(1)))
typedef unsigned short bf16_t;
typedef short bf16x8 __attribute__((ext_vector_type(8)));
typedef float f32x4 __attribute__((ext_vector_type(4)));
typedef float f32x2 __attribute__((ext_vector_type(2)));
typedef unsigned u32x4 __attribute__((ext_vector_type(4)));
typedef unsigned u32x2 __attribute__((ext_vector_type(2)));

constexpr int DM = 1024, BATCH = 8, SEQ = 2048, DEPTH = 4, MTOK = BATCH * SEQ;
constexpr int INCOLS = 5888, FFN = 2816, FFN2 = 5632;
constexpr int C_Q = 0, C_K = 512, C_V = 640, C_CB = 768, C_CC = 1280, C_CX = 1792, C_U = 2304, C_G = 2816;
constexpr float NORM_EPS = 1e-6f;
constexpr float LOG2E = 1.4426950408889634f;
constexpr float QSCALE = 0.125f * LOG2E;

constexpr size_t MiB = 1u << 20;
constexpr size_t WS_CTL = 0;
constexpr size_t ZERO_BYTES = 1 * MiB;
constexpr size_t WS_SSM = 1 * MiB;
constexpr size_t WS_ROPE = 4 * MiB;
constexpr size_t WS_ROWSS = 5 * MiB;
constexpr size_t WS_W = 7 * MiB;
constexpr size_t W_BUF = 34 * MiB;
constexpr size_t WS_XBF = 75 * MiB;
constexpr size_t WS_R1 = 107 * MiB;
constexpr size_t WS_R2 = 195 * MiB;
constexpr size_t WS_R3 = 291 * MiB;
constexpr size_t WS_Q = WS_R1, WS_K = WS_R1 + 16 * MiB, WS_V = WS_R1 + 20 * MiB, WS_CB = WS_R1 + 24 * MiB, WS_ZC = WS_R1 + 40 * MiB, WS_MG = WS_R1 + 56 * MiB;
constexpr size_t WS_GT = WS_R2, WS_HD = WS_R2, WS_U = WS_R3, WS_Z = WS_R3, WS_YS = WS_R3 + 16 * MiB, WS_CA = WS_R3 + 32 * MiB, WS_AO = WS_Q;
constexpr int HD_PITCH = 3072;
constexpr size_t WS_SSMM = 339 * MiB;
constexpr size_t SSMM_BUF = 9 * MiB;
constexpr size_t WS_END = 357 * MiB;
constexpr size_t SM_WY = 0, SM_GT = 6 * MiB, SM_L16 = 8 * MiB;
constexpr size_t WO_IN = 0, WO_AO = WO_IN + (size_t)INCOLS * DM, WO_CO = WO_AO + 1024 * 512, WO_GLU = WO_CO + 1024 * 512, WO_SO = WO_GLU + 512 * 512,
                 WO_MIX = WO_SO + 1024 * 512, WO_FI = WO_MIX + 1024 * 1024, WO_FO = WO_FI + (size_t)FFN2 * DM, WO_END = WO_FO + (size_t)DM * FFN;
static_assert(WO_END * 2 <= 34 * MiB, "weights fit");
constexpr size_t SO_LAM = 0;
constexpr size_t SO_BBAR = 64 * 1024;
constexpr size_t SO_POW = SO_BBAR + 32 * 64 * 16 * 2 * 4;
constexpr size_t SO_LAYER = 768 * 1024;

constexpr int RING_BYTES = 131072;
constexpr int MISC_OFF = RING_BYTES + 320;
constexpr int RSTAB_OFF = RING_BYTES + 4096;
constexpr int LDS_BYTES = 147456;
constexpr int NWAVES = 8, NTHREADS = 512;

__device__ __forceinline__ unsigned f2bf(float f) { unsigned u = __builtin_bit_cast(unsigned, f); return (u + 0x7fffu + ((u >> 16) & 1u)) >> 16; }
typedef __bf16 bf16x2_hw __attribute__((ext_vector_type(2)));
__device__ __forceinline__ unsigned pk2(float lo, float hi) { const f32x2 v = {lo, hi}; const bf16x2_hw b = __builtin_convertvector(v, bf16x2_hw); return __builtin_bit_cast(unsigned, b); }
__device__ __forceinline__ float bf2f(unsigned short b) { return __builtin_bit_cast(float, (unsigned)b << 16); }
__device__ __forceinline__ float bflo(unsigned w) { return __builtin_bit_cast(float, w << 16); }
__device__ __forceinline__ float bfhi(unsigned w) { return __builtin_bit_cast(float, w & 0xffff0000u); }
__device__ __forceinline__ void unpack8(const u32x4 w, float (&v)[8]) { v[0] = bflo(w.x); v[1] = bfhi(w.x); v[2] = bflo(w.y); v[3] = bfhi(w.y); v[4] = bflo(w.z); v[5] = bfhi(w.z); v[6] = bflo(w.w); v[7] = bfhi(w.w); }
__device__ __forceinline__ u32x4 pack8(const float (&v)[8]) { u32x4 w; w.x = pk2(v[0], v[1]); w.y = pk2(v[2], v[3]); w.z = pk2(v[4], v[5]); w.w = pk2(v[6], v[7]); return w; }
__device__ __forceinline__ float sigmoidf_(float x) { return __builtin_amdgcn_rcpf(1.0f + __builtin_amdgcn_exp2f(-LOG2E * x)); }
__device__ __forceinline__ float gelu_tanh(float y) { const float t = (1.5957691216057308f * LOG2E) * (y + 0.044715f * y * y * y); return y * __builtin_amdgcn_rcpf(1.0f + __builtin_amdgcn_exp2f(-t)); }
template <class T> __device__ __forceinline__ T gld(const void* p) { return *(const GAS T*)p; }
template <class T> __device__ __forceinline__ void gst(void* p, const T v) { *(GAS T*)p = v; }
__device__ __forceinline__ float wave_sum(float v) {
#pragma unroll
    for (int o = 1; o < 64; o <<= 1) v += __shfl_xor(v, o);
    return v;
}

#ifndef PROBE_AMP
#define PROBE_AMP -1
#endif
#define AMP_BEGIN(id) unsigned long long amp_t0_##id = 0; if (PROBE_AMP == (id)) amp_t0_##id = __builtin_amdgcn_s_memrealtime()
#define AMP_END(id) do { if (PROBE_AMP == (id)) { const unsigned long long t1_ = __builtin_amdgcn_s_memrealtime(); const unsigned long long tgt_ = t1_ + 3ull * (t1_ - amp_t0_##id); while (__builtin_amdgcn_s_memrealtime() < tgt_) __builtin_amdgcn_s_sleep(8); } } while (0)
__device__ __forceinline__ int opaque_tid(int wave) { unsigned z = 0u; asm volatile("" : "+v"(z)); return wave * 64 + (int)__builtin_amdgcn_mbcnt_hi(~0u, __builtin_amdgcn_mbcnt_lo(~0u, z)); }
__device__ __forceinline__ float row_rs(const float* ss, int row) {
    const f32x4* p = (const f32x4*)(ss + (size_t)row * 16); const f32x4 a = p[0], b = p[1], c = p[2], d = p[3];
    const float t = ((a[0] + a[1]) + (a[2] + a[3])) + ((b[0] + b[1]) + (b[2] + b[3])) + (((c[0] + c[1]) + (c[2] + c[3])) + ((d[0] + d[1]) + (d[2] + d[3])));
    return __builtin_amdgcn_rsqf(t * (1.0f / DM) + NORM_EPS);
}
namespace pg8 {
constexpr int BM = 256, BK = 64, HALF = 128, HTB = HALF * BK * 2, STAGE_BYTES = 8 * HTB, NXCD = 8, WGM = 8;
struct Unit { int pm, pn, seg; };
struct Gemm { const bf16_t* A0; const bf16_t* A1; const bf16_t* A2; const bf16_t* B0; const bf16_t* B1; const bf16_t* B2; int K; int lda; };
__device__ __forceinline__ const bf16_t* sel3(const bf16_t* p0, const bf16_t* p1, const bf16_t* p2, int s) {
    unsigned long long a = (unsigned long long)p0, b = (unsigned long long)p1, c = (unsigned long long)p2;
    asm volatile("" : "+s"(a), "+s"(b), "+s"(c));
    return (const bf16_t*)(s == 0 ? a : (s == 1 ? b : c)); }
__device__ __forceinline__ const bf16_t* selA(const Gemm& g, int s) { return sel3(g.A0, g.A1, g.A2, s); }
__device__ __forceinline__ const bf16_t* selB(const Gemm& g, int s) { return sel3(g.B0, g.B1, g.B2, s); }

struct StaticOrder {
    int nM, nN, nwg, G, c, nseg;
    __device__ void init(int M, int N, int G_, int c_, int nseg_) { nM = M / BM; nN = N / BM; nwg = nM * nN; G = G_; c = c_; nseg = nseg_; }
    __device__ bool next(int i, Unit& u) const {
        const int ti = i / nseg; u.seg = i - ti * nseg;
        const long L = (long)ti * G + c; if (L >= nwg) return false;
        int wgid = (int)L; { const int q = nwg / NXCD, r = nwg % NXCD, xcd = wgid % NXCD, off = wgid / NXCD; wgid = (xcd < r ? xcd * (q + 1) : r * (q + 1) + (xcd - r) * q) + off; }
        const int nig = WGM * nN, gid = wgid / nig, fm = gid * WGM, gsz = (nM - fm) < WGM ? (nM - fm) : WGM;
        u.pm = fm + ((wgid % nig) % gsz); u.pn = (wgid % nig) / gsz; return true;
    }
};

typedef f32x4 Acc[2][2][4][2];

struct EpiInProj {
    static constexpr bool NEEDS_RS = true;
    const float* rowss; const float* ropec; const float* ropes; const float* bgate;
    bf16_t *Q, *Kb, *Vb, *CB, *ZC, *U, *Gt;
    static constexpr int NSTORE = 16;
    __device__ __forceinline__ bool operator()(Acc& acc, const Unit& u, int wr, int wc, int fr, int fq, const LAS float* rstab) const {
        const int cl = wc * 32 + 8 * fq;
        const int rowb = u.pm * BM + wr * 64 + fr;
        const LAS float* rsp = rstab + wr * 64 + fr;
        if (u.pn >= 5 && u.pn < 9) {
            bf16_t* p0 = ZC + (size_t)rowb * 512 + (u.pn - 5) * HALF + cl;
#pragma unroll
            for (int ai = 0; ai < 2; ++ai)
#pragma unroll
                for (int m = 0; m < 4; ++m) {
                    const float rs = rsp[ai * HALF + m * 16], rs2 = rs * rs;
                    float v[8];
#pragma unroll
                    for (int e = 0; e < 4; ++e) { v[e] = acc[ai][0][m][0][e] * acc[ai][1][m][0][e] * rs2; v[4 + e] = acc[ai][0][m][1][e] * acc[ai][1][m][1][e] * rs2; }
                    { const u32x4 pz = pack8(v); u32x2 z0; z0.x = pz.x; z0.y = pz.y; u32x2 z1; z1.x = pz.z; z1.y = pz.w;
                      gst<u32x2>(p0 + (ai * HALF + m * 16) * 512, z0); gst<u32x2>(p0 + (ai * HALF + m * 16) * 512 + 4, z1); }
                    asm volatile("" ::: "memory");
                }
            return true;
        }
#pragma unroll
        for (int bj = 0; bj < 2; ++bj) {
            const int colt = u.pn * BM + bj * HALF;
            if (colt >= C_G) {
                const int pl = (u.pn < 19) ? bj : 2, go = (u.pn < 19) ? (u.pn - 11) * HALF : colt - (C_G + 2048);
                bf16_t* p0 = Gt + (size_t)rowb * 3072 + pl * 1024 + go + cl;
                float bg[8];
                { const f32x4 b0 = gld<f32x4>(bgate + pl * 1024 + go + cl), b1 = gld<f32x4>(bgate + pl * 1024 + go + cl + 4);
#pragma unroll
                  for (int e = 0; e < 4; ++e) { bg[e] = -LOG2E * b0[e]; bg[4 + e] = -LOG2E * b1[e]; } }
#pragma unroll
                for (int ai = 0; ai < 2; ++ai)
#pragma unroll
                    for (int m = 0; m < 4; ++m) {
                        const float nrs = -LOG2E * rsp[ai * HALF + m * 16];
                        float v[8];
#pragma unroll
                        for (int e = 0; e < 4; ++e) {
                            v[e] = 1.0f + __builtin_amdgcn_exp2f(fminf(__builtin_fmaf(acc[ai][bj][m][0][e], nrs, bg[e]), 86.f));
                            v[4 + e] = 1.0f + __builtin_amdgcn_exp2f(fminf(__builtin_fmaf(acc[ai][bj][m][1][e], nrs, bg[4 + e]), 86.f));
                        }
                        gst<u32x4>(p0 + (ai * HALF + m * 16) * 3072, pack8(v));
                        asm volatile("" ::: "memory");
                    }
            } else {
                bf16_t* p0; int pitch; float scale = 1.0f; bool rope = false;
                if (colt < C_K) { p0 = Q + (size_t)rowb * 512 + colt + cl; pitch = 512; scale = QSCALE; rope = (wc & 1) == 0; }
                else if (colt < C_V) { p0 = Kb + (size_t)rowb * 128 + cl; pitch = 128; rope = (wc & 1) == 0; }
                else if (colt < C_CB) { p0 = Vb + (size_t)rowb * 128 + cl; pitch = 128; }
                else if (colt < C_CC) { p0 = CB + (size_t)rowb * 512 + (colt - C_CB) + cl; pitch = 512; }
                else { const int cu = (colt - C_U) + cl; p0 = U + (size_t)(cu >> 4) * SEQ * 16 + (cu & 15) + ((size_t)(rowb >> 11) * 32 * SEQ + (rowb & (SEQ - 1))) * 16; pitch = 16; }
                if (rope) {
                    const float sgn = (fq == 0) ? -1.f : 1.f;
#pragma unroll
                    for (int ai = 0; ai < 2; ++ai)
#pragma unroll
                        for (int m = 0; m < 4; ++m) {
                            const float rs = rsp[ai * HALF + m * 16] * scale;
                            const int pos = (rowb + ai * HALF + m * 16) & (SEQ - 1);
                            const f32x4 c0 = gld<f32x4>(ropec + pos * 8), c1 = gld<f32x4>(ropec + pos * 8 + 4);
                            const f32x4 s0 = gld<f32x4>(ropes + pos * 8), s1 = gld<f32x4>(ropes + pos * 8 + 4);
                            float v[8];
#pragma unroll
                            for (int e = 0; e < 4; ++e) { v[e] = acc[ai][bj][m][0][e] * rs; v[4 + e] = acc[ai][bj][m][1][e] * rs; }
#pragma unroll
                            for (int e = 0; e < 8; ++e) {
                                const float p = __shfl_xor(v[e], 16);
                                const float cs = e < 4 ? c0[e & 3] : c1[e & 3], sn = e < 4 ? s0[e & 3] : s1[e & 3];
                                const float r = v[e] * cs + sgn * p * sn;
                                v[e] = (fq < 2) ? r : v[e];
                            }
                            gst<u32x4>(p0 + (ai * HALF + m * 16) * pitch, pack8(v));
                            asm volatile("" ::: "memory");
                        }
                } else {
#pragma unroll
                    for (int ai = 0; ai < 2; ++ai)
#pragma unroll
                        for (int m = 0; m < 4; ++m) {
                            const float rs = rsp[ai * HALF + m * 16] * scale;
                            float v[8];
#pragma unroll
                            for (int e = 0; e < 4; ++e) { v[e] = acc[ai][bj][m][0][e] * rs; v[4 + e] = acc[ai][bj][m][1][e] * rs; }
                            gst<u32x4>(p0 + (ai * HALF + m * 16) * pitch, pack8(v));
                            asm volatile("" ::: "memory");
                        }
                }
            }
        }
        return true;
    }
};

struct EpiGlu {
    static constexpr bool NEEDS_RS = false;
    const float* rowss; const bf16_t* YS; bf16_t* Z;
    static constexpr int NSTORE = 0;
    __device__ __forceinline__ bool operator()(Acc& acc, const Unit& u, int wr, int wc, int fr, int fq, const LAS float*) const {
        const size_t o0 = (size_t)(u.pm * BM + wr * 64 + fr) * 512 + u.pn * BM + wc * 32 + 8 * fq; const bf16_t* yp = YS + o0; bf16_t* zp = Z + o0;
        u32x4 yv[2][4][2];
#pragma unroll
        for (int ai = 0; ai < 2; ++ai)
#pragma unroll
            for (int m = 0; m < 4; ++m)
#pragma unroll
                for (int bj = 0; bj < 2; ++bj) yv[ai][m][bj] = gld<u32x4>(yp + (ai * HALF + m * 16) * 512 + bj * HALF);
#pragma unroll
        for (int ai = 0; ai < 2; ++ai) {
#pragma unroll
            for (int m = 0; m < 4; ++m)
#pragma unroll
                for (int bj = 0; bj < 2; ++bj) {
                    float y[8]; unpack8(yv[ai][m][bj], y);
                    float v[8];
#pragma unroll
                    for (int e = 0; e < 4; ++e) { v[e] = y[e] * sigmoidf_(acc[ai][bj][m][0][e]); v[4 + e] = y[4 + e] * sigmoidf_(acc[ai][bj][m][1][e]); }
                    gst<u32x4>(zp + (ai * HALF + m * 16) * 512 + bj * HALF, pack8(v));
                }
            asm volatile("" ::: "memory");
        }
        return true;
    }
};

struct EpiMerge {
    static constexpr bool NEEDS_RS = false;
    const float* rowss; const bf16_t* Gt; bf16_t* Mg; int seg_base;  static constexpr int NSTORE = 0;
    __device__ __forceinline__ bool operator()(Acc& acc, const Unit& u, int wr, int wc, int fr, int fq, const LAS float*) const {
        const int s = u.seg + seg_base;
        const bf16_t* gp = Gt + (size_t)(u.pm * BM + wr * 64 + fr) * 3072 + u.pn * BM + wc * 32 + 8 * fq;
        const bf16_t* pd = gp + (s == 0 ? 0 : (s == 1 ? 1024 : 2048));
        const bf16_t* pn_ = gp + (s == 0 ? 1024 : 2048);
        bf16_t* mp = Mg + (size_t)(u.pm * BM + wr * 64 + fr) * DM + u.pn * BM + wc * 32 + 8 * fq;
#pragma unroll
        for (int ai = 0; ai < 2; ++ai) {
            u32x4 ga[4][2], gb[4][2];
#pragma unroll
            for (int m = 0; m < 4; ++m)
#pragma unroll
                for (int bj = 0; bj < 2; ++bj) {
                    const size_t o = (size_t)(ai * HALF + m * 16) * 3072 + bj * HALF;
                    gb[m][bj] = gld<u32x4>(pd + o);
                    ga[m][bj] = (s < 2) ? gld<u32x4>(pn_ + o) : gb[m][bj];
                }
#pragma unroll
            for (int m = 0; m < 4; ++m)
#pragma unroll
                for (int bj = 0; bj < 2; ++bj) {
                    float fa[8], fb[8], f[8]; unpack8(ga[m][bj], fa); unpack8(gb[m][bj], fb);
#pragma unroll
                    for (int e = 0; e < 8; ++e) { const float r = __builtin_amdgcn_rcpf(fb[e]); f[e] = (s < 2) ? fa[e] * r : r; }
                    if (s < 2) {
#pragma unroll
                        for (int e = 0; e < 4; ++e) { acc[ai][bj][m][0][e] *= f[e]; acc[ai][bj][m][1][e] *= f[4 + e]; }
                    } else {
                        float v[8];
#pragma unroll
                        for (int e = 0; e < 4; ++e) { v[e] = acc[ai][bj][m][0][e] * f[e]; v[4 + e] = acc[ai][bj][m][1][e] * f[4 + e]; }
                        gst<u32x4>(mp + (size_t)(ai * HALF + m * 16) * DM + bj * HALF, pack8(v));
                    }
                }
            asm volatile("" ::: "memory");
        }
        return s == 2;
    }
};

struct EpiResid {
    static constexpr bool NEEDS_RS = false;
    const float* rowss; const float* Xin; bf16_t* XB; float* ss_next; bool first; bool dry;  static constexpr int NSTORE = 0;
    __device__ __forceinline__ void row_group(Acc& acc, const int ai, const int m, const float (&xo0)[8], const float (&xo1)[8], bf16_t* xb0, const int row0, const int pn, const int wc, const int fq) const {
        float ssq = 0.f;
#pragma unroll
        for (int bj = 0; bj < 2; ++bj) {
            float v[8];
#pragma unroll
            for (int e = 0; e < 4; ++e) { const float a0 = bj ? xo1[e] : xo0[e], a1 = bj ? xo1[4 + e] : xo0[4 + e]; v[e] = dry ? a0 : a0 + acc[ai][bj][m][0][e]; v[4 + e] = dry ? a1 : a1 + acc[ai][bj][m][1][e]; }
#pragma unroll
            for (int e = 0; e < 8; ++e) ssq += v[e] * v[e];
            gst<u32x4>(xb0 + (size_t)(ai * HALF + m * 16) * DM + bj * HALF, pack8(v));
        }
        ssq += __shfl_xor(ssq, 16); ssq += __shfl_xor(ssq, 32);
        if (fq == 0) gst<float>(ss_next + (size_t)(row0 + ai * HALF + m * 16) * 16 + pn * 4 + wc, ssq);
    }
    __device__ __forceinline__ bool operator()(Acc& acc, const Unit& u, int wr, int wc, int fr, int fq, const LAS float*) const {
        const int row0 = u.pm * BM + wr * 64 + fr, col0 = u.pn * BM + wc * 32 + 8 * fq;
        bf16_t* xb0 = XB + (size_t)row0 * DM + col0; const float* xi0 = Xin + (size_t)row0 * DM + col0;
        if (first) {
#pragma unroll
            for (int ai = 0; ai < 2; ++ai)
#pragma unroll
            for (int mh = 0; mh < 2; ++mh) {
                f32x4 xv[4][2][2];
#pragma unroll
                for (int m = 2 * mh; m < 2 * mh + 2; ++m)
#pragma unroll
                    for (int bj = 0; bj < 2; ++bj) { const float* xp = xi0 + (size_t)(ai * HALF + m * 16) * DM + bj * HALF; xv[m][bj][0] = __builtin_nontemporal_load((const GAS f32x4*)xp); xv[m][bj][1] = __builtin_nontemporal_load((const GAS f32x4*)(xp + 4)); }
#pragma unroll
                for (int m = 2 * mh; m < 2 * mh + 2; ++m) {
                    float x0[8], x1[8];
#pragma unroll
                    for (int e = 0; e < 4; ++e) { x0[e] = xv[m][0][0][e]; x0[4 + e] = xv[m][0][1][e]; x1[e] = xv[m][1][0][e]; x1[4 + e] = xv[m][1][1][e]; }
                    row_group(acc, ai, m, x0, x1, xb0, row0, u.pn, wc, fq);
                }
                asm volatile("" ::: "memory");
            }
        } else {
#pragma unroll
            for (int ai = 0; ai < 2; ++ai) {
                u32x4 xv[4][2];
#pragma unroll
                for (int m = 0; m < 4; ++m)
#pragma unroll
                    for (int bj = 0; bj < 2; ++bj) xv[m][bj] = gld<u32x4>(xb0 + (size_t)(ai * HALF + m * 16) * DM + bj * HALF);
#pragma unroll
                for (int m = 0; m < 4; ++m) {
                    float x0[8], x1[8]; unpack8(xv[m][0], x0); unpack8(xv[m][1], x1);
                    row_group(acc, ai, m, x0, x1, xb0, row0, u.pn, wc, fq);
                }
                asm volatile("" ::: "memory");
            }
        }
        return true;
    }
};

struct EpiFfnIn {
    static constexpr bool NEEDS_RS = true;
    const float* rowss; bf16_t* H;
    static constexpr int NSTORE = 8;
    __device__ __forceinline__ bool operator()(Acc& acc, const Unit& u, int wr, int wc, int fr, int fq, const LAS float* rstab) const {
        bf16_t* p0 = H + (size_t)(u.pm * BM + wr * 64 + fr) * HD_PITCH + u.pn * HALF + wc * 32 + 8 * fq;
        const LAS float* rsp = rstab + wr * 64 + fr;
#pragma unroll
        for (int ai = 0; ai < 2; ++ai)
#pragma unroll
            for (int m = 0; m < 4; ++m) {
                const float rs = rsp[ai * HALF + m * 16], nrs = -LOG2E * rs, rs2 = rs * rs;
                float v[8];
#pragma unroll
                for (int n = 0; n < 2; ++n)
#pragma unroll
                    for (int e = 0; e < 4; ++e) {
                        const float g = acc[ai][0][m][n][e], up = acc[ai][1][m][n][e];
                        v[4 * n + e] = (g * up * rs2) * __builtin_amdgcn_rcpf(1.0f + __builtin_amdgcn_exp2f(g * nrs));
                    }
                gst<u32x4>(p0 + (ai * HALF + m * 16) * HD_PITCH, pack8(v));
                asm volatile("" ::: "memory");
            }
        return true;
    }
};


__host__ __device__ __forceinline__ int lds_byte(int r, int c) { const int st = (r >> 4) * 2 + (c >> 5), rr = r & 15, cc = c & 31, ob = rr * 64 + cc * 2; return st * 1024 + (ob ^ (((ob >> 9) & 1) << 5)); }
__host__ __device__ __forceinline__ void stage_rc(int b, int& R, int& C) { const int st = b / 1024, sb = b % 1024, swz = sb ^ (((sb >> 9) & 1) << 5); R = (st >> 1) * 16 + swz / 64; C = (st & 1) * 32 + (swz % 64) / 2; }
__host__ __device__ __forceinline__ int perm32(int rho) { const int n = rho >> 4, i = rho & 15; return 8 * (i >> 2) + 4 * n + (i & 3); }

struct NoHook { __device__ __forceinline__ void operator()(const Unit&) const {} };
struct Src { __amdgpu_buffer_rsrc_t r; unsigned o; };
__device__ __forceinline__ Src operator+(Src s_, size_t d) { s_.o += (unsigned)d; return s_; }
__device__ __forceinline__ Src make_src(const bf16_t* p, size_t off) { Src s_; s_.r = __builtin_amdgcn_make_buffer_rsrc((void*)p, (short)0, 0x7fffffff, 0x00020000); s_.o = (unsigned)off; return s_; }
template <class Epi, bool ALIGN_EPI, bool SP2, class Hook>
__device__ __forceinline__ void gemm_phase(LAS unsigned char* lds, const Gemm g, const StaticOrder& S, const Epi& E, Acc& acc, const bool fresh, const Hook& H, const int wave_id) {
    const int tid = opaque_tid(wave_id), wid = wave_id, lane = tid & 63, wr = wid >> 2, wc = wid & 3, fr = lane & 15, fq = lane >> 4;
    const int K = g.K, nt = K / BK, lda = g.lda ? g.lda : K;
    unsigned voffA[2], voffB[2];
#pragma unroll
    for (int i = 0; i < 2; ++i) { int R, C; stage_rc(tid * 16 + i * 8192, R, C); const int Rb = (R & ~31) + perm32(R & 31);
        voffA[i] = (unsigned)(R * lda + C) * 2u; voffB[i] = (unsigned)(Rb * K + C) * 2u; }
    const size_t kstep = (size_t)(BK * 2);
    const size_t hstep = (size_t)HALF * K * 2, hstepA = (size_t)HALF * lda * 2;
    const size_t tstep = 2 * hstep, tstepA = 2 * hstepA;
    const unsigned ldsw = (unsigned)wid * 1024u;
    const int aoff = lds_byte(wr * 64 + fr, fq * 8), boff = lds_byte(wc * 32 + fr, fq * 8);
#define PG8_SA(b, h) (((b) * 2 + (h)) * HTB)
#define PG8_SB(b, h) ((4 + (b) * 2 + (h)) * HTB)
#define PG8_STAGE(bufoff, gbase, voff) do { const Src _g = (gbase); _Pragma("unroll") for (int _i = 0; _i < 2; ++_i) \
        __builtin_amdgcn_raw_ptr_buffer_load_lds(_g.r, (LAS unsigned*)(lds + (bufoff) + ldsw + _i * 8192), 16, (voff)[_i], _g.o, 0, 0); } while (0)
#define PG8_LDA(dst, b, h) do { _Pragma("unroll") for (int m = 0; m < 4; ++m) _Pragma("unroll") for (int k = 0; k < 2; ++k) dst[m][k] = *(const LAS bf16x8*)(lds + PG8_SA(b, h) + aoff + m * 2048 + k * 1024); } while (0)
#define PG8_LDB(dst, b, h) do { _Pragma("unroll") for (int n = 0; n < 2; ++n) _Pragma("unroll") for (int k = 0; k < 2; ++k) dst[n][k] = *(const LAS bf16x8*)(lds + PG8_SB(b, h) + boff + n * 2048 + k * 1024); } while (0)
#define PG8_MMA(ai, bj, At, Bt) do { __builtin_amdgcn_s_setprio(1); _Pragma("unroll") for (int m = 0; m < 4; ++m) _Pragma("unroll") for (int n = 0; n < 2; ++n) _Pragma("unroll") for (int k = 0; k < 2; ++k) \
        acc[ai][bj][m][n] = __builtin_amdgcn_mfma_f32_16x16x32_bf16(Bt[n][k], At[m][k], acc[ai][bj][m][n], 0, 0, 0); __builtin_amdgcn_s_setprio(0); } while (0)
#define PG8_WAIT_V(n) asm volatile("s_waitcnt vmcnt(" #n ")" ::: "memory")
#define PG8_WAIT_L(n) asm volatile("s_waitcnt lgkmcnt(" #n ")" ::: "memory")
#define PG8_TRIP_SP2(W12) do { \
            PG8_LDB(B0, 0, 0); PG8_LDB(B1, 0, 1); PG8_SCHED; PG8_LDA(At, 0, 0); PG8_STAGE(PG8_SA(1, 1), a1 + hstepA, voffA); \
            W12; PG8_WAIT_L(0); PG8_BAR; PG8_MMA(0, 0, At, B0); PG8_MMA(0, 1, At, B1); PG8_BAR; PG8_SCHED; \
            PG8_LDA(At, 0, 1); PG8_STAGE(PG8_SB(0, 0), b2, voffB); PG8_STAGE(PG8_SB(0, 1), b2 + hstep, voffB); PG8_STAGE(PG8_SA(0, 0), a2, voffA); \
            W12; PG8_WAIT_L(0); PG8_BAR; PG8_MMA(1, 0, At, B0); PG8_MMA(1, 1, At, B1); PG8_BAR; PG8_SCHED; \
            PG8_LDB(B0, 1, 0); PG8_LDB(B1, 1, 1); PG8_SCHED; PG8_LDA(At, 1, 0); PG8_STAGE(PG8_SA(0, 1), a2 + hstepA, voffA); \
            PG8_WAIT_V(8); PG8_WAIT_L(0); PG8_BAR; PG8_MMA(0, 0, At, B0); PG8_MMA(0, 1, At, B1); PG8_BAR; PG8_SCHED; \
            PG8_LDA(At, 1, 1); PG8_STAGE(PG8_SB(1, 0), b3, voffB); PG8_STAGE(PG8_SB(1, 1), b3 + hstep, voffB); PG8_STAGE(PG8_SA(1, 0), a3, voffA); \
            PG8_WAIT_V(8); PG8_WAIT_L(0); PG8_BAR; PG8_MMA(1, 0, At, B0); PG8_MMA(1, 1, At, B1); PG8_BAR; PG8_SCHED; } while (0)
#define PG8_BAR __builtin_amdgcn_s_barrier()
#define PG8_SCHED __builtin_amdgcn_sched_barrier(0)
    Unit cur, nxt; int ui = 0, rs_pm = -1, t0 = 0;
    if (!S.next(0, cur)) return;
    if (fresh) {
#pragma unroll
        for (int a = 0; a < 2; ++a)
#pragma unroll
            for (int b = 0; b < 2; ++b)
#pragma unroll
                for (int m = 0; m < 4; ++m)
#pragma unroll
                    for (int n = 0; n < 2; ++n) acc[a][b][m][n] = (f32x4){0.f, 0.f, 0.f, 0.f};
    }
    bf16x8 At[4][2], B0[2][2], B1[2][2];
    Src cA = make_src(selA(g, cur.seg), (size_t)cur.pm * tstepA), cB = make_src(selB(g, cur.seg), (size_t)cur.pn * tstep);
    if constexpr (SP2) {
        PG8_STAGE(PG8_SB(0, 0), cB, voffB); PG8_STAGE(PG8_SB(0, 1), cB + hstep, voffB); PG8_STAGE(PG8_SA(0, 0), cA, voffA); PG8_STAGE(PG8_SA(0, 1), cA + hstepA, voffA);
        if (wr == 1) PG8_BAR;
        PG8_WAIT_V(2); PG8_BAR;
        PG8_STAGE(PG8_SB(1, 0), cB + kstep, voffB); PG8_STAGE(PG8_SA(1, 0), cA + kstep, voffA); PG8_STAGE(PG8_SB(1, 1), cB + hstep + kstep, voffB);
        PG8_WAIT_V(6); PG8_BAR;
    } else {
        PG8_STAGE(PG8_SB(0, 0), cB, voffB); PG8_STAGE(PG8_SA(0, 0), cA, voffA); PG8_STAGE(PG8_SB(0, 1), cB + hstep, voffB); PG8_STAGE(PG8_SA(0, 1), cA + hstepA, voffA);
        if (wr == 1) PG8_BAR;
        PG8_WAIT_V(4); PG8_BAR;
        PG8_STAGE(PG8_SB(1, 0), cB + kstep, voffB); PG8_STAGE(PG8_SA(1, 0), cA + kstep, voffA); PG8_STAGE(PG8_SB(1, 1), cB + hstep + kstep, voffB);
        PG8_WAIT_V(6); PG8_BAR;
    }
    for (;;) {
        const bool has_next = S.next(ui + 1, nxt);
        const Src nA = has_next ? make_src(selA(g, nxt.seg), (size_t)nxt.pm * tstepA) : cA, nB = has_next ? make_src(selB(g, nxt.seg), (size_t)nxt.pn * tstep) : cB;
        for (int t = t0; t < nt; t += 2) {
            const bool last = (t == nt - 2);
            const Src a1 = cA + (size_t)(t + 1) * kstep;
            const Src a2 = last ? nA : cA + (size_t)(t + 2) * kstep, b2 = last ? nB : cB + (size_t)(t + 2) * kstep;
            const Src a3 = a2 + kstep, b3 = b2 + kstep;
            if (last && has_next) H(nxt);
            if constexpr (SP2) {
            PG8_TRIP_SP2(PG8_WAIT_V(8));
            } else {
            PG8_LDB(B0, 0, 0); PG8_SCHED; PG8_LDA(At, 0, 0); PG8_STAGE(PG8_SA(1, 1), a1 + hstepA, voffA);
            PG8_WAIT_L(8); PG8_BAR; PG8_WAIT_L(0); PG8_MMA(0, 0, At, B0); PG8_BAR; PG8_SCHED;
            PG8_LDB(B1, 0, 1); PG8_STAGE(PG8_SB(0, 0), b2, voffB);
            PG8_BAR; PG8_WAIT_L(0); PG8_MMA(0, 1, At, B1); PG8_BAR;
            PG8_LDA(At, 0, 1); PG8_STAGE(PG8_SA(0, 0), a2, voffA);
            PG8_BAR; PG8_WAIT_L(0); PG8_MMA(1, 0, At, B0); PG8_BAR; PG8_SCHED;
            PG8_STAGE(PG8_SB(0, 1), b2 + hstep, voffB);
            PG8_WAIT_V(6); PG8_BAR; PG8_MMA(1, 1, At, B1); PG8_BAR;
            PG8_LDB(B0, 1, 0); PG8_SCHED; PG8_LDA(At, 1, 0); PG8_STAGE(PG8_SA(0, 1), a2 + hstepA, voffA);
            PG8_WAIT_L(8); PG8_BAR; PG8_WAIT_L(0); PG8_MMA(0, 0, At, B0); PG8_BAR; PG8_SCHED;
            PG8_LDB(B1, 1, 1); PG8_STAGE(PG8_SB(1, 0), b3, voffB);
            PG8_BAR; PG8_WAIT_L(0); PG8_MMA(0, 1, At, B1); PG8_BAR;
            PG8_LDA(At, 1, 1); PG8_STAGE(PG8_SA(1, 0), a3, voffA);
            PG8_BAR; PG8_WAIT_L(0); PG8_MMA(1, 0, At, B0); PG8_BAR; PG8_SCHED;
            PG8_STAGE(PG8_SB(1, 1), b3 + hstep, voffB);
            PG8_WAIT_V(6); PG8_BAR; PG8_MMA(1, 1, At, B1); PG8_BAR;
            }
        }
        if constexpr (ALIGN_EPI) { if (wr == 0) PG8_BAR; }
        const int tid_ = opaque_tid(wave_id), fr_ = tid_ & 15, fq_ = (tid_ & 63) >> 4;
        const LAS float* rstab = (const LAS float*)(lds + RSTAB_OFF);
        if (Epi::NEEDS_RS && cur.pm != rs_pm) {
            rs_pm = cur.pm;
            const GAS f32x4* p = (const GAS f32x4*)(E.rowss + (size_t)(cur.pm * BM + (tid_ >> 1)) * 16) + (tid_ & 1) * 2; const f32x4 pa = p[0], pb = p[1];
            float t = ((pa[0] + pa[1]) + (pa[2] + pa[3])) + ((pb[0] + pb[1]) + (pb[2] + pb[3]));
            const float t2 = __shfl_xor(t, 1); t = (tid_ & 1) ? (t2 + t) : (t + t2);
            if ((tid_ & 1) == 0) ((LAS float*)(lds + RSTAB_OFF))[tid_ >> 1] = __builtin_amdgcn_rsqf(t * (1.0f / DM) + NORM_EPS);
            PG8_WAIT_L(0); PG8_BAR;
        }
        AMP_BEGIN(11);
        const bool reset = E(acc, cur, wr, wc, fr_, fq_, rstab);
        AMP_END(11);
        if (!has_next) break;
        if (reset) {
#pragma unroll
            for (int a = 0; a < 2; ++a)
#pragma unroll
                for (int b = 0; b < 2; ++b)
#pragma unroll
                    for (int m = 0; m < 4; ++m)
#pragma unroll
                        for (int n = 0; n < 2; ++n) acc[a][b][m][n] = (f32x4){0.f, 0.f, 0.f, 0.f};
        }
        cur = nxt; cA = nA; cB = nB; ++ui;
        if constexpr (ALIGN_EPI) { if (wr == 1) PG8_BAR; }
        if constexpr (SP2 && Epi::NSTORE > 0) {
            const Src a1 = cA + kstep, a2 = cA + 2 * kstep, b2 = cB + 2 * kstep, a3 = a2 + kstep, b3 = b2 + kstep;
            if constexpr (Epi::NSTORE == 16) PG8_TRIP_SP2(PG8_WAIT_V(24)); else PG8_TRIP_SP2(PG8_WAIT_V(16));
            t0 = 2;
        }
    }
    PG8_WAIT_V(0);
    if constexpr (!ALIGN_EPI) { if (wr == 0) PG8_BAR; }
    PG8_BAR;
#undef PG8_SA
#undef PG8_SB
#undef PG8_STAGE
#undef PG8_LDA
#undef PG8_LDB
#undef PG8_MMA
#undef PG8_WAIT_V
#undef PG8_TRIP_SP2
#undef PG8_WAIT_L
#undef PG8_BAR
#undef PG8_SCHED
}
}


#define XB_TMO      128
#define XB_XCNT(j)  (256  + 64 * (j))
#define XB_XSUB(j)  (1280 + 64 * (j))
#define XB_XGEN(j)  (2304 + 64 * (j))
#define XB_TOP      3328
#define XB_TOPGEN   3392
#define XCD_BAR_WORDS 3456
#define XB_SPIN_CAP (1u << 18)
__device__ __forceinline__ unsigned xb_ld(unsigned* p)              { return __hip_atomic_load(p, __ATOMIC_RELAXED, __HIP_MEMORY_SCOPE_AGENT); }
__device__ __forceinline__ unsigned xb_add(unsigned* p, unsigned v) { return __hip_atomic_fetch_add(p, v, __ATOMIC_RELAXED, __HIP_MEMORY_SCOPE_AGENT); }
__device__ __forceinline__ unsigned xb_xcc_id() { return (unsigned)__builtin_amdgcn_s_getreg((3 << 11) | 20) & 0xFu; }
#define XB_SPIN(cond, bar) do { unsigned _sp = 0; while (cond) { __builtin_amdgcn_s_sleep(1); \
    if ((++_sp & 255u) == 0u) { if (xb_ld(&(bar)[XB_TMO])) break; if (_sp > XB_SPIN_CAP) { atomicAdd(&(bar)[XB_TMO], 1u); break; } } } } while (0)
struct XcdBarrier { unsigned* bar; unsigned x; volatile LAS unsigned* st; int wave; bool local_ok; };
__device__ __forceinline__ bool xb_thread0(int wave) { unsigned z = 0u; asm volatile("" : "+v"(z)); return wave == 0 && __builtin_amdgcn_mbcnt_hi(~0u, __builtin_amdgcn_mbcnt_lo(~0u, z)) == 0u; }
__device__ __forceinline__ XcdBarrier xcd_barrier_post(unsigned* bar, volatile LAS unsigned* st, int wave) {
    XcdBarrier b; b.bar = bar; b.x = xb_xcc_id(); b.st = st; b.wave = wave; b.local_ok = false;
    if (xb_thread0(wave)) (void)xb_add(&bar[XB_XCNT(b.x)], 1u);
    return b;
}
__device__ __forceinline__ void xcd_barrier_complete(unsigned* bar, unsigned x, unsigned& nloc, unsigned& nx) {
    const unsigned G = gridDim.x * gridDim.y * gridDim.z;
    unsigned sum, cnt, mine, sp = 0u;
    for (;;) {
        sum = 0u; cnt = 0u; mine = 0u;
#pragma unroll
        for (unsigned j = 0; j < 16; ++j) { const unsigned c = xb_ld(&bar[XB_XCNT(j)]); sum += c; cnt += (c > 0u) ? 1u : 0u; mine = (j == x) ? c : mine; }
        if (sum == G) break;
        __builtin_amdgcn_s_sleep(1);
        if ((++sp & 255u) == 0u) { if (xb_ld(&bar[XB_TMO])) break; if (sp > XB_SPIN_CAP) { atomicAdd(&bar[XB_TMO], 1u); break; } }
    }
    nloc = mine > 0u ? mine : 1u; nx = cnt > 0u ? cnt : 1u;
}
#define XB_GSUB(g)  (4096 + 64 * (g))
#define XB_GGEN(g)  (8192 + 64 * (g))
__device__ __forceinline__ void xcd_barrier(const XcdBarrier& b, const int scope = 0) {
    const bool xcd_only = scope != 0;
    asm volatile("s_waitcnt vmcnt(0)" ::: "memory");
    __syncthreads();
    if (scope == 2 && b.local_ok) {
        if (xb_thread0(b.wave)) {
            unsigned* bar = b.bar;
            const unsigned g = (blockIdx.x & 7u) * 8u + ((blockIdx.x >> 3) & 7u);
            const unsigned old = xb_add(&bar[XB_GSUB(g)], 1u);
            const unsigned gen = old >> 2;
            if ((old & 3u) == 3u) xb_add(&bar[XB_GGEN(g)], 1u);
            else XB_SPIN(xb_ld(&bar[XB_GGEN(g)]) == gen, bar);
            __builtin_amdgcn_fence(__ATOMIC_ACQUIRE, "agent");
            asm volatile("s_waitcnt vmcnt(0)" ::: "memory");
        }
        __syncthreads();
        return;
    }
    if (xb_thread0(b.wave)) {
        unsigned* bar = b.bar;
        __builtin_amdgcn_s_waitcnt(0);
        unsigned nloc = b.st[0], nx = b.st[1];
        if (nloc == 0u) { xcd_barrier_complete(bar, b.x, nloc, nx); b.st[0] = nloc; b.st[1] = nx; }
        const unsigned old = xb_add(&bar[XB_XSUB(b.x)], 1u);
        const unsigned gen = old / nloc;
        if (old + 1u == (gen + 1u) * nloc) {
            if (!(xcd_only && b.local_ok)) {
                __builtin_amdgcn_fence(__ATOMIC_RELEASE, "agent");
                asm volatile("s_waitcnt vmcnt(0)" ::: "memory");
                const unsigned og = xb_add(&bar[XB_TOP], 1u);
                const unsigned tg = og / nx;
                if (og + 1u == (tg + 1u) * nx) xb_add(&bar[XB_TOPGEN], 1u);
                else XB_SPIN(xb_ld(&bar[XB_TOPGEN]) == tg, bar);
            }
            __builtin_amdgcn_fence(__ATOMIC_ACQUIRE, "agent");
            xb_add(&bar[XB_XGEN(b.x)], 1u);
            asm volatile("s_waitcnt vmcnt(0)" ::: "memory");
        } else {
            XB_SPIN(xb_ld(&bar[XB_XGEN(b.x)]) == gen, bar);
            __builtin_amdgcn_fence(__ATOMIC_ACQUIRE, "agent");
            asm volatile("s_waitcnt vmcnt(0)" ::: "memory");
        }
    }
    __syncthreads();
}

struct BarrierHook { const XcdBarrier* b; int at_seg; __device__ __forceinline__ void operator()(const pg8::Unit& nxt) const { if (nxt.seg == at_seg) xcd_barrier(*b, 2); } };


struct EpiResidFinal {
    static constexpr bool NEEDS_RS = false;
    const float* rowss; const bf16_t* XB; float* OUT; float* ss; const float* gain; const XcdBarrier* bar;
    static constexpr int NSTORE = 0;
    __device__ __forceinline__ bool operator()(pg8::Acc& acc, const pg8::Unit& u, int wr, int wc, int fr, int fq, const LAS float* rstab) const {
        using namespace pg8;
        const int row0 = u.pm * BM + wr * 64 + fr, col0 = u.pn * BM + wc * 32 + 8 * fq;
        const bf16_t* xb0 = XB + (size_t)row0 * DM + col0;
#pragma unroll
        for (int ai = 0; ai < 2; ++ai) {
            u32x4 xv[4][2];
#pragma unroll
            for (int m = 0; m < 4; ++m)
#pragma unroll
                for (int bj = 0; bj < 2; ++bj) xv[m][bj] = gld<u32x4>(xb0 + (size_t)(ai * HALF + m * 16) * DM + bj * HALF);
#pragma unroll
            for (int m = 0; m < 4; ++m) {
                float ssq = 0.f;
#pragma unroll
                for (int bj = 0; bj < 2; ++bj) {
                    float h8[8]; unpack8(xv[m][bj], h8);
                    f32x4 x0, x1;
#pragma unroll
                    for (int e = 0; e < 4; ++e) { x0[e] = h8[e] + acc[ai][bj][m][0][e]; x1[e] = h8[4 + e] + acc[ai][bj][m][1][e]; }
                    acc[ai][bj][m][0] = x0; acc[ai][bj][m][1] = x1;
#pragma unroll
                    for (int e = 0; e < 4; ++e) ssq += x0[e] * x0[e];
#pragma unroll
                    for (int e = 0; e < 4; ++e) ssq += x1[e] * x1[e];
                }
                ssq += __shfl_xor(ssq, 16); ssq += __shfl_xor(ssq, 32);
                if (fq == 0) gst<float>(ss + (size_t)(row0 + ai * HALF + m * 16) * 16 + u.pn * 4 + wc, ssq);
            }
            asm volatile("" ::: "memory");
        }
        xcd_barrier(*bar, 2);
        {
            const int tid_ = ((wr * 4 + wc) * 64) + fq * 16 + fr;
            const GAS f32x4* p = (const GAS f32x4*)(ss + (size_t)(u.pm * BM + (tid_ >> 1)) * 16) + (tid_ & 1) * 2; const f32x4 pa = p[0], pb = p[1];
            float t = ((pa[0] + pa[1]) + (pa[2] + pa[3])) + ((pb[0] + pb[1]) + (pb[2] + pb[3]));
            const float t2 = __shfl_xor(t, 1); t = (tid_ & 1) ? (t2 + t) : (t + t2);
            if ((tid_ & 1) == 0) ((LAS float*)rstab)[tid_ >> 1] = __builtin_amdgcn_rsqf(t * (1.0f / DM) + NORM_EPS);
            asm volatile("s_waitcnt lgkmcnt(0)" ::: "memory"); __builtin_amdgcn_s_barrier(); asm volatile("" ::: "memory");
        }
        float* op0 = OUT + (size_t)row0 * DM + col0;
#pragma unroll
        for (int bj = 0; bj < 2; ++bj) {
            const f32x4 g0 = gld<f32x4>(gain + col0 + bj * HALF), g1 = gld<f32x4>(gain + col0 + bj * HALF + 4);
#pragma unroll
            for (int ai = 0; ai < 2; ++ai)
#pragma unroll
                for (int m = 0; m < 4; ++m) {
                    const float rs = rstab[ai * HALF + wr * 64 + m * 16 + fr];
                    float* op = op0 + (size_t)(ai * HALF + m * 16) * DM + bj * HALF;
                    __builtin_nontemporal_store(acc[ai][bj][m][0] * rs * g0, (GAS f32x4*)op); __builtin_nontemporal_store(acc[ai][bj][m][1] * rs * g1, (GAS f32x4*)(op + 4));
                }
        }
        return true;
    }
};

struct Args { const float* in[23]; float* out; unsigned char* ws; int ph_lo, ph_hi, li, pad; };
enum { I_X = 0, I_NMIX, I_WIN, I_BGATE, I_SINK, I_WAO, I_CONVW, I_WCO, I_ARE, I_AIM, I_BRE, I_BIM, I_CRE, I_CIM, I_SD, I_LOGDT, I_WGLU, I_WSO, I_WMIX, I_NFFN, I_WFI, I_WFO, I_NFIN };
constexpr int PH_PER_LAYER = 7, PH_L0 = 2, PH_FINAL = PH_L0 + DEPTH * PH_PER_LAYER, N_PHASES = PH_FINAL + 1;
constexpr int N_WITEMS = 8576;

struct Frame {
    LAS unsigned char* lds;
    int tid, lane, wave, G;
    unsigned char* ws;
};

__device__ __forceinline__ void transpose_item(const float* W, int K, int N, bf16_t* WT, int kb, int nb, int drow0, const float* kscale, LAS float* scr, int lane) {
    const int k0 = 64 * kb, n0 = 32 * nb, c = lane & 7;
    f32x4 s0 = {1.f, 1.f, 1.f, 1.f}, s1 = {1.f, 1.f, 1.f, 1.f};
    if (kscale) { s0 = *(const f32x4*)(kscale + k0 + 8 * c); s1 = *(const f32x4*)(kscale + k0 + 8 * c + 4); }
    const float* src = W + (size_t)(k0 + (lane >> 5)) * N + n0 + (lane & 31);
    float w[32];
#pragma unroll
    for (int i = 0; i < 32; ++i) w[i] = __builtin_nontemporal_load(src + (size_t)(2 * i) * N);
#pragma unroll
    for (int i = 0; i < 32; ++i) scr[(2 * i + (lane >> 5)) * 33 + (lane & 31)] = w[i];
    asm volatile("s_waitcnt lgkmcnt(0)" ::: "memory");
#pragma unroll
    for (int j = 0; j < 4; ++j) { const int n = (lane >> 3) + 8 * j; const LAS float* s = scr + (8 * c) * 33 + n;
        u32x4 o; o.x = pk2(s[0 * 33] * s0[0], s[1 * 33] * s0[1]); o.y = pk2(s[2 * 33] * s0[2], s[3 * 33] * s0[3]); o.z = pk2(s[4 * 33] * s1[0], s[5 * 33] * s1[1]); o.w = pk2(s[6 * 33] * s1[2], s[7 * 33] * s1[3]);
        *(u32x4*)(WT + (size_t)(drow0 + n) * K + k0 + 8 * c) = o; }
    asm volatile("s_waitcnt lgkmcnt(0)" ::: "memory");
}

__device__ __forceinline__ void prep_global(Frame& F, const Args& a) {
    F.tid = opaque_tid(F.wave); F.lane = F.tid & 63;
    float* rc = (float*)(F.ws + WS_ROPE); float* rsn = rc + SEQ * 8;
    const int gt = blockIdx.x * NTHREADS + F.tid, NT = F.G * NTHREADS;
    for (int i = gt; i < SEQ * 8; i += NT) {
        const int pos = i >> 3, j = i & 7;
        const float invf = (float)exp(-(double)(2 * j) / 16.0 * log(500000.0));
        const float ang = (float)pos * invf;
        double s, c; sincos((double)ang, &s, &c);
        rc[i] = (float)c; rsn[i] = (float)s;
    }
    for (int it = gt; it < DEPTH * 32 * 64 * 17; it += NT) {
        const int i = it / 17, k = it - i * 17;
        const int l = i >> 11, gp = i & 2047, g = gp >> 6;
        const double dt = exp((double)a.in[I_LOGDT][l * 32 + g]);
        const double ar = (double)a.in[I_ARE][i], aim = (double)a.in[I_AIM][i];
        const double mg = exp(ar * dt * k); double s2, c2; sincos(aim * dt * k, &s2, &c2);
        float* pw = (float*)(F.ws + WS_SSM + (size_t)l * SO_LAYER + SO_POW) + (size_t)gp * 34;
        pw[2 * k] = (float)(mg * c2); pw[2 * k + 1] = (float)(mg * s2);
        if (k == 1) {
            const double lr = mg * c2, li = mg * s2;
            const double nr = lr - 1.0, ni = li, den = ar * ar + aim * aim;
            const double cr = (nr * ar + ni * aim) / den, ci = (ni * ar - nr * aim) / den;
            float* lam = (float*)(F.ws + WS_SSM + (size_t)l * SO_LAYER + SO_LAM); float* bb = (float*)(F.ws + WS_SSM + (size_t)l * SO_LAYER + SO_BBAR);
            lam[gp * 2] = (float)lr; lam[gp * 2 + 1] = (float)li;
            const float* bre = a.in[I_BRE] + (size_t)i * 16; const float* bim = a.in[I_BIM] + (size_t)i * 16;
            for (int h = 0; h < 16; ++h) { const double br = bre[h], bi = bim[h]; bb[(gp * 16 + h) * 2] = (float)(cr * br - ci * bi); bb[(gp * 16 + h) * 2 + 1] = (float)(cr * bi + ci * br); }
        }
    }
    const int gw = blockIdx.x * NWAVES + F.wave, NGW = F.G * NWAVES;
    const float* x = a.in[I_X]; bf16_t* xb = (bf16_t*)(F.ws + WS_XBF); float* ss = (float*)(F.ws + WS_ROWSS);
    for (int r0 = gw; r0 < MTOK; r0 += 4 * NGW) {
        f32x4 v[4][4];
#pragma unroll
        for (int q = 0; q < 4; ++q) { const int r = min(r0 + q * NGW, MTOK - 1); const f32x4* xr = (const f32x4*)(x + (size_t)r * DM) + F.lane;
#pragma unroll
            for (int j = 0; j < 4; ++j) v[q][j] = __builtin_nontemporal_load(xr + 64 * j); }
#pragma unroll
        for (int q = 0; q < 4; ++q) {
            const int r = r0 + q * NGW;
            if (r < MTOK) {
                u32x2* ob = (u32x2*)(xb + (size_t)r * DM) + F.lane;
                float s = 0.f;
#pragma unroll
                for (int j = 0; j < 4; ++j) { const f32x4 t = v[q][j]; s += t[0] * t[0] + t[1] * t[1] + t[2] * t[2] + t[3] * t[3]; u32x2 w; w.x = pk2(t[0], t[1]); w.y = pk2(t[2], t[3]); ob[64 * j] = w; }
                s = wave_sum(s);
                if (F.lane < 16) ss[(size_t)r * 16 + F.lane] = (F.lane == 0) ? s : 0.f;
            }
        }
    }
}

__device__ __forceinline__ void prep_weights(Frame& F, const Args& a, int l, int it_lo, int it_hi, int gw, int ngw) {
    F.tid = opaque_tid(F.wave); F.lane = F.tid & 63;
    bf16_t* W = (bf16_t*)(F.ws + WS_W + (size_t)(l & 1) * W_BUF);
    LAS float* scr = (LAS float*)(F.lds + F.wave * 16384);
    const float* w_in = a.in[I_WIN] + (size_t)l * DM * INCOLS; const float* w_ao = a.in[I_WAO] + (size_t)l * 512 * DM; const float* w_co = a.in[I_WCO] + (size_t)l * 512 * DM;
    const float* w_gl = a.in[I_WGLU] + (size_t)l * 512 * 512; const float* w_so = a.in[I_WSO] + (size_t)l * 512 * DM; const float* w_mx = a.in[I_WMIX] + (size_t)l * DM * DM;
    const float* w_fi = a.in[I_WFI] + (size_t)l * DM * FFN2; const float* w_fo = a.in[I_WFO] + (size_t)l * FFN * DM;
    const float* nmix = a.in[I_NMIX] + l * DM; const float* nffn = a.in[I_NFFN] + l * DM;
    constexpr int I0 = 16 * 184, I1 = 8 * 32, I2 = 8 * 32, I3 = 8 * 16, I4 = 8 * 32, I5 = 16 * 32, I6 = 16 * 176, I7 = 44 * 32;
    static_assert(I0 + I1 + I2 + I3 + I4 + I5 + I6 + I7 == N_WITEMS, "weight items");
    for (int it = it_lo + gw; it < it_hi; it += ngw) {
        int r = it;
        if (r < I0) { const int kb = r / 184, nb = r % 184, n0 = 32 * nb; int d0 = n0;
            if (n0 >= C_CC && n0 < C_CX) { const int c = n0 - C_CC; d0 = 256 * (5 + c / 128) + (c % 128); }
            else if (n0 >= C_CX && n0 < C_U) { const int c = n0 - C_CX; d0 = 256 * (5 + c / 128) + 128 + (c % 128); }
            else if (n0 >= C_G && n0 < C_G + 1024) { const int c = n0 - C_G; d0 = 256 * (11 + c / 128) + (c % 128); }
            else if (n0 >= C_G + 1024 && n0 < C_G + 2048) { const int c = n0 - C_G - 1024; d0 = 256 * (11 + c / 128) + 128 + (c % 128); }
            transpose_item(w_in, DM, INCOLS, W + WO_IN, kb, nb, d0, nmix, scr, F.lane); continue; } r -= I0;
        if (r < I1) { const int kb = r / 32, nb = r % 32; transpose_item(w_ao, 512, DM, W + WO_AO, kb, nb, 32 * nb, nullptr, scr, F.lane); continue; } r -= I1;
        if (r < I2) { const int kb = r / 32, nb = r % 32; transpose_item(w_co, 512, DM, W + WO_CO, kb, nb, 32 * nb, nullptr, scr, F.lane); continue; } r -= I2;
        if (r < I3) { const int kb = r / 16, nb = r % 16; transpose_item(w_gl, 512, 512, W + WO_GLU, kb, nb, 32 * nb, nullptr, scr, F.lane); continue; } r -= I3;
        if (r < I4) { const int kb = r / 32, nb = r % 32; transpose_item(w_so, 512, DM, W + WO_SO, kb, nb, 32 * nb, nullptr, scr, F.lane); continue; } r -= I4;
        if (r < I5) { const int kb = r / 32, nb = r % 32; transpose_item(w_mx, DM, DM, W + WO_MIX, kb, nb, 32 * nb, nullptr, scr, F.lane); continue; } r -= I5;
        if (r < I6) { const int kb = r / 176, nb = r % 176; const int n0 = 32 * nb; const int j0 = n0 < FFN ? n0 : n0 - FFN; const int drow0 = 256 * (j0 / 128) + (n0 < FFN ? 0 : 128) + (j0 % 128);
            transpose_item(w_fi, DM, FFN2, W + WO_FI, kb, nb, drow0, nffn, scr, F.lane); continue; } r -= I6;
        { const int kb = r / 32, nb = r % 32; transpose_item(w_fo, FFN, DM, W + WO_FO, kb, nb, 32 * nb, nullptr, scr, F.lane); }
    }
}

__device__ __forceinline__ void prep_ssm(Frame& F, const Args& a, int l, int item_lo, int item_step) {
    F.tid = opaque_tid(F.wave); F.lane = F.tid & 63;
    __syncthreads();
    {
        LAS float* pw = (LAS float*)(F.lds);
        LAS float* cC = pw + 64 * 34;
        LAS float* bB = cC + 16 * 64 * 2;
        LAS float* kd = bB + 64 * 16 * 2;
        unsigned char* smm = F.ws + WS_SSMM + (size_t)(l & 1) * SSMM_BUF;
        bf16_t* WY = (bf16_t*)(smm + SM_WY); bf16_t* GT = (bf16_t*)(smm + SM_GT); float* L16 = (float*)(smm + SM_L16);
        const int tid = F.tid;
        for (int item = item_lo; item < 256; item += item_step) {
            const int g = item >> 3, part = item & 7;
            const float* gpw = (const float*)(F.ws + WS_SSM + (size_t)l * SO_LAYER + SO_POW) + (size_t)g * 64 * 34;
            const float* gbb = (const float*)(F.ws + WS_SSM + (size_t)l * SO_LAYER + SO_BBAR) + (size_t)g * 64 * 32;
            const float* gcr = a.in[I_CRE] + (size_t)(l * 32 + g) * 1024; const float* gci = a.in[I_CIM] + (size_t)(l * 32 + g) * 1024;
            for (int i = tid; i < 64 * 34; i += NTHREADS) pw[i] = gpw[i];
            for (int i = tid; i < 2048; i += NTHREADS) bB[i] = gbb[i];
            for (int i = tid; i < 1024; i += NTHREADS) { cC[2 * i] = gcr[i]; cC[2 * i + 1] = gci[i]; }
            __syncthreads();
            {
                const int dd = tid >> 8, h = (tid >> 4) & 15, h2 = tid & 15, d = 2 * part + dd;
                float a0 = 0.f, a1 = 0.f, a2 = 0.f, a3 = 0.f;
#pragma unroll 4
                for (int p = 0; p < 64; p += 4) {
#pragma unroll
                    for (int u = 0; u < 4; ++u) {
                        const f32x2 c = *(const LAS f32x2*)(cC + (h * 64 + p + u) * 2), w = *(const LAS f32x2*)(pw + (p + u) * 34 + 2 * d), bv = *(const LAS f32x2*)(bB + ((p + u) * 16 + h2) * 2);
                        const float tr = c[0] * w[0] - c[1] * w[1], ti = c[0] * w[1] + c[1] * w[0];
                        const float t = tr * bv[0] - ti * bv[1];
                        if (u == 0) a0 += t; else if (u == 1) a1 += t; else if (u == 2) a2 += t; else a3 += t;
                    }
                }
                float acc = (a0 + a1) + (a2 + a3);
                if (d == 0 && h == h2) acc += a.in[I_SD][l * 512 + g * 16 + h];
                kd[tid] = acc;
            }
            __syncthreads();
            for (int dd = 0; dd < 2; ++dd) {
                const int d = 2 * part + dd, nblk = 16 - d;
                for (int it = tid; it < nblk * 32; it += NTHREADS) {
                    const int bi = it >> 5, r = (it >> 1) & 15, hc = it & 1, tau = d + bi, sI = bi;
                    float v[8];
#pragma unroll
                    for (int j = 0; j < 8; ++j) v[j] = kd[(dd * 16 + r) * 16 + hc * 8 + j];
                    *(u32x4*)(WY + ((size_t)g * 256 + tau * 16 + r) * 384 + sI * 16 + hc * 8) = pack8(v);
                }
            }
            if (tid < 32) { const int r = tid >> 1, hc = tid & 1; unsigned zz = 0u; asm volatile("" : "+v"(zz)); u32x4 z; z.x = zz; z.y = zz; z.z = zz; z.w = zz;
                *(u32x4*)(WY + ((size_t)g * 256 + (2 * part) * 16 + r) * 384 + (2 * part + 1) * 16 + hc * 8) = z; }
            {
                const int r = tid >> 4, kc = tid & 15, n = part * 32 + r, tau = n >> 4, h = n & 15, q = kc * 8; const bool im = q >= 64; const int p0 = im ? q - 64 : q;
                float v[8];
#pragma unroll
                for (int j = 0; j < 8; ++j) { const int p = p0 + j; const float cr = cC[(h * 64 + p) * 2], ci = cC[(h * 64 + p) * 2 + 1], pr = pw[p * 34 + 2 * (tau + 1)], pi = pw[p * 34 + 2 * (tau + 1) + 1];
                    v[j] = im ? -(cr * pi + ci * pr) : (cr * pr - ci * pi); }
                *(u32x4*)(WY + ((size_t)g * 256 + n) * 384 + 256 + q) = pack8(v);
            }
            {
                const int r = tid >> 5, kc = tid & 31, k0 = kc * 8, n = part * 16 + r, sI = k0 >> 4, h0 = k0 & 15, p = n & 63; const bool im = n >= 64;
                const float pr = pw[p * 34 + 2 * (15 - sI)], pi = pw[p * 34 + 2 * (15 - sI) + 1];
                float v[8];
#pragma unroll
                for (int j = 0; j < 8; ++j) { const float br = bB[(p * 16 + h0 + j) * 2], bi = bB[(p * 16 + h0 + j) * 2 + 1]; v[j] = im ? (pr * bi + pi * br) : (pr * br - pi * bi); }
                *(u32x4*)(GT + ((size_t)g * 128 + n) * 256 + k0) = pack8(v);
            }
            if (part == 0 && tid < 64) { L16[(g * 64 + tid) * 2] = pw[tid * 34 + 32]; L16[(g * 64 + tid) * 2 + 1] = pw[tid * 34 + 33]; }
            __syncthreads();
        }
    }
}


typedef float f32x16 __attribute__((ext_vector_type(16)));
constexpr int UX_PITCH = 784, SSM_S_OFF = 64 * UX_PITCH;

constexpr int AT_KPITCH = 144, AT_VPITCH = 520, AT_VT_OFF = 256 * AT_KPITCH;

constexpr int CONVW_OFF = RING_BYTES + 8192;
__device__ __forceinline__ void conv_item(const bf16_t* CB, const bf16_t* ZC, bf16_t* CA, const LAS float* cw, int it) {
    const int row = it >> 6, c0 = (it & 63) * 8, t = row & (SEQ - 1);
    const size_t o = (size_t)row * 512 + c0;
    const size_t o1 = (t >= 1) ? o - 512 : o, o2 = (t >= 2) ? o - 1024 : o;
    const u32x4 vb = *(const u32x4*)(CB + o), vz0 = *(const u32x4*)(ZC + o), vz1 = *(const u32x4*)(ZC + o1), vz2 = *(const u32x4*)(ZC + o2);
    float cb[8], z0[8], z1[8], z2[8];
    unpack8(vb, cb); unpack8(vz0, z0); unpack8(vz1, z1); unpack8(vz2, z2);
    const float m1 = (t >= 1) ? 1.f : 0.f, m2 = (t >= 2) ? 1.f : 0.f;
    float v[8];
#pragma unroll
    for (int e = 0; e < 8; ++e) v[e] = cb[e] * (cw[c0 + e] * (z2[e] * m2) + cw[512 + c0 + e] * (z1[e] * m1) + cw[1024 + c0 + e] * z0[e]);
    *(u32x4*)(CA + o) = pack8(v);
}

template <int NB>
__device__ __forceinline__ void conv_batch(const bf16_t* CB, const bf16_t* ZC, bf16_t* CA, const LAS float* cw, int it0, int stride, int it_end) {
    u32x4 vb[NB], vz[NB][3];
#pragma unroll
    for (int k = 0; k < NB; ++k) {
        const int it = min(it0 + k * stride, it_end - 1);
        const int row = it >> 6, c0 = (it & 63) * 8, t = row & (SEQ - 1);
        const size_t o = (size_t)row * 512 + c0, o1 = (t >= 1) ? o - 512 : o, o2 = (t >= 2) ? o - 1024 : o;
        vb[k] = *(const u32x4*)(CB + o);
        vz[k][0] = *(const u32x4*)(ZC + o); vz[k][1] = *(const u32x4*)(ZC + o1); vz[k][2] = *(const u32x4*)(ZC + o2);
    }
#pragma unroll
    for (int k = 0; k < NB; ++k) {
        const int it = it0 + k * stride;
        if (it < it_end) {
            const int row = it >> 6, c0 = (it & 63) * 8, t = row & (SEQ - 1);
            float cb[8], z0[8], z1[8], z2[8];
            unpack8(vb[k], cb); unpack8(vz[k][0], z0); unpack8(vz[k][1], z1); unpack8(vz[k][2], z2);
            const float m1 = (t >= 1) ? 1.f : 0.f, m2 = (t >= 2) ? 1.f : 0.f;
            float v[8];
#pragma unroll
            for (int e = 0; e < 8; ++e) v[e] = cb[e] * (cw[c0 + e] * (z2[e] * m2) + cw[512 + c0 + e] * (z1[e] * m1) + cw[1024 + c0 + e] * z0[e]);
            *(u32x4*)(CA + (size_t)row * 512 + c0) = pack8(v);
        }
    }
}
__device__ __forceinline__ void conv_phase(Frame& F, const Args& a, int l, int blk, int nblk) {
    F.tid = opaque_tid(F.wave); F.lane = F.tid & 63;
    const bf16_t* CB = (const bf16_t*)(F.ws + WS_CB); const bf16_t* ZC = (const bf16_t*)(F.ws + WS_ZC);
    bf16_t* CA = (bf16_t*)(F.ws + WS_CA);
    LAS float* cw = (LAS float*)(F.lds + CONVW_OFF);
    for (int i = F.tid; i < 1536; i += NTHREADS) cw[i] = a.in[I_CONVW][l * 1536 + i];
    __syncthreads();
    const int per = (MTOK * 64 + nblk - 1) / nblk, lo = blk * per, hi = min(lo + per, MTOK * 64);
    for (int it0 = lo + F.tid; it0 < hi; it0 += 4 * NTHREADS) conv_batch<4>(CB, ZC, CA, cw, it0, NTHREADS, hi);
}

__device__ __forceinline__ void mixers_phase(Frame& F, const Args& a, int l, const bool do_conv) {
    F.tid = opaque_tid(F.wave); F.lane = F.tid & 63;
    const int tid = F.tid, lane = F.lane, wave = F.wave, l31 = lane & 31, hi = lane >> 5;
    const bf16_t* Q = (const bf16_t*)(F.ws + WS_Q); const bf16_t* Kb = (const bf16_t*)(F.ws + WS_K); const bf16_t* Vb = (const bf16_t*)(F.ws + WS_V);
    const bf16_t* CB = (const bf16_t*)(F.ws + WS_CB); const bf16_t* CC = (const bf16_t*)(F.ws + WS_ZC);
    const bf16_t* U = (const bf16_t*)(F.ws + WS_U);
    bf16_t* AO = (bf16_t*)(F.ws + WS_AO); bf16_t* YS = (bf16_t*)(F.ws + WS_YS); bf16_t* CA = (bf16_t*)(F.ws + WS_CA);
    const unsigned char* smm = F.ws + WS_SSMM + (size_t)(l & 1) * SSMM_BUF;
    const bf16_t* WY = (const bf16_t*)(smm + SM_WY); const bf16_t* GT = (const bf16_t*)(smm + SM_GT); const float* L16 = (const float*)(smm + SM_L16);
    LAS unsigned char* kl = F.lds; LAS unsigned char* vt = F.lds + AT_VT_OFF;
    LAS unsigned char* ux = F.lds; LAS float* S = (LAS float*)(F.lds + SSM_S_OFF);
    LAS float* cw = (LAS float*)(F.lds + CONVW_OFF);
    if (do_conv) for (int i = tid; i < 1536; i += NTHREADS) cw[i] = a.in[I_CONVW][l * 1536 + i];
    const int conv_per_blk = (MTOK * 64 + F.G - 1) / F.G;
    int conv_next = do_conv ? blockIdx.x * conv_per_blk : MTOK * 64; const int conv_end = do_conv ? min(conv_next + conv_per_blk, MTOK * 64) : MTOK * 64;
    const int n_units = (BATCH * 32 - (int)blockIdx.x + F.G - 1) / F.G;
    const int conv_per_slot = (conv_per_blk + 2 * n_units - 1) / (2 * n_units);
    for (int unit = blockIdx.x; unit < BATCH * 32; unit += F.G) {
        AMP_BEGIN(9);
        {
            const int b = unit & 7, n = unit >> 4, kvh = (unit >> 3) & 1;
            const int rowq0 = b * SEQ + n * 128, rowk0 = rowq0 - 128;
            const int hq = kvh * 4 + (wave >> 1);
            u32x4 kv[4], vv[4];
#pragma unroll
            for (int i = 0; i < 4; ++i) {
                const int v = tid + i * NTHREADS, key = v >> 3, dc = v & 7;
                const int rk = (n == 0 && key < 128) ? rowq0 : rowk0 + key;
                kv[i] = *(const u32x4*)(Kb + (size_t)rk * 128 + kvh * 64 + dc * 8);
                vv[i] = *(const u32x4*)(Vb + (size_t)rk * 128 + kvh * 64 + dc * 8);
            }
            bf16x8 qf[2][4];
#pragma unroll
            for (int sb = 0; sb < 2; ++sb)
#pragma unroll
                for (int ks = 0; ks < 4; ++ks) qf[sb][ks] = *(const bf16x8*)(Q + (size_t)(rowq0 + (wave & 1) * 64 + sb * 32 + l31) * 512 + hq * 64 + ks * 16 + hi * 8);
            const float sl = a.in[I_SINK][l * 8 + hq] * LOG2E;
#pragma unroll
            for (int i = 0; i < 4; ++i) {
                const int v = tid + i * NTHREADS, key = v >> 3, dc = v & 7;
                *(LAS u32x4*)(kl + key * AT_KPITCH + dc * 16) = kv[i];
                LAS bf16_t* vp = (LAS bf16_t*)(vt + (dc * 8) * AT_VPITCH + key * 2);
                vp[0 * (AT_VPITCH / 2)] = (bf16_t)(vv[i].x & 0xffffu); vp[1 * (AT_VPITCH / 2)] = (bf16_t)(vv[i].x >> 16);
                vp[2 * (AT_VPITCH / 2)] = (bf16_t)(vv[i].y & 0xffffu); vp[3 * (AT_VPITCH / 2)] = (bf16_t)(vv[i].y >> 16);
                vp[4 * (AT_VPITCH / 2)] = (bf16_t)(vv[i].z & 0xffffu); vp[5 * (AT_VPITCH / 2)] = (bf16_t)(vv[i].z >> 16);
                vp[6 * (AT_VPITCH / 2)] = (bf16_t)(vv[i].w & 0xffffu); vp[7 * (AT_VPITCH / 2)] = (bf16_t)(vv[i].w >> 16);
            }
            __syncthreads();
#pragma unroll
            for (int sb = 0; sb < 2; ++sb) {
                const int q0 = (wave & 1) * 64 + sb * 32;
                const size_t qrow = (size_t)(rowq0 + q0 + l31);
                f32x16 sc[5];
#pragma unroll
                for (int kt = 0; kt < 5; ++kt) {
                    f32x16 acc = {};
                    const LAS unsigned char* kp = kl + (q0 + 32 * kt + l31) * AT_KPITCH + hi * 16;
#pragma unroll
                    for (int ks = 0; ks < 4; ++ks) acc = __builtin_amdgcn_mfma_f32_32x32x16_bf16(*(const LAS bf16x8*)(kp + ks * 32), qf[sb][ks], acc, 0, 0, 0);
                    sc[kt] = acc;
                }
                const int dlt = l31 - 4 * hi;
                float mx = -1e30f;
#pragma unroll
                for (int kt = 0; kt < 5; ++kt) {
                    const bool tile_ok = (n > 0) || (q0 + 32 * kt >= 128);
#pragma unroll
                    for (int r = 0; r < 16; ++r) {
                        const int c0 = (r & 3) + 8 * (r >> 2);
                        const bool ok = (kt == 0) ? (tile_ok && c0 > dlt) : ((kt == 4) ? (tile_ok && c0 <= dlt) : tile_ok);
                        const float v = ok ? sc[kt][r] : -1e30f;
                        sc[kt][r] = v; mx = fmaxf(mx, v);
                    }
                }
                mx = fmaxf(mx, __shfl_xor(mx, 32));
                mx = fmaxf(mx, sl);
                float ls = 0.f;
#pragma unroll
                for (int kt = 0; kt < 5; ++kt)
#pragma unroll
                    for (int r = 0; r < 16; ++r) { const float p = __builtin_amdgcn_exp2f(sc[kt][r] - mx); sc[kt][r] = p; ls += p; }
                ls += __shfl_xor(ls, 32);
                ls += __builtin_amdgcn_exp2f(sl - mx);
                f32x16 o0 = {}, o1 = {};
#pragma unroll
                for (int kt = 0; kt < 5; ++kt)
#pragma unroll
                    for (int s2 = 0; s2 < 2; ++s2) {
                        u32x4 pw; pw.x = pk2(sc[kt][8 * s2 + 0], sc[kt][8 * s2 + 1]); pw.y = pk2(sc[kt][8 * s2 + 2], sc[kt][8 * s2 + 3]); pw.z = pk2(sc[kt][8 * s2 + 4], sc[kt][8 * s2 + 5]); pw.w = pk2(sc[kt][8 * s2 + 6], sc[kt][8 * s2 + 7]);
                        const bf16x8 pf = __builtin_bit_cast(bf16x8, pw);
                        const int col = q0 + 32 * kt + 16 * s2 + 4 * hi;
                        const LAS unsigned char* vp0 = vt + l31 * AT_VPITCH + col * 2;
                        const LAS unsigned char* vp1 = vp0 + 32 * AT_VPITCH;
                        const u32x2 a0 = *(const LAS u32x2*)(vp0), a1 = *(const LAS u32x2*)(vp0 + 16);
                        const u32x2 c0 = *(const LAS u32x2*)(vp1), c1 = *(const LAS u32x2*)(vp1 + 16);
                        u32x4 va; va.x = a0.x; va.y = a0.y; va.z = a1.x; va.w = a1.y;
                        u32x4 vc; vc.x = c0.x; vc.y = c0.y; vc.z = c1.x; vc.w = c1.y;
                        o0 = __builtin_amdgcn_mfma_f32_32x32x16_bf16(__builtin_bit_cast(bf16x8, va), pf, o0, 0, 0, 0);
                        o1 = __builtin_amdgcn_mfma_f32_32x32x16_bf16(__builtin_bit_cast(bf16x8, vc), pf, o1, 0, 0, 0);
                    }
                const float inv = __builtin_amdgcn_rcpf(ls);
                bf16_t* op = AO + qrow * 512 + hq * 64 + 4 * hi;
#pragma unroll
                for (int qd = 0; qd < 4; ++qd) {
                    u32x2 w0; w0.x = pk2(o0[4 * qd] * inv, o0[4 * qd + 1] * inv); w0.y = pk2(o0[4 * qd + 2] * inv, o0[4 * qd + 3] * inv);
                    u32x2 w1; w1.x = pk2(o1[4 * qd] * inv, o1[4 * qd + 1] * inv); w1.y = pk2(o1[4 * qd + 2] * inv, o1[4 * qd + 3] * inv);
                    *(u32x2*)(op + 8 * qd) = w0; *(u32x2*)(op + 32 + 8 * qd) = w1;
                }
            }
        }
        AMP_END(9);
        AMP_BEGIN(10);
        {
            const int b = unit & 7, g = unit >> 3;
            const bf16_t* ug = U + (size_t)(b * 32 + g) * SEQ * 16;
            const bf16_t* wy = WY + (size_t)g * 256 * 384; const bf16_t* gt = GT + (size_t)g * 128 * 256;
            u32x4 ur[4];
#pragma unroll
            for (int i = 0; i < 4; ++i) ur[i] = ((const u32x4*)ug)[tid + i * NTHREADS];
            const int rb = wave >> 2, cb = wave & 3;
            float xr = 0.f, xi = 0.f, lr = 0.f, li = 0.f;
            { lr = L16[(g * 64 + lane) * 2]; li = L16[(g * 64 + lane) * 2 + 1]; }
            __syncthreads();
#pragma unroll 1
            for (int half = 0; half < 2; ++half) {
                bf16x8 gfr[16];
                { const bf16_t* bp = gt + (size_t)(cb * 32 + l31) * 256 + hi * 8;
#pragma unroll
                  for (int ks = 0; ks < 16; ++ks) gfr[ks] = *(const bf16x8*)(bp + ks * 16); }
#pragma unroll
                for (int i = 0; i < 4; ++i) { const int v = tid + i * NTHREADS, c = v >> 5, kc = v & 31; *(LAS u32x4*)(ux + c * UX_PITCH + kc * 16) = ur[i]; }
                if (half == 0) {
#pragma unroll
                    for (int i = 0; i < 4; ++i) ur[i] = ((const u32x4*)(ug + (size_t)1024 * 16))[tid + i * NTHREADS];
                }
                __syncthreads();
                {
                    f32x16 acc = {};
                    const LAS unsigned char* ap = ux + (rb * 32 + l31) * UX_PITCH + hi * 16;
#pragma unroll
                    for (int ks = 0; ks < 16; ++ks) acc = __builtin_amdgcn_mfma_f32_32x32x16_bf16(*(const LAS bf16x8*)(ap + ks * 32), gfr[ks], acc, 0, 0, 0);
#pragma unroll
                    for (int r = 0; r < 16; ++r) S[(rb * 32 + (r & 3) + 8 * (r >> 2) + 4 * hi) * 128 + cb * 32 + l31] = acc[r];
                }
                bf16x8 afr[24];
                { const bf16_t* ap = wy + (size_t)(wave * 32 + l31) * 384 + hi * 8;
#pragma unroll
                  for (int ks = 0; ks < 24; ++ks) if (ks >= 16 || ks <= 2 * wave + 1) afr[ks] = *(const bf16x8*)(ap + ks * 16); else afr[ks] = (bf16x8){0, 0, 0, 0, 0, 0, 0, 0}; }
                __syncthreads();
                if (!do_conv) {
                    const f32x2 L1 = {lr, lr}, L2 = {-li, li};
                    f32x2 P[8]; f32x2 A = {0.f, 0.f};
#pragma unroll
                    for (int q = 0; q < 8; ++q) {
                        f32x2 sv; sv[0] = S[(8 * wave + q) * 128 + lane]; sv[1] = S[(8 * wave + q) * 128 + 64 + lane];
                        P[q] = A;
                        const f32x2 As = __builtin_shufflevector(A, A, 1, 0);
                        A = L1 * A + sv; A = L2 * As + A;
                    }
                    LAS float* T = S + 64 * 128;
                    T[wave * 128 + lane] = A[0]; T[wave * 128 + 64 + lane] = A[1];
                    float pr = lr, pi = li;
#pragma unroll
                    for (int k = 0; k < 3; ++k) { const float nr = pr * pr - pi * pi, ni = 2.f * pr * pi; pr = nr; pi = ni; }
                    const f32x2 M1 = {pr, pr}, M2 = {-pi, pi};
                    __syncthreads();
                    f32x2 C = {xr, xi}, Cw = C;
#pragma unroll
                    for (int j = 0; j < 8; ++j) {
                        if (j == wave) Cw = C;
                        f32x2 tv; tv[0] = T[j * 128 + lane]; tv[1] = T[j * 128 + 64 + lane];
                        const f32x2 Cs = __builtin_shufflevector(C, C, 1, 0);
                        C = M1 * C + tv; C = M2 * Cs + C;
                    }
                    xr = C[0]; xi = C[1];
                    f32x2 Y = Cw;
#pragma unroll
                    for (int q = 0; q < 8; ++q) {
                        const f32x2 X = Y + P[q];
                        const unsigned w = pk2(X[0], X[1]);
                        *(LAS bf16_t*)(ux + (8 * wave + q) * UX_PITCH + (256 + lane) * 2) = (bf16_t)(w & 0xffffu);
                        *(LAS bf16_t*)(ux + (8 * wave + q) * UX_PITCH + (320 + lane) * 2) = (bf16_t)(w >> 16);
                        const f32x2 Ys = __builtin_shufflevector(Y, Y, 1, 0);
                        Y = L1 * Y; Y = L2 * Ys + Y;
                    }
                } else if (wave == 0) {
                    f32x2 X = {xr, xi}; const f32x2 L1 = {lr, lr}, L2 = {-li, li};
                    f32x2 sn[8];
#pragma unroll
                    for (int q = 0; q < 8; ++q) { sn[q][0] = S[q * 128 + lane]; sn[q][1] = S[q * 128 + 64 + lane]; }
#pragma unroll 1
                    for (int c0 = 0; c0 < 64; c0 += 8) {
                        f32x2 sv[8];
#pragma unroll
                        for (int q = 0; q < 8; ++q) sv[q] = sn[q];
                        const int cn = (c0 + 8) & 63;
#pragma unroll
                        for (int q = 0; q < 8; ++q) { sn[q][0] = S[(cn + q) * 128 + lane]; sn[q][1] = S[(cn + q) * 128 + 64 + lane]; }
#pragma unroll
                        for (int q = 0; q < 8; ++q) {
                            const unsigned w = pk2(X[0], X[1]);
                            *(LAS bf16_t*)(ux + (c0 + q) * UX_PITCH + (256 + lane) * 2) = (bf16_t)(w & 0xffffu);
                            *(LAS bf16_t*)(ux + (c0 + q) * UX_PITCH + (320 + lane) * 2) = (bf16_t)(w >> 16);
                            const f32x2 Xs = __builtin_shufflevector(X, X, 1, 0);
                            X = L1 * X + sv[q];
                            X = L2 * Xs + X;
                        }
                    }
                    xr = X[0]; xi = X[1];
                } else {
                    const int slot_end = min(conv_next + conv_per_slot, conv_end);
                    for (int it = conv_next + (tid - 64); it < slot_end; it += NTHREADS - 64) conv_item(CB, CC, CA, cw, it);
                }
                conv_next = min(conv_next + conv_per_slot, conv_end);
                __syncthreads();
                {
                    f32x16 acc0 = {}, acc1 = {};
                    const LAS unsigned char* bp0 = ux + l31 * UX_PITCH + hi * 16;
                    const LAS unsigned char* bp1 = bp0 + 32 * UX_PITCH;
#pragma unroll
                    for (int ks = 0; ks < 24; ++ks) {
                        if (ks < 16 && ks > 2 * wave + 1) continue;
                        const bf16x8 b0 = *(const LAS bf16x8*)(bp0 + ks * 32);
                        const bf16x8 b1 = *(const LAS bf16x8*)(bp1 + ks * 32);
                        acc0 = __builtin_amdgcn_mfma_f32_32x32x16_bf16(afr[ks], b0, acc0, 0, 0, 0);
                        acc1 = __builtin_amdgcn_mfma_f32_32x32x16_bf16(afr[ks], b1, acc1, 0, 0, 0);
                    }
#pragma unroll
                    for (int cbk = 0; cbk < 2; ++cbk) {
                        unsigned wx[4], wy[4];
#pragma unroll
                        for (int q = 0; q < 4; ++q) {
                            float y0, y1, y2, y3;
                            if (cbk == 0) { y0 = acc0[4 * q]; y1 = acc0[4 * q + 1]; y2 = acc0[4 * q + 2]; y3 = acc0[4 * q + 3]; } else { y0 = acc1[4 * q]; y1 = acc1[4 * q + 1]; y2 = acc1[4 * q + 2]; y3 = acc1[4 * q + 3]; }
                            wx[q] = pk2(gelu_tanh(y0), gelu_tanh(y1)); wy[q] = pk2(gelu_tanh(y2), gelu_tanh(y3));
                        }
                        const auto s0x = __builtin_amdgcn_permlane32_swap(wx[0], wx[2], false, false), s0y = __builtin_amdgcn_permlane32_swap(wy[0], wy[2], false, false);
                        const auto s1x = __builtin_amdgcn_permlane32_swap(wx[1], wx[3], false, false), s1y = __builtin_amdgcn_permlane32_swap(wy[1], wy[3], false, false);
                        u32x4 lo4, hi4; lo4.x = s0x[0]; lo4.y = s0y[0]; lo4.z = s0x[1]; lo4.w = s0y[1]; hi4.x = s1x[0]; hi4.y = s1y[0]; hi4.z = s1x[1]; hi4.w = s1y[1];
                        const size_t row = (size_t)b * SEQ + half * 1024 + 16 * (cbk * 32 + l31) + 2 * wave + hi;
                        *(u32x4*)(YS + row * 512 + g * 16) = lo4; *(u32x4*)(YS + row * 512 + g * 16 + 8) = hi4;
                    }
                }
                __syncthreads();
            }
        }
        AMP_END(10);
    }
    for (int it = conv_next + tid; it < conv_end; it += NTHREADS) conv_item(CB, CC, CA, cw, it);
}

__device__ __forceinline__ void final_norm(Frame& F, const Args& a) {
    F.tid = opaque_tid(F.wave); F.lane = F.tid & 63;
    const int gw = blockIdx.x * NWAVES + F.wave, NGW = F.G * NWAVES;
    const float* ss = (const float*)(F.ws + WS_ROWSS); const float* gn = a.in[I_NFIN];
    const bf16_t* XB = (const bf16_t*)(F.ws + WS_XBF);
    for (int r = gw; r < MTOK; r += NGW) {
        const float rs = row_rs(ss, r);
        u32x2 hv[4];
#pragma unroll
        for (int j = 0; j < 4; ++j) hv[j] = *(const u32x2*)(XB + (size_t)r * DM + 256 * j + 4 * F.lane);
        f32x4* xr = (f32x4*)(a.out + (size_t)r * DM) + F.lane; const f32x4* gp = (const f32x4*)gn + F.lane;
#pragma unroll
        for (int j = 0; j < 4; ++j) { const f32x4 gg = gp[64 * j]; f32x4 v; v[0] = bflo(hv[j].x); v[1] = bfhi(hv[j].x); v[2] = bflo(hv[j].y); v[3] = bfhi(hv[j].y);
            xr[64 * j] = v * rs * gg; }
    }
}

#ifndef REP_INPROJ
#define REP_INPROJ 1
#endif
#ifndef REP_MIXERS
#define REP_MIXERS 1
#endif
#ifndef REP_FFNIN
#define REP_FFNIN 1
#endif
#ifndef REP_BAR
#define REP_BAR 1
#endif
#ifndef REP_MIXO
#define REP_MIXO 1
#endif
#ifndef REP_FFNOUT
#define REP_FFNOUT 1
#endif
#ifndef REP_MERGE
#define REP_MERGE 1
#endif
#define RUN_GEMM(g, S, E, acc, fresh) pg8::gemm_phase<decltype(E), true, true, pg8::NoHook>(F.lds, g, S, E, acc, fresh, pg8::NoHook{}, F.wave)
__global__ void __launch_bounds__(NTHREADS, 2) fwd_kernel(Args args) {
    extern __shared__ __attribute__((aligned(16))) unsigned char lds[];
    Frame F;
    F.lds = (LAS unsigned char*)lds; F.tid = threadIdx.x; F.lane = F.tid & 63; F.wave = __builtin_amdgcn_readfirstlane(F.tid >> 6); F.G = gridDim.x; F.ws = args.ws;
    const int lo = args.ph_lo, hi = args.ph_hi;
#define IN(k) (lo <= (k) && (k) < hi)
#define SEAM(k) do { if (IN(k) && IN((k) + 1)) { for (int rb_ = 0; rb_ < REP_BAR; ++rb_) xcd_barrier(bar); } } while (0)
#define SEAM_X(k) do { if (IN(k) && IN((k) + 1)) { for (int rb_ = 0; rb_ < REP_BAR; ++rb_) xcd_barrier(bar, 1); } } while (0)
#define SEAM_G(k) do { if (IN(k) && IN((k) + 1)) { for (int rb_ = 0; rb_ < REP_BAR; ++rb_) xcd_barrier(bar, 2); } } while (0)
#define REPEAT(n) for (int rep_ = 0; rep_ < (n); ++rep_, (rep_ < (n) ? xcd_barrier(bar) : (void)0))
    for (int u = F.tid; u < (LDS_BYTES - RING_BYTES) / 4; u += NTHREADS) ((LAS unsigned*)(F.lds + RING_BYTES))[u] = 0u;
    __syncthreads();
    XcdBarrier bar; bar.bar = (unsigned*)(args.ws + WS_CTL) + 4096; bar.x = 0; bar.st = (volatile LAS unsigned*)(F.lds + MISC_OFF); bar.wave = F.wave;
    if (hi - lo > 1) bar = xcd_barrier_post((unsigned*)(args.ws + WS_CTL) + 4096, (volatile LAS unsigned*)(F.lds + MISC_OFF), F.wave);
    unsigned char* ws0 = args.ws;
    unsigned* xcc_tbl = (unsigned*)(args.ws + WS_CTL) + 1024;
    if (hi - lo > 1 && xb_thread0(F.wave)) __hip_atomic_store(&xcc_tbl[blockIdx.x], xb_xcc_id() + 1u, __ATOMIC_RELAXED, __HIP_MEMORY_SCOPE_AGENT);
    const int gwave = blockIdx.x * NWAVES + F.wave, ngwave = F.G * NWAVES;
    { AMP_BEGIN(0); if (IN(0)) { prep_global(F, args); prep_weights(F, args, 0, 0, N_WITEMS, gwave, ngwave); } AMP_END(0); }
    SEAM(0);
    if (IN(0) && IN(1) && F.G == 256 && lo == 0 && hi == N_PHASES) {
        const int ln = (int)__builtin_amdgcn_mbcnt_hi(~0u, __builtin_amdgcn_mbcnt_lo(~0u, 0u));
        const unsigned head = __hip_atomic_load(&xcc_tbl[ln & 7], __ATOMIC_RELAXED, __HIP_MEMORY_SCOPE_AGENT);
        bool ok = head != 0u;
#pragma unroll
        for (int k = 0; k < 4; ++k) ok = ok && (__hip_atomic_load(&xcc_tbl[64 * k + ln], __ATOMIC_RELAXED, __HIP_MEMORY_SCOPE_AGENT) == head);
        bar.local_ok = __builtin_amdgcn_readfirstlane((int)(__builtin_amdgcn_ballot_w64(ok) == ~0ull)) != 0;
    }
    if (IN(1)) { prep_ssm(F, args, 0, (int)blockIdx.x, F.G); __syncthreads(); }
    SEAM(1);

#pragma unroll 1
    for (int l = 0; l < DEPTH; ++l) {
        const int pb = PH_L0 + l * PH_PER_LAYER;
        unsigned char* ws = ws0; asm volatile("" : "+s"(ws));
        bf16_t* W = (bf16_t*)(ws + WS_W + (size_t)(l & 1) * W_BUF);
        bf16_t* XB = (bf16_t*)(ws + WS_XBF);
        float* ROWSS = (float*)(ws + WS_ROWSS);
        bf16_t* Q = (bf16_t*)(ws + WS_Q); bf16_t* Kb = (bf16_t*)(ws + WS_K); bf16_t* Vb = (bf16_t*)(ws + WS_V);
        bf16_t* CB = (bf16_t*)(ws + WS_CB); bf16_t* CC = (bf16_t*)(ws + WS_ZC); bf16_t* U = (bf16_t*)(ws + WS_U);
        bf16_t* MG = (bf16_t*)(ws + WS_MG); bf16_t* Z = (bf16_t*)(ws + WS_Z);
        bf16_t* GT = (bf16_t*)(ws + WS_GT); bf16_t* HD = (bf16_t*)(ws + WS_HD);
        bf16_t* AO = (bf16_t*)(ws + WS_AO); bf16_t* YS = (bf16_t*)(ws + WS_YS); bf16_t* CA = (bf16_t*)(ws + WS_CA);
        int bid = blockIdx.x, Gv = F.G; asm volatile("" : "+s"(bid), "+s"(Gv));
        const bool split = (Gv == 256) && IN(pb + 2) && IN(pb + 3);
        AMP_BEGIN(1);
        if (IN(pb + 0)) {
            pg8::Gemm g{XB, XB, XB, W + WO_IN, W + WO_IN, W + WO_IN, DM, 0}; pg8::StaticOrder S; S.init(MTOK, INCOLS, F.G, (int)blockIdx.x, 1);
            pg8::EpiInProj E{ROWSS, (const float*)(ws + WS_ROPE), (const float*)(ws + WS_ROPE) + SEQ * 8, args.in[I_BGATE] + l * 3072, Q, Kb, Vb, CB, CC, U, GT};
            if (l + 1 < DEPTH) { if (Gv == 256) { if (bid >= 192) { prep_ssm(F, args, l + 1, bid - 192, 64); __syncthreads(); } } else { prep_ssm(F, args, l + 1, bid, Gv); __syncthreads(); } }
            REPEAT(REP_INPROJ) { pg8::Acc acc; RUN_GEMM(g, S, E, acc, true); }
        }
        AMP_END(1);
        SEAM_X(pb + 0);
        AMP_BEGIN(2);
        if (IN(pb + 1)) REPEAT(REP_MIXERS) { mixers_phase(F, args, l, !split); }
        AMP_END(2);
        SEAM_X(pb + 1);
#define GLU_UNITS() do { \
            {     \
                pg8::Gemm g{YS, YS, YS, W + WO_GLU, W + WO_GLU, W + WO_GLU, 512, 0}; pg8::StaticOrder S; S.init(MTOK, 512, F.G, (int)blockIdx.x, 1); \
                pg8::EpiGlu E{nullptr, YS, Z}; \
                pg8::Acc acc; RUN_GEMM(g, S, E, acc, true); \
            } \
            if (split) { if (bid >= 128) { conv_phase(F, args, l, (bid & 7) * 16 + (((bid >> 3) & 7) * 2 + ((bid - 128) >> 6)), 128);        __syncthreads(); } }     \
            } while (0)
        if (split) REPEAT(REP_MERGE) {
            { AMP_BEGIN(3); GLU_UNITS(); AMP_END(3); }
            AMP_BEGIN(4);
            pg8::Gemm g{AO, CA, Z, W + WO_AO, W + WO_CO, W + WO_SO, 512, 0}; pg8::StaticOrder S; S.init(MTOK, DM, F.G, (int)blockIdx.x, 3);
            pg8::EpiMerge E{nullptr, GT, MG, 0};
            const BarrierHook H{&bar, 1};
            pg8::Acc acc; pg8::gemm_phase<pg8::EpiMerge, true, true, BarrierHook>(F.lds, g, S, E, acc, true, H, F.wave);
            AMP_END(4);
        } else {
            if (IN(pb + 2)) GLU_UNITS();
            SEAM(pb + 2);
            if (IN(pb + 3)) {
                pg8::Gemm g{AO, CA, Z, W + WO_AO, W + WO_CO, W + WO_SO, 512, 0}; pg8::StaticOrder S; S.init(MTOK, DM, F.G, (int)blockIdx.x, 3);
                pg8::EpiMerge E{nullptr, GT, MG, 0};
                pg8::Acc acc; RUN_GEMM(g, S, E, acc, true);
            }
        }
#undef GLU_UNITS
        SEAM_G(pb + 3);
        AMP_BEGIN(5);
        if (IN(pb + 4)) {
            pg8::Gemm g{MG, MG, MG, W + WO_MIX, W + WO_MIX, W + WO_MIX, DM, 0}; pg8::StaticOrder S; S.init(MTOK, DM, F.G, (int)blockIdx.x, 1);
            REPEAT(REP_MIXO) { pg8::EpiResid E{nullptr, args.in[I_X], XB, ROWSS + (size_t)MTOK * 16, l == 0 && rep_ == 0, rep_ + 1 < REP_MIXO}; pg8::Acc acc; RUN_GEMM(g, S, E, acc, true); }
        }
        AMP_END(5);
        SEAM_G(pb + 4);
        AMP_BEGIN(6);
        if (IN(pb + 5)) {
            pg8::Gemm g{XB, XB, XB, W + WO_FI, W + WO_FI, W + WO_FI, DM, 0}; pg8::StaticOrder S; S.init(MTOK, FFN2, F.G, (int)blockIdx.x, 1);
            pg8::EpiFfnIn E{ROWSS + (size_t)MTOK * 16, HD};
            if (l + 1 < DEPTH) {
                if (Gv == 256) { if (bid >= 128) { prep_weights(F, args, l + 1, 0, N_WITEMS, bid * NWAVES + F.wave - 1024, 1024); __syncthreads(); } } else { prep_weights(F, args, l + 1, 0, N_WITEMS, bid * NWAVES + F.wave, Gv * NWAVES); __syncthreads(); }
            }
            REPEAT(REP_FFNIN) { pg8::Acc acc; RUN_GEMM(g, S, E, acc, true); }
        }
        AMP_END(6);
        SEAM_G(pb + 5);
        AMP_BEGIN(7);
        const bool fuse_final = (l == DEPTH - 1) && IN(pb + 6) && IN(PH_FINAL) && (Gv == 256);
        if (IN(pb + 6)) {
            pg8::Gemm g{HD, HD, HD, W + WO_FO, W + WO_FO, W + WO_FO, FFN, HD_PITCH}; pg8::StaticOrder S; S.init(MTOK, DM, F.G, (int)blockIdx.x, 1);
            if (fuse_final) {
                EpiResidFinal E{nullptr, XB, args.out, ROWSS, args.in[I_NFIN], &bar};
                pg8::Acc acc; RUN_GEMM(g, S, E, acc, true);
            } else {
                REPEAT(REP_FFNOUT) { pg8::EpiResid E{nullptr, args.in[I_X], XB, ROWSS, false, rep_ + 1 < REP_FFNOUT}; pg8::Acc acc; RUN_GEMM(g, S, E, acc, true); }
            }
        }
        AMP_END(7);
        if (!fuse_final) SEAM(pb + 6);
    }
    { AMP_BEGIN(8); const bool final_fused = IN(PH_L0 + (DEPTH - 1) * PH_PER_LAYER + 6) && IN(PH_FINAL) && (F.G == 256); if (IN(PH_FINAL) && !final_fused) final_norm(F, args); AMP_END(8); }
#undef IN
}

extern "C" void kernel_launch(void* const* d_in, const int* in_sizes, int n_in, void* d_out, int out_size, void* d_ws, size_t ws_size, hipStream_t stream) {
    static int grid = 0;
    if (grid == 0) {
        if (n_in != 23 || out_size != MTOK * DM || ws_size < WS_END) { fprintf(stderr, "kernel_launch: unexpected shapes (n_in %d out %d ws %zu)\n", n_in, out_size, ws_size); grid = -1; return; }
        if (hipFuncSetAttribute((const void*)fwd_kernel, hipFuncAttributeMaxDynamicSharedMemorySize, LDS_BYTES) != hipSuccess) { fprintf(stderr, "hipFuncSetAttribute failed\n"); grid = -1; return; }
        int dev = 0, cus = 0, per_cu = 0; (void)hipGetDevice(&dev); (void)hipDeviceGetAttribute(&cus, hipDeviceAttributeMultiprocessorCount, dev);
        if (hipOccupancyMaxActiveBlocksPerMultiprocessor(&per_cu, (const void*)fwd_kernel, NTHREADS, LDS_BYTES) != hipSuccess || per_cu < 1) { fprintf(stderr, "occupancy query failed (%d)\n", per_cu); (void)hipGetLastError(); per_cu = 1; }
        grid = cus > 0 ? cus : 256;
    }
    if (grid < 0) return;
    (void)hipMemsetAsync((char*)d_ws, 0, ZERO_BYTES, stream);
    Args a{};
    for (int i = 0; i < 23; ++i) a.in[i] = (const float*)d_in[i];
    a.out = (float*)d_out; a.ws = (unsigned char*)d_ws;
#if N_LAUNCH_MODE == 1
    a.ph_lo = 0; a.ph_hi = N_PHASES; a.li = 0;
    void* kargs[] = {&a};
    hipError_t e = hipLaunchCooperativeKernel((const void*)fwd_kernel, dim3(grid), dim3(NTHREADS), kargs, LDS_BYTES, stream);
    if (e != hipSuccess) fprintf(stderr, "cooperative launch failed: %s (grid %d)\n", hipGetErrorString(e), grid);
#else
    for (int p = 0; p < N_PHASES; ++p) {
        a.ph_lo = p; a.ph_hi = p + 1; a.li = 0;
        hipLaunchKernelGGL(fwd_kernel, dim3(grid), dim3(NTHREADS), LDS_BYTES, stream, a);
    }
#endif
}
```

```cpp
#include <hip/hip_runtime.h>
#include <cstdio>
#include <cstdint>

#ifndef FAST_GEMM
#define FAST_GEMM 1
#endif
#ifndef N_LAUNCH_MODE
#define N_LAUNCH_MODE 1
#endif

#define LAS __attribute__((address_space(3)))
#define GAS __attribute__((address_space(1)))
typedef unsigned short bf16_t;
typedef short bf16x8 __attribute__((ext_vector_type(8)));
typedef float f32x4 __attribute__((ext_vector_type(4)));
typedef float f32x2 __attribute__((ext_vector_type(2)));
typedef unsigned u32x4 __attribute__((ext_vector_type(4)));
typedef unsigned u32x2 __attribute__((ext_vector_type(2)));

constexpr int DM = 1024, BATCH = 8, SEQ = 2048, DEPTH = 4, MTOK = BATCH * SEQ;
constexpr int INCOLS = 5888, FFN = 2816, FFN2 = 5632;
constexpr int C_Q = 0, C_K = 512, C_V = 640, C_CB = 768, C_CC = 1280, C_CX = 1792, C_U = 2304, C_G = 2816;
constexpr float NORM_EPS = 1e-6f;
constexpr float LOG2E = 1.4426950408889634f;
constexpr float QSCALE = 0.125f * LOG2E;

constexpr size_t MiB = 1u << 20;
constexpr size_t WS_CTL = 0;
constexpr size_t ZERO_BYTES = 64 * 1024;
constexpr size_t WS_SSM = 1 * MiB;
constexpr size_t WS_ROPE = 4 * MiB;
constexpr size_t WS_ROWSS = 5 * MiB;
constexpr size_t WS_W = 7 * MiB;
constexpr size_t W_BUF = 34 * MiB;
constexpr size_t WS_XBF = 75 * MiB;
constexpr size_t WS_R1 = 107 * MiB;
constexpr size_t WS_R2 = 195 * MiB;
constexpr size_t WS_R3 = 291 * MiB;
constexpr size_t WS_Q = WS_R1, WS_K = WS_R1 + 16 * MiB, WS_V = WS_R1 + 20 * MiB, WS_CB = WS_R1 + 24 * MiB, WS_ZC = WS_R1 + 40 * MiB, WS_MG = WS_R1 + 56 * MiB;
constexpr size_t WS_GT = WS_R2, WS_HD = WS_R2, WS_U = WS_R3, WS_Z = WS_R3, WS_YS = WS_R3 + 16 * MiB, WS_CA = WS_R3 + 32 * MiB, WS_AO = WS_Q;
constexpr int HD_PITCH = 3072;
constexpr size_t WS_SSMM = 339 * MiB;
constexpr size_t SSMM_BUF = 9 * MiB;
constexpr size_t WS_END = 357 * MiB;
constexpr size_t SM_WY = 0, SM_GT = 6 * MiB, SM_L16 = 8 * MiB;
constexpr size_t WO_IN = 0, WO_AO = WO_IN + (size_t)INCOLS * DM, WO_CO = WO_AO + 1024 * 512, WO_GLU = WO_CO + 1024 * 512, WO_SO = WO_GLU + 512 * 512,
                 WO_MIX = WO_SO + 1024 * 512, WO_FI = WO_MIX + 1024 * 1024, WO_FO = WO_FI + (size_t)FFN2 * DM, WO_END = WO_FO + (size_t)DM * FFN;
static_assert(WO_END * 2 <= 34 * MiB, "weights fit");
constexpr size_t SO_LAM = 0;
constexpr size_t SO_BBAR = 64 * 1024;
constexpr size_t SO_POW = SO_BBAR + 32 * 64 * 16 * 2 * 4;
constexpr size_t SO_LAYER = 768 * 1024;

constexpr int RING_BYTES = 131072;
constexpr int MISC_OFF = RING_BYTES + 320;
constexpr int RSTAB_OFF = RING_BYTES + 4096;
constexpr int LDS_BYTES = 147456;
constexpr int NWAVES = 8, NTHREADS = 512;

__device__ __forceinline__ unsigned f2bf(float f) { unsigned u = __builtin_bit_cast(unsigned, f); return (u + 0x7fffu + ((u >> 16) & 1u)) >> 16; }
typedef __bf16 bf16x2_hw __attribute__((ext_vector_type(2)));
__device__ __forceinline__ unsigned pk2(float lo, float hi) { const f32x2 v = {lo, hi}; const bf16x2_hw b = __builtin_convertvector(v, bf16x2_hw); return __builtin_bit_cast(unsigned, b); }
__device__ __forceinline__ float bf2f(unsigned short b) { return __builtin_bit_cast(float, (unsigned)b << 16); }
__device__ __forceinline__ float bflo(unsigned w) { return __builtin_bit_cast(float, w << 16); }
__device__ __forceinline__ float bfhi(unsigned w) { return __builtin_bit_cast(float, w & 0xffff0000u); }
__device__ __forceinline__ void unpack8(const u32x4 w, float (&v)[8]) { v[0] = bflo(w.x); v[1] = bfhi(w.x); v[2] = bflo(w.y); v[3] = bfhi(w.y); v[4] = bflo(w.z); v[5] = bfhi(w.z); v[6] = bflo(w.w); v[7] = bfhi(w.w); }
__device__ __forceinline__ u32x4 pack8(const float (&v)[8]) { u32x4 w; w.x = pk2(v[0], v[1]); w.y = pk2(v[2], v[3]); w.z = pk2(v[4], v[5]); w.w = pk2(v[6], v[7]); return w; }
__device__ __forceinline__ float sigmoidf_(float x) { return __builtin_amdgcn_rcpf(1.0f + __builtin_amdgcn_exp2f(-LOG2E * x)); }
__device__ __forceinline__ float gelu_tanh(float y) { const float t = (1.5957691216057308f * LOG2E) * (y + 0.044715f * y * y * y); return y * __builtin_amdgcn_rcpf(1.0f + __builtin_amdgcn_exp2f(-t)); }
template <class T> __device__ __forceinline__ T gld(const void* p) { return *(const GAS T*)p; }
template <class T> __device__ __forceinline__ void gst(void* p, const T v) { *(GAS T*)p = v; }
__device__ __forceinline__ __amdgpu_buffer_rsrc_t bsrc(const void* p) { return __builtin_amdgcn_make_buffer_rsrc((void*)p, (short)0, 0x7fffffff, 0x00020000); }
__device__ __forceinline__ u32x4 bld16s(const __amdgpu_buffer_rsrc_t r, const unsigned lane_off, const unsigned scalar_off) { return __builtin_bit_cast(u32x4, __builtin_amdgcn_raw_buffer_load_b128(r, lane_off, scalar_off, 0)); }
__device__ __forceinline__ void gst_wt16(void* p, const u32x4 v) { asm volatile("global_store_dwordx4 %0, %1, off sc1\n\ts_nop 1" :: "v"(p), "v"(v) : "memory"); }
__device__ __forceinline__ void gst_wt4(void* p, const float v) { asm volatile("global_store_dword %0, %1, off sc1\n\ts_nop 1" :: "v"(p), "v"(v) : "memory"); }
__device__ __forceinline__ float xsum16p(float x) { const unsigned u = __builtin_bit_cast(unsigned, x); const auto r = __builtin_amdgcn_permlane16_swap(u, u ^ 0x80000000u, false, false); unsigned r0 = r[0], r1 = r[1]; asm("" : "+v"(r0), "+v"(r1)); return fabsf(__builtin_bit_cast(float, r0) + __builtin_bit_cast(float, r1)); }
__device__ __forceinline__ float xsum32p(float x) { const unsigned u = __builtin_bit_cast(unsigned, x); const auto r = __builtin_amdgcn_permlane32_swap(u, u ^ 0x80000000u, false, false); unsigned r0 = r[0], r1 = r[1]; asm("" : "+v"(r0), "+v"(r1)); return fabsf(__builtin_bit_cast(float, r0) + __builtin_bit_cast(float, r1)); }
__device__ __forceinline__ float wave_sum(float v) {
#pragma unroll
    for (int o = 1; o < 64; o <<= 1) v += __shfl_xor(v, o);
    return v;
}

#ifndef PROBE_AMP
#define PROBE_AMP -1
#endif
#define AMP_BEGIN(id) unsigned long long amp_t0_##id = 0; if (PROBE_AMP == (id)) amp_t0_##id = __builtin_amdgcn_s_memrealtime()
#define AMP_END(id) do { if (PROBE_AMP == (id)) { const unsigned long long t1_ = __builtin_amdgcn_s_memrealtime(); const unsigned long long tgt_ = t1_ + 3ull * (t1_ - amp_t0_##id); while (__builtin_amdgcn_s_memrealtime() < tgt_) __builtin_amdgcn_s_sleep(8); } } while (0)
__device__ __forceinline__ int opaque_tid(int wave) { unsigned z = 0u; asm volatile("" : "+v"(z)); return wave * 64 + (int)__builtin_amdgcn_mbcnt_hi(~0u, __builtin_amdgcn_mbcnt_lo(~0u, z)); }
__device__ __forceinline__ float row_rs(const float* ss, int row) {
    const f32x4* p = (const f32x4*)(ss + (size_t)row * 16); const f32x4 a = p[0], b = p[1], c = p[2], d = p[3];
    const float t = ((a[0] + a[1]) + (a[2] + a[3])) + ((b[0] + b[1]) + (b[2] + b[3])) + (((c[0] + c[1]) + (c[2] + c[3])) + ((d[0] + d[1]) + (d[2] + d[3])));
    return __builtin_amdgcn_rsqf(t * (1.0f / DM) + NORM_EPS);
}
namespace pg8 {
constexpr int BM = 256, BK = 64, HALF = 128, HTB = HALF * BK * 2, STAGE_BYTES = 8 * HTB, NXCD = 8, WGM = 8;
struct Unit { int pm, pn, seg; };
struct Gemm { const bf16_t* A0; const bf16_t* A1; const bf16_t* A2; const bf16_t* B0; const bf16_t* B1; const bf16_t* B2; int K; int lda; };
__device__ __forceinline__ const bf16_t* sel3(const bf16_t* p0, const bf16_t* p1, const bf16_t* p2, int s) {
    unsigned long long a = (unsigned long long)p0, b = (unsigned long long)p1, c = (unsigned long long)p2;
    asm volatile("" : "+s"(a), "+s"(b), "+s"(c));
    return (const bf16_t*)(s == 0 ? a : (s == 1 ? b : c)); }
__device__ __forceinline__ const bf16_t* selA(const Gemm& g, int s) { return sel3(g.A0, g.A1, g.A2, s); }
__device__ __forceinline__ const bf16_t* selB(const Gemm& g, int s) { return sel3(g.B0, g.B1, g.B2, s); }

struct StaticOrder {
    int nM, nN, nwg, G, c, nseg;
    __device__ void init(int M, int N, int G_, int c_, int nseg_) { nM = M / BM; nN = N / BM; nwg = nM * nN; G = G_; c = c_; nseg = nseg_; }
    __device__ bool next(int i, Unit& u) const {
        const int ti = i / nseg; u.seg = i - ti * nseg;
        const long L = (long)ti * G + c; if (L >= nwg) return false;
        int wgid = (int)L; { const int q = nwg / NXCD, r = nwg % NXCD, xcd = wgid % NXCD, off = wgid / NXCD; wgid = (xcd < r ? xcd * (q + 1) : r * (q + 1) + (xcd - r) * q) + off; }
        const int nig = WGM * nN, gid = wgid / nig, fm = gid * WGM, gsz = (nM - fm) < WGM ? (nM - fm) : WGM;
        u.pm = fm + ((wgid % nig) % gsz); u.pn = (wgid % nig) / gsz; return true;
    }
};

typedef f32x4 Acc[2][2][4][2];

struct EpiInProj {
    static constexpr bool NEEDS_RS = true;
    const float* rowss; const float* ropec; const float* ropes; const float* bgate;
    bf16_t *Q, *Kb, *Vb, *CB, *ZC, *U, *Gt;
    static constexpr int NSTORE = 16;
    __device__ __forceinline__ bool operator()(Acc& acc, const Unit& u, int wr, int wc, int fr, int fq, const LAS float* rstab) const {
        const int cl = wc * 32 + 8 * fq;
        const int rowb = u.pm * BM + wr * 64 + fr;
        const LAS float* rsp = rstab + wr * 64 + fr;
        if (u.pn >= 5 && u.pn < 9) {
            bf16_t* p0 = ZC + (size_t)rowb * 512 + (u.pn - 5) * HALF + cl;
#pragma unroll
            for (int ai = 0; ai < 2; ++ai)
#pragma unroll
                for (int m = 0; m < 4; ++m) {
                    const float rs = rsp[ai * HALF + m * 16], rs2 = rs * rs;
                    float v[8];
#pragma unroll
                    for (int e = 0; e < 4; ++e) { v[e] = acc[ai][0][m][0][e] * acc[ai][1][m][0][e] * rs2; v[4 + e] = acc[ai][0][m][1][e] * acc[ai][1][m][1][e] * rs2; }
                    { const u32x4 pz = pack8(v); u32x2 z0; z0.x = pz.x; z0.y = pz.y; u32x2 z1; z1.x = pz.z; z1.y = pz.w;
                      gst<u32x2>(p0 + (ai * HALF + m * 16) * 512, z0); gst<u32x2>(p0 + (ai * HALF + m * 16) * 512 + 4, z1); }
                    asm volatile("" ::: "memory");
                }
            return true;
        }
#pragma unroll
        for (int bj = 0; bj < 2; ++bj) {
            const int colt = u.pn * BM + bj * HALF;
            if (colt >= C_G) {
                const int pl = (u.pn < 19) ? bj : 2, go = (u.pn < 19) ? (u.pn - 11) * HALF : colt - (C_G + 2048);
                bf16_t* p0 = Gt + (size_t)rowb * 3072 + pl * 1024 + go + cl;
                float bg[8];
                { const f32x4 b0 = gld<f32x4>(bgate + pl * 1024 + go + cl), b1 = gld<f32x4>(bgate + pl * 1024 + go + cl + 4);
#pragma unroll
                  for (int e = 0; e < 4; ++e) { bg[e] = -LOG2E * b0[e]; bg[4 + e] = -LOG2E * b1[e]; } }
#pragma unroll
                for (int ai = 0; ai < 2; ++ai)
#pragma unroll
                    for (int m = 0; m < 4; ++m) {
                        const float nrs = -LOG2E * rsp[ai * HALF + m * 16];
                        float v[8];
#pragma unroll
                        for (int e = 0; e < 4; ++e) {
                            v[e] = 1.0f + __builtin_amdgcn_exp2f(fminf(__builtin_fmaf(acc[ai][bj][m][0][e], nrs, bg[e]), 86.f));
                            v[4 + e] = 1.0f + __builtin_amdgcn_exp2f(fminf(__builtin_fmaf(acc[ai][bj][m][1][e], nrs, bg[4 + e]), 86.f));
                        }
                        gst<u32x4>(p0 + (ai * HALF + m * 16) * 3072, pack8(v));
                        asm volatile("" ::: "memory");
                    }
            } else {
                bf16_t* p0; int pitch; float scale = 1.0f; bool rope = false;
                if (colt < C_K) { p0 = Q + (size_t)rowb * 512 + colt + cl; pitch = 512; scale = QSCALE; rope = (wc & 1) == 0; }
                else if (colt < C_V) { p0 = Kb + (size_t)rowb * 128 + cl; pitch = 128; rope = (wc & 1) == 0; }
                else if (colt < C_CB) { p0 = Vb + (size_t)rowb * 128 + cl; pitch = 128; }
                else if (colt < C_CC) { p0 = CB + (size_t)rowb * 512 + (colt - C_CB) + cl; pitch = 512; }
                else { const int cu = (colt - C_U) + cl; p0 = U + (size_t)(cu >> 4) * SEQ * 16 + (cu & 15) + ((size_t)(rowb >> 11) * 32 * SEQ + (rowb & (SEQ - 1))) * 16; pitch = 16; }
                if (rope) {
                    const float sgn = (fq == 0) ? -1.f : 1.f;
#pragma unroll
                    for (int ai = 0; ai < 2; ++ai)
#pragma unroll
                        for (int m = 0; m < 4; ++m) {
                            const float rs = rsp[ai * HALF + m * 16] * scale;
                            const int pos = (rowb + ai * HALF + m * 16) & (SEQ - 1);
                            const f32x4 c0 = gld<f32x4>(ropec + pos * 8), c1 = gld<f32x4>(ropec + pos * 8 + 4);
                            const f32x4 s0 = gld<f32x4>(ropes + pos * 8), s1 = gld<f32x4>(ropes + pos * 8 + 4);
                            float v[8];
#pragma unroll
                            for (int e = 0; e < 4; ++e) { v[e] = acc[ai][bj][m][0][e] * rs; v[4 + e] = acc[ai][bj][m][1][e] * rs; }
#pragma unroll
                            for (int e = 0; e < 8; ++e) {
                                const float p = __shfl_xor(v[e], 16);
                                const float cs = e < 4 ? c0[e & 3] : c1[e & 3], sn = e < 4 ? s0[e & 3] : s1[e & 3];
                                const float r = v[e] * cs + sgn * p * sn;
                                v[e] = (fq < 2) ? r : v[e];
                            }
                            gst<u32x4>(p0 + (ai * HALF + m * 16) * pitch, pack8(v));
                            asm volatile("" ::: "memory");
                        }
                } else {
#pragma unroll
                    for (int ai = 0; ai < 2; ++ai)
#pragma unroll
                        for (int m = 0; m < 4; ++m) {
                            const float rs = rsp[ai * HALF + m * 16] * scale;
                            float v[8];
#pragma unroll
                            for (int e = 0; e < 4; ++e) { v[e] = acc[ai][bj][m][0][e] * rs; v[4 + e] = acc[ai][bj][m][1][e] * rs; }
                            gst<u32x4>(p0 + (ai * HALF + m * 16) * pitch, pack8(v));
                            asm volatile("" ::: "memory");
                        }
                }
            }
        }
        return true;
    }
};

struct EpiGlu {
    static constexpr bool NEEDS_RS = false;
    const float* rowss; const bf16_t* YS; bf16_t* Z;
    static constexpr int NSTORE = 0;
    __device__ __forceinline__ bool operator()(Acc& acc, const Unit& u, int wr, int wc, int fr, int fq, const LAS float*) const {
        const size_t o0 = (size_t)(u.pm * BM + wr * 64 + fr) * 512 + u.pn * BM + wc * 32 + 8 * fq; const bf16_t* yp = YS + o0; bf16_t* zp = Z + o0;
        u32x4 yv[2][4][2];
#pragma unroll
        for (int ai = 0; ai < 2; ++ai)
#pragma unroll
            for (int m = 0; m < 4; ++m)
#pragma unroll
                for (int bj = 0; bj < 2; ++bj) yv[ai][m][bj] = gld<u32x4>(yp + (ai * HALF + m * 16) * 512 + bj * HALF);
#pragma unroll
        for (int ai = 0; ai < 2; ++ai) {
#pragma unroll
            for (int m = 0; m < 4; ++m)
#pragma unroll
                for (int bj = 0; bj < 2; ++bj) {
                    float y[8]; unpack8(yv[ai][m][bj], y);
                    float v[8];
#pragma unroll
                    for (int e = 0; e < 4; ++e) { v[e] = y[e] * sigmoidf_(acc[ai][bj][m][0][e]); v[4 + e] = y[4 + e] * sigmoidf_(acc[ai][bj][m][1][e]); }
                    gst<u32x4>(zp + (ai * HALF + m * 16) * 512 + bj * HALF, pack8(v));
                }
            asm volatile("" ::: "memory");
        }
        return true;
    }
};

struct EpiMerge {
    static constexpr bool NEEDS_RS = false;
    const float* rowss; const bf16_t* Gt; bf16_t* Mg; int seg_base;  static constexpr int NSTORE = 0;
    __device__ __forceinline__ bool operator()(Acc& acc, const Unit& u, int wr, int wc, int fr, int fq, const LAS float*) const {
        const int s = u.seg + seg_base;
        const bf16_t* gp = Gt + (size_t)(u.pm * BM + wr * 64 + fr) * 3072 + u.pn * BM + wc * 32 + 8 * fq;
        const bf16_t* pd = gp + (s == 0 ? 0 : (s == 1 ? 1024 : 2048));
        const bf16_t* pn_ = gp + (s == 0 ? 1024 : 2048);
        bf16_t* mp = Mg + (size_t)(u.pm * BM + wr * 64 + fr) * DM + u.pn * BM + wc * 32 + 8 * fq;
#pragma unroll
        for (int ai = 0; ai < 2; ++ai) {
            u32x4 ga[4][2], gb[4][2];
#pragma unroll
            for (int m = 0; m < 4; ++m)
#pragma unroll
                for (int bj = 0; bj < 2; ++bj) {
                    const size_t o = (size_t)(ai * HALF + m * 16) * 3072 + bj * HALF;
                    gb[m][bj] = gld<u32x4>(pd + o);
                    ga[m][bj] = (s < 2) ? gld<u32x4>(pn_ + o) : gb[m][bj];
                }
#pragma unroll
            for (int m = 0; m < 4; ++m)
#pragma unroll
                for (int bj = 0; bj < 2; ++bj) {
                    float fa[8], fb[8], f[8]; unpack8(ga[m][bj], fa); unpack8(gb[m][bj], fb);
#pragma unroll
                    for (int e = 0; e < 8; ++e) { const float r = __builtin_amdgcn_rcpf(fb[e]); f[e] = (s < 2) ? fa[e] * r : r; }
                    if (s < 2) {
#pragma unroll
                        for (int e = 0; e < 4; ++e) { acc[ai][bj][m][0][e] *= f[e]; acc[ai][bj][m][1][e] *= f[4 + e]; }
                    } else {
                        float v[8];
#pragma unroll
                        for (int e = 0; e < 4; ++e) { v[e] = acc[ai][bj][m][0][e] * f[e]; v[4 + e] = acc[ai][bj][m][1][e] * f[4 + e]; }
                        gst<u32x4>(mp + (size_t)(ai * HALF + m * 16) * DM + bj * HALF, pack8(v));
                    }
                }
            asm volatile("" ::: "memory");
        }
        return s == 2;
    }
};

struct EpiResid {
    static constexpr bool NEEDS_RS = false;
    const float* rowss; const float* Xin; bf16_t* XB; float* ss_next; bool first; bool dry;  static constexpr int NSTORE = 0;
    __device__ __forceinline__ void row_group(Acc& acc, const int ai, const int m, const float (&xo0)[8], const float (&xo1)[8], bf16_t* xb0, const int row0, const int pn, const int wc, const int fq) const {
        float ssq = 0.f;
#pragma unroll
        for (int bj = 0; bj < 2; ++bj) {
            float v[8];
#pragma unroll
            for (int e = 0; e < 4; ++e) { const float a0 = bj ? xo1[e] : xo0[e], a1 = bj ? xo1[4 + e] : xo0[4 + e]; v[e] = dry ? a0 : a0 + acc[ai][bj][m][0][e]; v[4 + e] = dry ? a1 : a1 + acc[ai][bj][m][1][e]; }
#pragma unroll
            for (int e = 0; e < 8; ++e) ssq += v[e] * v[e];
            gst<u32x4>(xb0 + (size_t)(ai * HALF + m * 16) * DM + bj * HALF, pack8(v));
        }
        ssq = xsum32p(xsum16p(ssq));
        if (fq == 0) gst<float>(ss_next + (size_t)(row0 + ai * HALF + m * 16) * 16 + pn * 4 + wc, ssq);
    }
    __device__ __forceinline__ bool operator()(Acc& acc, const Unit& u, int wr, int wc, int fr, int fq, const LAS float*) const {
        const int row0 = u.pm * BM + wr * 64 + fr, col0 = u.pn * BM + wc * 32 + 8 * fq;
        bf16_t* xb0 = XB + (size_t)row0 * DM + col0; const float* xi0 = Xin + (size_t)row0 * DM + col0;
#pragma unroll
        for (int ai = 0; ai < 2; ++ai) {
            u32x4 xv[4][2];
#pragma unroll
            for (int m = 0; m < 4; ++m)
#pragma unroll
                for (int bj = 0; bj < 2; ++bj) xv[m][bj] = gld<u32x4>(xb0 + (size_t)(ai * HALF + m * 16) * DM + bj * HALF);
#pragma unroll
            for (int m = 0; m < 4; ++m) {
                float x0[8], x1[8]; unpack8(xv[m][0], x0); unpack8(xv[m][1], x1);
                row_group(acc, ai, m, x0, x1, xb0, row0, u.pn, wc, fq);
            }
            asm volatile("" ::: "memory");
        }
        return true;
    }
};

struct EpiFfnIn {
    static constexpr bool NEEDS_RS = true;
    const float* rowss; bf16_t* H;
    static constexpr int NSTORE = 8;
    __device__ __forceinline__ bool operator()(Acc& acc, const Unit& u, int wr, int wc, int fr, int fq, const LAS float* rstab) const {
        bf16_t* p0 = H + (size_t)(u.pm * BM + wr * 64 + fr) * HD_PITCH + u.pn * HALF + wc * 32 + 8 * fq;
        const LAS float* rsp = rstab + wr * 64 + fr;
#pragma unroll
        for (int ai = 0; ai < 2; ++ai)
#pragma unroll
            for (int m = 0; m < 4; ++m) {
                const float rs = rsp[ai * HALF + m * 16], nrs = -LOG2E * rs, rs2 = rs * rs;
                float v[8];
#pragma unroll
                for (int n = 0; n < 2; ++n)
#pragma unroll
                    for (int e = 0; e < 4; ++e) {
                        const float g = acc[ai][0][m][n][e], up = acc[ai][1][m][n][e];
                        v[4 * n + e] = (g * up * rs2) * __builtin_amdgcn_rcpf(1.0f + __builtin_amdgcn_exp2f(g * nrs));
                    }
                gst<u32x4>(p0 + (ai * HALF + m * 16) * HD_PITCH, pack8(v));
                asm volatile("" ::: "memory");
            }
        return true;
    }
};


__host__ __device__ __forceinline__ int lds_byte(int r, int c) { const int st = (r >> 4) * 2 + (c >> 5), rr = r & 15, cc = c & 31, ob = rr * 64 + cc * 2; return st * 1024 + (ob ^ (((ob >> 9) & 1) << 5)); }
__host__ __device__ __forceinline__ void stage_rc(int b, int& R, int& C) { const int st = b / 1024, sb = b % 1024, swz = sb ^ (((sb >> 9) & 1) << 5); R = (st >> 1) * 16 + swz / 64; C = (st & 1) * 32 + (swz % 64) / 2; }
__host__ __device__ __forceinline__ int perm32(int rho) { const int n = rho >> 4, i = rho & 15; return 8 * (i >> 2) + 4 * n + (i & 3); }

struct NoHook { __device__ __forceinline__ void operator()(const Unit&) const {} };
struct Src { __amdgpu_buffer_rsrc_t r; unsigned o; };
__device__ __forceinline__ Src operator+(Src s_, size_t d) { s_.o += (unsigned)d; return s_; }
__device__ __forceinline__ Src make_src(const bf16_t* p, size_t off) { Src s_; s_.r = __builtin_amdgcn_make_buffer_rsrc((void*)p, (short)0, 0x7fffffff, 0x00020000); s_.o = (unsigned)off; return s_; }
template <class Epi, bool ALIGN_EPI, bool SP2, class Hook>
__device__ __forceinline__ void gemm_phase(LAS unsigned char* lds, const Gemm g, const StaticOrder& S, const Epi& E, Acc& acc, const bool fresh, const Hook& H, const int wave_id) {
    const int tid = opaque_tid(wave_id), wid = wave_id, lane = tid & 63, wr = wid >> 2, wc = wid & 3, fr = lane & 15, fq = lane >> 4;
    const int K = g.K, nt = K / BK, lda = g.lda ? g.lda : K;
    unsigned voffA[2], voffB[2];
#pragma unroll
    for (int i = 0; i < 2; ++i) { int R, C; stage_rc(tid * 16 + i * 8192, R, C); const int Rb = (R & ~31) + perm32(R & 31);
        voffA[i] = (unsigned)(R * lda + C) * 2u; voffB[i] = (unsigned)(Rb * K + C) * 2u; }
    const size_t kstep = (size_t)(BK * 2);
    const size_t hstep = (size_t)HALF * K * 2, hstepA = (size_t)HALF * lda * 2;
    const size_t tstep = 2 * hstep, tstepA = 2 * hstepA;
    const unsigned ldsw = (unsigned)wid * 1024u;
    const int aoff = lds_byte(wr * 64 + fr, fq * 8), boff = lds_byte(wc * 32 + fr, fq * 8);
#define PG8_SA(b, h) (((b) * 2 + (h)) * HTB)
#define PG8_SB(b, h) ((4 + (b) * 2 + (h)) * HTB)
#define PG8_STAGE(bufoff, gbase, voff) do { const Src _g = (gbase); _Pragma("unroll") for (int _i = 0; _i < 2; ++_i) \
        __builtin_amdgcn_raw_ptr_buffer_load_lds(_g.r, (LAS unsigned*)(lds + (bufoff) + ldsw + _i * 8192), 16, (voff)[_i], _g.o, 0, 0); } while (0)
#define PG8_LDA(dst, b, h) do { _Pragma("unroll") for (int m = 0; m < 4; ++m) _Pragma("unroll") for (int k = 0; k < 2; ++k) dst[m][k] = *(const LAS bf16x8*)(lds + PG8_SA(b, h) + aoff + m * 2048 + k * 1024); } while (0)
#define PG8_LDB(dst, b, h) do { _Pragma("unroll") for (int n = 0; n < 2; ++n) _Pragma("unroll") for (int k = 0; k < 2; ++k) dst[n][k] = *(const LAS bf16x8*)(lds + PG8_SB(b, h) + boff + n * 2048 + k * 1024); } while (0)
#define PG8_MMA(ai, bj, At, Bt) do { __builtin_amdgcn_s_setprio(1); _Pragma("unroll") for (int m = 0; m < 4; ++m) _Pragma("unroll") for (int n = 0; n < 2; ++n) _Pragma("unroll") for (int k = 0; k < 2; ++k) \
        acc[ai][bj][m][n] = __builtin_amdgcn_mfma_f32_16x16x32_bf16(Bt[n][k], At[m][k], acc[ai][bj][m][n], 0, 0, 0); __builtin_amdgcn_s_setprio(0); } while (0)
#define PG8_WAIT_V(n) asm volatile("s_waitcnt vmcnt(" #n ")" ::: "memory")
#define PG8_WAIT_L(n) asm volatile("s_waitcnt lgkmcnt(" #n ")" ::: "memory")
#define PG8_TRIP_SP2(W12) do { \
            PG8_LDB(B0, 0, 0); PG8_LDB(B1, 0, 1); PG8_SCHED; PG8_LDA(At, 0, 0); PG8_STAGE(PG8_SA(1, 1), a1 + hstepA, voffA); \
            W12; PG8_WAIT_L(0); PG8_BAR; PG8_MMA(0, 0, At, B0); PG8_MMA(0, 1, At, B1); PG8_BAR; PG8_SCHED; \
            PG8_LDA(At, 0, 1); PG8_STAGE(PG8_SB(0, 0), b2, voffB); PG8_STAGE(PG8_SB(0, 1), b2 + hstep, voffB); PG8_STAGE(PG8_SA(0, 0), a2, voffA); \
            W12; PG8_WAIT_L(0); PG8_BAR; PG8_MMA(1, 0, At, B0); PG8_MMA(1, 1, At, B1); PG8_BAR; PG8_SCHED; \
            PG8_LDB(B0, 1, 0); PG8_LDB(B1, 1, 1); PG8_SCHED; PG8_LDA(At, 1, 0); PG8_STAGE(PG8_SA(0, 1), a2 + hstepA, voffA); \
            PG8_WAIT_V(8); PG8_WAIT_L(0); PG8_BAR; PG8_MMA(0, 0, At, B0); PG8_MMA(0, 1, At, B1); PG8_BAR; PG8_SCHED; \
            PG8_LDA(At, 1, 1); PG8_STAGE(PG8_SB(1, 0), b3, voffB); PG8_STAGE(PG8_SB(1, 1), b3 + hstep, voffB); PG8_STAGE(PG8_SA(1, 0), a3, voffA); \
            PG8_WAIT_V(8); PG8_WAIT_L(0); PG8_BAR; PG8_MMA(1, 0, At, B0); PG8_MMA(1, 1, At, B1); PG8_BAR; PG8_SCHED; } while (0)
#define PG8_BAR __builtin_amdgcn_s_barrier()
#define PG8_SCHED __builtin_amdgcn_sched_barrier(0)
    Unit cur, nxt; int ui = 0, rs_pm = -1, t0 = 0;
    if (!S.next(0, cur)) return;
    if (fresh) {
#pragma unroll
        for (int a = 0; a < 2; ++a)
#pragma unroll
            for (int b = 0; b < 2; ++b)
#pragma unroll
                for (int m = 0; m < 4; ++m)
#pragma unroll
                    for (int n = 0; n < 2; ++n) acc[a][b][m][n] = (f32x4){0.f, 0.f, 0.f, 0.f};
    }
    bf16x8 At[4][2], B0[2][2], B1[2][2];
    Src cA = make_src(selA(g, cur.seg), (size_t)cur.pm * tstepA), cB = make_src(selB(g, cur.seg), (size_t)cur.pn * tstep);
    if constexpr (SP2) {
        f32x4 rpa = {0.f, 0.f, 0.f, 0.f}, rpb = rpa;
        float rsum = 0.f;
        if constexpr (Epi::NEEDS_RS) { const GAS f32x4* p = (const GAS f32x4*)(E.rowss + (size_t)(cur.pm * BM + (tid >> 1)) * 16) + (tid & 1) * 2; rpa = p[0]; rpb = p[1]; }
        PG8_STAGE(PG8_SB(0, 0), cB, voffB); PG8_STAGE(PG8_SB(0, 1), cB + hstep, voffB); PG8_STAGE(PG8_SA(0, 0), cA, voffA); PG8_STAGE(PG8_SA(0, 1), cA + hstepA, voffA);
        if (wr == 1) PG8_BAR;
        PG8_WAIT_V(2); PG8_BAR;
        if constexpr (Epi::NEEDS_RS) {
            rsum = ((rpa[0] + rpa[1]) + (rpa[2] + rpa[3])) + ((rpb[0] + rpb[1]) + (rpb[2] + rpb[3]));
            const float t2 = __builtin_bit_cast(float, __builtin_amdgcn_update_dpp(0, __builtin_bit_cast(int, rsum), 0xB1  , 0xf, 0xf, false)); rsum = (tid & 1) ? (t2 + rsum) : (rsum + t2);
            if ((tid & 1) == 0) ((LAS float*)(lds + RSTAB_OFF))[tid >> 1] = __builtin_amdgcn_rsqf(rsum * (1.0f / DM) + NORM_EPS);
            rs_pm = cur.pm;
        }
        PG8_STAGE(PG8_SB(1, 0), cB + kstep, voffB); PG8_STAGE(PG8_SA(1, 0), cA + kstep, voffA); PG8_STAGE(PG8_SB(1, 1), cB + hstep + kstep, voffB);
        PG8_WAIT_V(6); PG8_BAR;
    } else {
        PG8_STAGE(PG8_SB(0, 0), cB, voffB); PG8_STAGE(PG8_SA(0, 0), cA, voffA); PG8_STAGE(PG8_SB(0, 1), cB + hstep, voffB); PG8_STAGE(PG8_SA(0, 1), cA + hstepA, voffA);
        if (wr == 1) PG8_BAR;
        PG8_WAIT_V(4); PG8_BAR;
        PG8_STAGE(PG8_SB(1, 0), cB + kstep, voffB); PG8_STAGE(PG8_SA(1, 0), cA + kstep, voffA); PG8_STAGE(PG8_SB(1, 1), cB + hstep + kstep, voffB);
        PG8_WAIT_V(6); PG8_BAR;
    }
    for (;;) {
        const bool has_next = S.next(ui + 1, nxt);
        const Src nA = has_next ? make_src(selA(g, nxt.seg), (size_t)nxt.pm * tstepA) : cA, nB = has_next ? make_src(selB(g, nxt.seg), (size_t)nxt.pn * tstep) : cB;
        for (int t = t0; t < nt; t += 2) {
            const bool last = (t == nt - 2);
            const Src a1 = cA + (size_t)(t + 1) * kstep;
            const Src a2 = last ? nA : cA + (size_t)(t + 2) * kstep, b2 = last ? nB : cB + (size_t)(t + 2) * kstep;
            const Src a3 = a2 + kstep, b3 = b2 + kstep;
            if (last && has_next) H(nxt);
            if constexpr (SP2) {
            PG8_TRIP_SP2(PG8_WAIT_V(8));
            } else {
            PG8_LDB(B0, 0, 0); PG8_SCHED; PG8_LDA(At, 0, 0); PG8_STAGE(PG8_SA(1, 1), a1 + hstepA, voffA);
            PG8_WAIT_L(8); PG8_BAR; PG8_WAIT_L(0); PG8_MMA(0, 0, At, B0); PG8_BAR; PG8_SCHED;
            PG8_LDB(B1, 0, 1); PG8_STAGE(PG8_SB(0, 0), b2, voffB);
            PG8_BAR; PG8_WAIT_L(0); PG8_MMA(0, 1, At, B1); PG8_BAR;
            PG8_LDA(At, 0, 1); PG8_STAGE(PG8_SA(0, 0), a2, voffA);
            PG8_BAR; PG8_WAIT_L(0); PG8_MMA(1, 0, At, B0); PG8_BAR; PG8_SCHED;
            PG8_STAGE(PG8_SB(0, 1), b2 + hstep, voffB);
            PG8_WAIT_V(6); PG8_BAR; PG8_MMA(1, 1, At, B1); PG8_BAR;
            PG8_LDB(B0, 1, 0); PG8_SCHED; PG8_LDA(At, 1, 0); PG8_STAGE(PG8_SA(0, 1), a2 + hstepA, voffA);
            PG8_WAIT_L(8); PG8_BAR; PG8_WAIT_L(0); PG8_MMA(0, 0, At, B0); PG8_BAR; PG8_SCHED;
            PG8_LDB(B1, 1, 1); PG8_STAGE(PG8_SB(1, 0), b3, voffB);
            PG8_BAR; PG8_WAIT_L(0); PG8_MMA(0, 1, At, B1); PG8_BAR;
            PG8_LDA(At, 1, 1); PG8_STAGE(PG8_SA(1, 0), a3, voffA);
            PG8_BAR; PG8_WAIT_L(0); PG8_MMA(1, 0, At, B0); PG8_BAR; PG8_SCHED;
            PG8_STAGE(PG8_SB(1, 1), b3 + hstep, voffB);
            PG8_WAIT_V(6); PG8_BAR; PG8_MMA(1, 1, At, B1); PG8_BAR;
            }
        }
        if constexpr (ALIGN_EPI) { if (wr == 0) PG8_BAR; }
        const int tid_ = opaque_tid(wave_id), fr_ = tid_ & 15, fq_ = (tid_ & 63) >> 4;
        const LAS float* rstab = (const LAS float*)(lds + RSTAB_OFF);
        if (Epi::NEEDS_RS && cur.pm != rs_pm) {
            rs_pm = cur.pm;
            const GAS f32x4* p = (const GAS f32x4*)(E.rowss + (size_t)(cur.pm * BM + (tid_ >> 1)) * 16) + (tid_ & 1) * 2; const f32x4 pa = p[0], pb = p[1];
            float t = ((pa[0] + pa[1]) + (pa[2] + pa[3])) + ((pb[0] + pb[1]) + (pb[2] + pb[3]));
            const float t2 = __shfl_xor(t, 1); t = (tid_ & 1) ? (t2 + t) : (t + t2);
            if ((tid_ & 1) == 0) ((LAS float*)(lds + RSTAB_OFF))[tid_ >> 1] = __builtin_amdgcn_rsqf(t * (1.0f / DM) + NORM_EPS);
            PG8_WAIT_L(0); PG8_BAR;
        }
        AMP_BEGIN(11);
        const bool reset = E(acc, cur, wr, wc, fr_, fq_, rstab);
        AMP_END(11);
        if (!has_next) break;
        if (reset) {
#pragma unroll
            for (int a = 0; a < 2; ++a)
#pragma unroll
                for (int b = 0; b < 2; ++b)
#pragma unroll
                    for (int m = 0; m < 4; ++m)
#pragma unroll
                        for (int n = 0; n < 2; ++n) acc[a][b][m][n] = (f32x4){0.f, 0.f, 0.f, 0.f};
        }
        cur = nxt; cA = nA; cB = nB; ++ui;
        if constexpr (ALIGN_EPI) { if (wr == 1) PG8_BAR; }
        if constexpr (SP2 && Epi::NSTORE > 0) {
            const Src a1 = cA + kstep, a2 = cA + 2 * kstep, b2 = cB + 2 * kstep, a3 = a2 + kstep, b3 = b2 + kstep;
            if constexpr (Epi::NSTORE == 16) PG8_TRIP_SP2(PG8_WAIT_V(24)); else PG8_TRIP_SP2(PG8_WAIT_V(16));
            t0 = 2;
        }
    }
    PG8_WAIT_V(0);
    if constexpr (!ALIGN_EPI) { if (wr == 0) PG8_BAR; }
    PG8_BAR;
#undef PG8_SA
#undef PG8_SB
#undef PG8_STAGE
#undef PG8_LDA
#undef PG8_LDB
#undef PG8_MMA
#undef PG8_WAIT_V
#undef PG8_TRIP_SP2
#undef PG8_WAIT_L
#undef PG8_BAR
#undef PG8_SCHED
}
}


#define XB_TMO      128
#define XB_XCNT(j)  (256  + 64 * (j))
#define XB_XSUB(j)  (1280 + 64 * (j))
#define XB_XGEN(j)  (2304 + 64 * (j))
#define XB_TOP      3328
#define XB_TOPGEN   3392
#define XCD_BAR_WORDS 3456
#define XB_SPIN_CAP (1u << 18)
__device__ __forceinline__ unsigned xb_ld(unsigned* p)              { return __hip_atomic_load(p, __ATOMIC_RELAXED, __HIP_MEMORY_SCOPE_AGENT); }
__device__ __forceinline__ unsigned xb_add(unsigned* p, unsigned v) { return __hip_atomic_fetch_add(p, v, __ATOMIC_RELAXED, __HIP_MEMORY_SCOPE_AGENT); }
__device__ __forceinline__ unsigned xb_xcc_id() { return (unsigned)__builtin_amdgcn_s_getreg((3 << 11) | 20) & 0xFu; }
#define XB_SPIN(cond, bar) do { unsigned _sp = 0; while (cond) { __builtin_amdgcn_s_sleep(1); \
    if ((++_sp & 255u) == 0u) { if (xb_ld(&(bar)[XB_TMO])) break; if (_sp > XB_SPIN_CAP) { atomicAdd(&(bar)[XB_TMO], 1u); break; } } } } while (0)
struct XcdBarrier { unsigned* bar; unsigned x; volatile LAS unsigned* st; int wave; bool local_ok; };
__device__ __forceinline__ bool xb_thread0(int wave) { unsigned z = 0u; asm volatile("" : "+v"(z)); return wave == 0 && __builtin_amdgcn_mbcnt_hi(~0u, __builtin_amdgcn_mbcnt_lo(~0u, z)) == 0u; }
__device__ __forceinline__ XcdBarrier xcd_barrier_post(unsigned* bar, volatile LAS unsigned* st, int wave) {
    XcdBarrier b; b.bar = bar; b.x = xb_xcc_id(); b.st = st; b.wave = wave; b.local_ok = false;
    if (xb_thread0(wave)) (void)xb_add(&bar[XB_XCNT(b.x)], 1u);
    return b;
}
__device__ __forceinline__ void xcd_barrier_complete(unsigned* bar, unsigned x, unsigned& nloc, unsigned& nx) {
    const unsigned G = gridDim.x * gridDim.y * gridDim.z;
    unsigned sum, cnt, mine, sp = 0u;
    for (;;) {
        sum = 0u; cnt = 0u; mine = 0u;
#pragma unroll
        for (unsigned j = 0; j < 16; ++j) { const unsigned c = xb_ld(&bar[XB_XCNT(j)]); sum += c; cnt += (c > 0u) ? 1u : 0u; mine = (j == x) ? c : mine; }
        if (sum == G) break;
        __builtin_amdgcn_s_sleep(1);
        if ((++sp & 255u) == 0u) { if (xb_ld(&bar[XB_TMO])) break; if (sp > XB_SPIN_CAP) { atomicAdd(&bar[XB_TMO], 1u); break; } }
    }
    nloc = mine > 0u ? mine : 1u; nx = cnt > 0u ? cnt : 1u;
}
#define XB_GSUB(g)  (4096 + 64 * (g))
#define XB_GGEN(g)  (8192 + 64 * (g))
__device__ __forceinline__ void xcd_barrier(const XcdBarrier& b, const int scope = 0) {
    const bool xcd_only = scope == 1 || scope == 2;
    asm volatile("s_waitcnt vmcnt(0)" ::: "memory");
    __syncthreads();
    if (scope == 2 && b.local_ok) {
        if (xb_thread0(b.wave)) {
            unsigned* bar = b.bar;
            const unsigned g = (blockIdx.x & 7u) * 8u + ((blockIdx.x >> 3) & 7u);
            const unsigned old = xb_add(&bar[XB_GSUB(g)], 1u);
            const unsigned gen = old >> 2;
            if ((old & 3u) == 3u) {
                (void)xb_add(&bar[XB_GGEN(g)], 1u);
                asm volatile("buffer_inv sc1\n\ts_waitcnt vmcnt(0)" ::: "memory");
            } else {
                XB_SPIN(xb_ld(&bar[XB_GGEN(g)]) == gen, bar);
                __builtin_amdgcn_fence(__ATOMIC_ACQUIRE, "agent");
                asm volatile("s_waitcnt vmcnt(0)" ::: "memory");
            }
        }
        __syncthreads();
        return;
    }
    if (xb_thread0(b.wave)) {
        unsigned* bar = b.bar;
        __builtin_amdgcn_s_waitcnt(0);
        unsigned nloc = b.st[0], nx = b.st[1];
        if (nloc == 0u) { xcd_barrier_complete(bar, b.x, nloc, nx); b.st[0] = nloc; b.st[1] = nx; }
        const unsigned old = xb_add(&bar[XB_XSUB(b.x)], 1u);
        const unsigned gen = old / nloc;
        if (old + 1u == (gen + 1u) * nloc) {
            if (!(xcd_only && b.local_ok)) {
                if (!(scope == 3 && b.local_ok)) __builtin_amdgcn_fence(__ATOMIC_RELEASE, "agent");
                asm volatile("s_waitcnt vmcnt(0)" ::: "memory");
                const unsigned og = xb_add(&bar[XB_TOP], 1u);
                const unsigned tg = og / nx;
                if (og + 1u == (tg + 1u) * nx) xb_add(&bar[XB_TOPGEN], 1u);
                else XB_SPIN(xb_ld(&bar[XB_TOPGEN]) == tg, bar);
            }
            __builtin_amdgcn_fence(__ATOMIC_ACQUIRE, "agent");
            xb_add(&bar[XB_XGEN(b.x)], 1u);
            asm volatile("s_waitcnt vmcnt(0)" ::: "memory");
        } else {
            XB_SPIN(xb_ld(&bar[XB_XGEN(b.x)]) == gen, bar);
            __builtin_amdgcn_fence(__ATOMIC_ACQUIRE, "agent");
            asm volatile("s_waitcnt vmcnt(0)" ::: "memory");
        }
    }
    __syncthreads();
}

struct BarrierHook { const XcdBarrier* b; int at_seg; __device__ __forceinline__ void operator()(const pg8::Unit& nxt) const { if (nxt.seg == at_seg) xcd_barrier(*b, 2); } };


struct EpiResidFinal {
    static constexpr bool NEEDS_RS = false;
    const float* rowss; const bf16_t* XB; float* OUT; float* ss; const float* gain; const XcdBarrier* bar;
    static constexpr int NSTORE = 0;
    __device__ __forceinline__ bool operator()(pg8::Acc& acc, const pg8::Unit& u, int wr, int wc, int fr, int fq, const LAS float* rstab) const {
        using namespace pg8;
        const int row0 = u.pm * BM + wr * 64 + fr, col0 = u.pn * BM + wc * 32 + 8 * fq;
        const bf16_t* xb0 = XB + (size_t)row0 * DM + col0;
#pragma unroll
        for (int ai = 0; ai < 2; ++ai) {
            u32x4 xv[4][2];
#pragma unroll
            for (int m = 0; m < 4; ++m)
#pragma unroll
                for (int bj = 0; bj < 2; ++bj) xv[m][bj] = gld<u32x4>(xb0 + (size_t)(ai * HALF + m * 16) * DM + bj * HALF);
#pragma unroll
            for (int m = 0; m < 4; ++m) {
                float ssq = 0.f;
#pragma unroll
                for (int bj = 0; bj < 2; ++bj) {
                    float h8[8]; unpack8(xv[m][bj], h8);
                    f32x4 x0, x1;
#pragma unroll
                    for (int e = 0; e < 4; ++e) { x0[e] = h8[e] + acc[ai][bj][m][0][e]; x1[e] = h8[4 + e] + acc[ai][bj][m][1][e]; }
                    acc[ai][bj][m][0] = x0; acc[ai][bj][m][1] = x1;
#pragma unroll
                    for (int e = 0; e < 4; ++e) ssq += x0[e] * x0[e];
#pragma unroll
                    for (int e = 0; e < 4; ++e) ssq += x1[e] * x1[e];
                }
                ssq = xsum32p(xsum16p(ssq));
                if (fq == 0) gst<float>(ss + (size_t)(row0 + ai * HALF + m * 16) * 16 + u.pn * 4 + wc, ssq);
            }
            asm volatile("" ::: "memory");
        }
        xcd_barrier(*bar, 2);
        {
            const int tid_ = ((wr * 4 + wc) * 64) + fq * 16 + fr;
            const GAS f32x4* p = (const GAS f32x4*)(ss + (size_t)(u.pm * BM + (tid_ >> 1)) * 16) + (tid_ & 1) * 2; const f32x4 pa = p[0], pb = p[1];
            float t = ((pa[0] + pa[1]) + (pa[2] + pa[3])) + ((pb[0] + pb[1]) + (pb[2] + pb[3]));
            const float t2 = __shfl_xor(t, 1); t = (tid_ & 1) ? (t2 + t) : (t + t2);
            if ((tid_ & 1) == 0) ((LAS float*)rstab)[tid_ >> 1] = __builtin_amdgcn_rsqf(t * (1.0f / DM) + NORM_EPS);
            asm volatile("s_waitcnt lgkmcnt(0)" ::: "memory"); __builtin_amdgcn_s_barrier(); asm volatile("" ::: "memory");
        }
        float* op0 = OUT + (size_t)row0 * DM + col0;
#pragma unroll
        for (int bj = 0; bj < 2; ++bj) {
            const f32x4 g0 = gld<f32x4>(gain + col0 + bj * HALF), g1 = gld<f32x4>(gain + col0 + bj * HALF + 4);
#pragma unroll
            for (int ai = 0; ai < 2; ++ai)
#pragma unroll
                for (int m = 0; m < 4; ++m) {
                    const float rs = rstab[ai * HALF + wr * 64 + m * 16 + fr];
                    float* op = op0 + (size_t)(ai * HALF + m * 16) * DM + bj * HALF;
                    __builtin_nontemporal_store(acc[ai][bj][m][0] * rs * g0, (GAS f32x4*)op); __builtin_nontemporal_store(acc[ai][bj][m][1] * rs * g1, (GAS f32x4*)(op + 4));
                }
        }
        return true;
    }
};

struct Args { const float* in[23]; float* out; unsigned char* ws; int ph_lo, ph_hi, li, pad; };
enum { I_X = 0, I_NMIX, I_WIN, I_BGATE, I_SINK, I_WAO, I_CONVW, I_WCO, I_ARE, I_AIM, I_BRE, I_BIM, I_CRE, I_CIM, I_SD, I_LOGDT, I_WGLU, I_WSO, I_WMIX, I_NFFN, I_WFI, I_WFO, I_NFIN };
constexpr int PH_PER_LAYER = 7, PH_L0 = 2, PH_FINAL = PH_L0 + DEPTH * PH_PER_LAYER, N_PHASES = PH_FINAL + 1;
constexpr int N_WITEMS = 8576;

struct Frame {
    LAS unsigned char* lds;
    int tid, lane, wave, G;
    unsigned char* ws;
};

__device__ __forceinline__ void transpose_item(const float* W, int K, int N, bf16_t* WT, int kb, int nb, int drow0, const float* kscale, LAS float* scr, int lane) {
    const int k0 = 64 * kb, n0 = 32 * nb, c = lane & 7;
    f32x4 s0 = {1.f, 1.f, 1.f, 1.f}, s1 = {1.f, 1.f, 1.f, 1.f};
    if (kscale) { s0 = *(const f32x4*)(kscale + k0 + 8 * c); s1 = *(const f32x4*)(kscale + k0 + 8 * c + 4); }
    const float* src = W + (size_t)(k0 + (lane >> 5)) * N + n0 + (lane & 31);
    float w[32];
#pragma unroll
    for (int i = 0; i < 32; ++i) w[i] = __builtin_nontemporal_load(src + (size_t)(2 * i) * N);
#pragma unroll
    for (int i = 0; i < 32; ++i) scr[(2 * i + (lane >> 5)) * 33 + (lane & 31)] = w[i];
    asm volatile("s_waitcnt lgkmcnt(0)" ::: "memory");
#pragma unroll
    for (int j = 0; j < 4; ++j) { const int n = (lane >> 3) + 8 * j; const LAS float* s = scr + (8 * c) * 33 + n;
        u32x4 o; o.x = pk2(s[0 * 33] * s0[0], s[1 * 33] * s0[1]); o.y = pk2(s[2 * 33] * s0[2], s[3 * 33] * s0[3]); o.z = pk2(s[4 * 33] * s1[0], s[5 * 33] * s1[1]); o.w = pk2(s[6 * 33] * s1[2], s[7 * 33] * s1[3]);
        gst_wt16(WT + (size_t)(drow0 + n) * K + k0 + 8 * c, o); }
    asm volatile("s_waitcnt lgkmcnt(0)" ::: "memory");
}

__device__ __forceinline__ void prep_global(Frame& F, const Args& a) {
    F.tid = opaque_tid(F.wave); F.lane = F.tid & 63;
    float* rc = (float*)(F.ws + WS_ROPE); float* rsn = rc + SEQ * 8;
    const int gt = blockIdx.x * NTHREADS + F.tid, NT = F.G * NTHREADS;
    for (int i = gt; i < SEQ * 8; i += NT) {
        const int pos = i >> 3, j = i & 7;
        const float invf = (float)exp(-(double)(2 * j) / 16.0 * log(500000.0));
        const float ang = (float)pos * invf;
        double s, c; sincos((double)ang, &s, &c);
        rc[i] = (float)c; rsn[i] = (float)s;
    }
    for (int it = gt; it < DEPTH * 32 * 64 * 17; it += NT) {
        const int i = it / 17, k = it - i * 17;
        const int l = i >> 11, gp = i & 2047, g = gp >> 6;
        const double dt = exp((double)a.in[I_LOGDT][l * 32 + g]);
        const double ar = (double)a.in[I_ARE][i], aim = (double)a.in[I_AIM][i];
        const double mg = exp(ar * dt * k); double s2, c2; sincos(aim * dt * k, &s2, &c2);
        float* pw = (float*)(F.ws + WS_SSM + (size_t)l * SO_LAYER + SO_POW) + (size_t)gp * 34;
        pw[2 * k] = (float)(mg * c2); pw[2 * k + 1] = (float)(mg * s2);
        if (k == 1) {
            const double lr = mg * c2, li = mg * s2;
            const double nr = lr - 1.0, ni = li, den = ar * ar + aim * aim;
            const double cr = (nr * ar + ni * aim) / den, ci = (ni * ar - nr * aim) / den;
            float* lam = (float*)(F.ws + WS_SSM + (size_t)l * SO_LAYER + SO_LAM); float* bb = (float*)(F.ws + WS_SSM + (size_t)l * SO_LAYER + SO_BBAR);
            lam[gp * 2] = (float)lr; lam[gp * 2 + 1] = (float)li;
            const float* bre = a.in[I_BRE] + (size_t)i * 16; const float* bim = a.in[I_BIM] + (size_t)i * 16;
            for (int h = 0; h < 16; ++h) { const double br = bre[h], bi = bim[h]; bb[(gp * 16 + h) * 2] = (float)(cr * br - ci * bi); bb[(gp * 16 + h) * 2 + 1] = (float)(cr * bi + ci * br); }
        }
    }
    const int gw = blockIdx.x * NWAVES + F.wave, NGW = F.G * NWAVES;
    const float* x = a.in[I_X]; bf16_t* xb = (bf16_t*)(F.ws + WS_XBF); float* ss = (float*)(F.ws + WS_ROWSS);
    for (int r0 = gw; r0 < MTOK; r0 += 4 * NGW) {
        f32x4 v[4][4];
#pragma unroll
        for (int q = 0; q < 4; ++q) { const int r = min(r0 + q * NGW, MTOK - 1); const f32x4* xr = (const f32x4*)(x + (size_t)r * DM) + F.lane;
#pragma unroll
            for (int j = 0; j < 4; ++j) v[q][j] = __builtin_nontemporal_load(xr + 64 * j); }
#pragma unroll
        for (int q = 0; q < 4; ++q) {
            const int r = r0 + q * NGW;
            if (r < MTOK) {
                u32x2* ob = (u32x2*)(xb + (size_t)r * DM) + F.lane;
                float s = 0.f;
#pragma unroll
                for (int j = 0; j < 4; ++j) { const f32x4 t = v[q][j]; s += t[0] * t[0] + t[1] * t[1] + t[2] * t[2] + t[3] * t[3]; u32x2 w; w.x = pk2(t[0], t[1]); w.y = pk2(t[2], t[3]); ob[64 * j] = w; }
                s = wave_sum(s);
                if (F.lane < 16) ss[(size_t)r * 16 + F.lane] = (F.lane == 0) ? s : 0.f;
            }
        }
    }
}

__device__ __forceinline__ void prep_weights(Frame& F, const Args& a, int l, int it_lo, int it_hi, int gw, int ngw) {
    F.tid = opaque_tid(F.wave); F.lane = F.tid & 63;
    bf16_t* W = (bf16_t*)(F.ws + WS_W + (size_t)(l & 1) * W_BUF);
    LAS float* scr = (LAS float*)(F.lds + F.wave * 16384);
    const float* w_in = a.in[I_WIN] + (size_t)l * DM * INCOLS; const float* w_ao = a.in[I_WAO] + (size_t)l * 512 * DM; const float* w_co = a.in[I_WCO] + (size_t)l * 512 * DM;
    const float* w_gl = a.in[I_WGLU] + (size_t)l * 512 * 512; const float* w_so = a.in[I_WSO] + (size_t)l * 512 * DM; const float* w_mx = a.in[I_WMIX] + (size_t)l * DM * DM;
    const float* w_fi = a.in[I_WFI] + (size_t)l * DM * FFN2; const float* w_fo = a.in[I_WFO] + (size_t)l * FFN * DM;
    const float* nmix = a.in[I_NMIX] + l * DM; const float* nffn = a.in[I_NFFN] + l * DM;
    constexpr int I0 = 16 * 184, I1 = 8 * 32, I2 = 8 * 32, I3 = 8 * 16, I4 = 8 * 32, I5 = 16 * 32, I6 = 16 * 176, I7 = 44 * 32;
    static_assert(I0 + I1 + I2 + I3 + I4 + I5 + I6 + I7 == N_WITEMS, "weight items");
    for (int it = it_lo + gw; it < it_hi; it += ngw) {
        int r = it;
        if (r < I0) { const int kb = r / 184, nb = r % 184, n0 = 32 * nb; int d0 = n0;
            if (n0 >= C_CC && n0 < C_CX) { const int c = n0 - C_CC; d0 = 256 * (5 + c / 128) + (c % 128); }
            else if (n0 >= C_CX && n0 < C_U) { const int c = n0 - C_CX; d0 = 256 * (5 + c / 128) + 128 + (c % 128); }
            else if (n0 >= C_G && n0 < C_G + 1024) { const int c = n0 - C_G; d0 = 256 * (11 + c / 128) + (c % 128); }
            else if (n0 >= C_G + 1024 && n0 < C_G + 2048) { const int c = n0 - C_G - 1024; d0 = 256 * (11 + c / 128) + 128 + (c % 128); }
            transpose_item(w_in, DM, INCOLS, W + WO_IN, kb, nb, d0, nmix, scr, F.lane); continue; } r -= I0;
        if (r < I1) { const int kb = r / 32, nb = r % 32; transpose_item(w_ao, 512, DM, W + WO_AO, kb, nb, 32 * nb, nullptr, scr, F.lane); continue; } r -= I1;
        if (r < I2) { const int kb = r / 32, nb = r % 32; transpose_item(w_co, 512, DM, W + WO_CO, kb, nb, 32 * nb, nullptr, scr, F.lane); continue; } r -= I2;
        if (r < I3) { const int kb = r / 16, nb = r % 16; transpose_item(w_gl, 512, 512, W + WO_GLU, kb, nb, 32 * nb, nullptr, scr, F.lane); continue; } r -= I3;
        if (r < I4) { const int kb = r / 32, nb = r % 32; transpose_item(w_so, 512, DM, W + WO_SO, kb, nb, 32 * nb, nullptr, scr, F.lane); continue; } r -= I4;
        if (r < I5) { const int kb = r / 32, nb = r % 32; transpose_item(w_mx, DM, DM, W + WO_MIX, kb, nb, 32 * nb, nullptr, scr, F.lane); continue; } r -= I5;
        if (r < I6) { const int kb = r / 176, nb = r % 176; const int n0 = 32 * nb; const int j0 = n0 < FFN ? n0 : n0 - FFN; const int drow0 = 256 * (j0 / 128) + (n0 < FFN ? 0 : 128) + (j0 % 128);
            transpose_item(w_fi, DM, FFN2, W + WO_FI, kb, nb, drow0, nffn, scr, F.lane); continue; } r -= I6;
        { const int kb = r / 32, nb = r % 32; transpose_item(w_fo, FFN, DM, W + WO_FO, kb, nb, 32 * nb, nullptr, scr, F.lane); }
    }
}

__device__ __forceinline__ size_t wy_off(int g, int n, int k0) { return (size_t)g * 256 * 384 + (size_t)((((n >> 5) * 24 + (k0 >> 4)) * 64 + ((k0 >> 3) & 1) * 32 + (n & 31)) * 8); }
__device__ __forceinline__ size_t gt_off(int g, int n, int k0) { return (size_t)g * 128 * 256 + (size_t)((((n >> 5) * 16 + (k0 >> 4)) * 64 + ((k0 >> 3) & 1) * 32 + (n & 31)) * 8); }
__device__ __forceinline__ void prep_ssm(Frame& F, const Args& a, int l, int item_lo, int item_step) {
    F.tid = opaque_tid(F.wave); F.lane = F.tid & 63;
    __syncthreads();
    {
        LAS float* pw = (LAS float*)(F.lds);
        LAS float* cC = pw + 64 * 34;
        LAS float* bB = cC + 16 * 64 * 2;
        LAS float* kd = bB + 64 * 16 * 2;
        unsigned char* smm = F.ws + WS_SSMM + (size_t)(l & 1) * SSMM_BUF;
        bf16_t* WY = (bf16_t*)(smm + SM_WY); bf16_t* GT = (bf16_t*)(smm + SM_GT); float* L16 = (float*)(smm + SM_L16);
        const int tid = F.tid;
        for (int item = item_lo; item < 256; item += item_step) {
            const int g = item >> 3, part = item & 7;
            const float* gpw = (const float*)(F.ws + WS_SSM + (size_t)l * SO_LAYER + SO_POW) + (size_t)g * 64 * 34;
            const float* gbb = (const float*)(F.ws + WS_SSM + (size_t)l * SO_LAYER + SO_BBAR) + (size_t)g * 64 * 32;
            const float* gcr = a.in[I_CRE] + (size_t)(l * 32 + g) * 1024; const float* gci = a.in[I_CIM] + (size_t)(l * 32 + g) * 1024;
            for (int i = tid; i < 64 * 34; i += NTHREADS) pw[i] = gpw[i];
            for (int i = tid; i < 2048; i += NTHREADS) bB[i] = gbb[i];
            for (int i = tid; i < 1024; i += NTHREADS) { cC[2 * i] = gcr[i]; cC[2 * i + 1] = gci[i]; }
            __syncthreads();
            {
                const int dd = tid >> 8, h = (tid >> 4) & 15, h2 = tid & 15, d = 2 * part + dd;
                float a0 = 0.f, a1 = 0.f, a2 = 0.f, a3 = 0.f;
#pragma unroll 4
                for (int p = 0; p < 64; p += 4) {
#pragma unroll
                    for (int u = 0; u < 4; ++u) {
                        const f32x2 c = *(const LAS f32x2*)(cC + (h * 64 + p + u) * 2), w = *(const LAS f32x2*)(pw + (p + u) * 34 + 2 * d), bv = *(const LAS f32x2*)(bB + ((p + u) * 16 + h2) * 2);
                        const float tr = c[0] * w[0] - c[1] * w[1], ti = c[0] * w[1] + c[1] * w[0];
                        const float t = tr * bv[0] - ti * bv[1];
                        if (u == 0) a0 += t; else if (u == 1) a1 += t; else if (u == 2) a2 += t; else a3 += t;
                    }
                }
                float acc = (a0 + a1) + (a2 + a3);
                if (d == 0 && h == h2) acc += a.in[I_SD][l * 512 + g * 16 + h];
                kd[tid] = acc;
            }
            __syncthreads();
            for (int dd = 0; dd < 2; ++dd) {
                const int d = 2 * part + dd, nblk = 16 - d;
                for (int it = tid; it < nblk * 32; it += NTHREADS) {
                    const int bi = it >> 5, r = (it >> 1) & 15, hc = it & 1, tau = d + bi, sI = bi;
                    float v[8];
#pragma unroll
                    for (int j = 0; j < 8; ++j) v[j] = kd[(dd * 16 + r) * 16 + hc * 8 + j];
                    gst_wt16(WY + wy_off(g, tau * 16 + r, sI * 16 + hc * 8), pack8(v));
                }
            }
            if (tid < 32) { const int r = tid >> 1, hc = tid & 1; unsigned zz = 0u; asm volatile("" : "+v"(zz)); u32x4 z; z.x = zz; z.y = zz; z.z = zz; z.w = zz;
                gst_wt16(WY + wy_off(g, (2 * part) * 16 + r, (2 * part + 1) * 16 + hc * 8), z); }
            {
                const int r = tid >> 4, kc = tid & 15, n = part * 32 + r, tau = n >> 4, h = n & 15, q = kc * 8; const bool im = q >= 64; const int p0 = im ? q - 64 : q;
                float v[8];
#pragma unroll
                for (int j = 0; j < 8; ++j) { const int p = p0 + j; const float cr = cC[(h * 64 + p) * 2], ci = cC[(h * 64 + p) * 2 + 1], pr = pw[p * 34 + 2 * (tau + 1)], pi = pw[p * 34 + 2 * (tau + 1) + 1];
                    v[j] = im ? -(cr * pi + ci * pr) : (cr * pr - ci * pi); }
                gst_wt16(WY + wy_off(g, n, 256 + q), pack8(v));
            }
            {
                const int r = tid >> 5, kc = tid & 31, k0 = kc * 8, n = part * 16 + r, sI = k0 >> 4, h0 = k0 & 15, p = n & 63; const bool im = n >= 64;
                const float pr = pw[p * 34 + 2 * (15 - sI)], pi = pw[p * 34 + 2 * (15 - sI) + 1];
                float v[8];
#pragma unroll
                for (int j = 0; j < 8; ++j) { const float br = bB[(p * 16 + h0 + j) * 2], bi = bB[(p * 16 + h0 + j) * 2 + 1]; v[j] = im ? (pr * bi + pi * br) : (pr * br - pi * bi); }
                gst_wt16(GT + gt_off(g, n, k0), pack8(v));
            }
            if (part == 0 && tid < 64) { gst_wt4(&L16[(g * 64 + tid) * 2], pw[tid * 34 + 32]); gst_wt4(&L16[(g * 64 + tid) * 2 + 1], pw[tid * 34 + 33]); }
            __syncthreads();
        }
    }
}


typedef float f32x16 __attribute__((ext_vector_type(16)));
constexpr int UX_PITCH = 784, SSM_S_OFF = 64 * UX_PITCH;

constexpr int AT_KPITCH = 144, AT_VPITCH = 520, AT_VT_OFF = 256 * AT_KPITCH;

constexpr int CONVW_OFF = RING_BYTES + 8192;
__device__ __forceinline__ void conv_item(const bf16_t* CB, const bf16_t* ZC, bf16_t* CA, const LAS float* cw, int it) {
    const int row = it >> 6, c0 = (it & 63) * 8, t = row & (SEQ - 1);
    const size_t o = (size_t)row * 512 + c0;
    const size_t o1 = (t >= 1) ? o - 512 : o, o2 = (t >= 2) ? o - 1024 : o;
    const u32x4 vb = *(const u32x4*)(CB + o), vz0 = *(const u32x4*)(ZC + o), vz1 = *(const u32x4*)(ZC + o1), vz2 = *(const u32x4*)(ZC + o2);
    float cb[8], z0[8], z1[8], z2[8];
    unpack8(vb, cb); unpack8(vz0, z0); unpack8(vz1, z1); unpack8(vz2, z2);
    const float m1 = (t >= 1) ? 1.f : 0.f, m2 = (t >= 2) ? 1.f : 0.f;
    float v[8];
#pragma unroll
    for (int e = 0; e < 8; ++e) v[e] = cb[e] * (cw[c0 + e] * (z2[e] * m2) + cw[512 + c0 + e] * (z1[e] * m1) + cw[1024 + c0 + e] * z0[e]);
    *(u32x4*)(CA + o) = pack8(v);
}

template <int NB>
__device__ __forceinline__ void conv_batch(const bf16_t* CB, const bf16_t* ZC, bf16_t* CA, const LAS float* cw, int it0, int stride, int it_end) {
    u32x4 vb[NB], vz[NB][3];
#pragma unroll
    for (int k = 0; k < NB; ++k) {
        const int it = min(it0 + k * stride, it_end - 1);
        const int row = it >> 6, c0 = (it & 63) * 8, t = row & (SEQ - 1);
        const size_t o = (size_t)row * 512 + c0, o1 = (t >= 1) ? o - 512 : o, o2 = (t >= 2) ? o - 1024 : o;
        vb[k] = *(const u32x4*)(CB + o);
        vz[k][0] = *(const u32x4*)(ZC + o); vz[k][1] = *(const u32x4*)(ZC + o1); vz[k][2] = *(const u32x4*)(ZC + o2);
    }
#pragma unroll
    for (int k = 0; k < NB; ++k) {
        const int it = it0 + k * stride;
        if (it < it_end) {
            const int row = it >> 6, c0 = (it & 63) * 8, t = row & (SEQ - 1);
            float cb[8], z0[8], z1[8], z2[8];
            unpack8(vb[k], cb); unpack8(vz[k][0], z0); unpack8(vz[k][1], z1); unpack8(vz[k][2], z2);
            const float m1 = (t >= 1) ? 1.f : 0.f, m2 = (t >= 2) ? 1.f : 0.f;
            float v[8];
#pragma unroll
            for (int e = 0; e < 8; ++e) v[e] = cb[e] * (cw[c0 + e] * (z2[e] * m2) + cw[512 + c0 + e] * (z1[e] * m1) + cw[1024 + c0 + e] * z0[e]);
            *(u32x4*)(CA + (size_t)row * 512 + c0) = pack8(v);
        }
    }
}
__device__ __forceinline__ void conv_phase(Frame& F, const Args& a, int l, int blk, int nblk) {
    F.tid = opaque_tid(F.wave); F.lane = F.tid & 63;
    const bf16_t* CB = (const bf16_t*)(F.ws + WS_CB); const bf16_t* ZC = (const bf16_t*)(F.ws + WS_ZC);
    bf16_t* CA = (bf16_t*)(F.ws + WS_CA);
    LAS float* cw = (LAS float*)(F.lds + CONVW_OFF);
    for (int i = F.tid; i < 1536; i += NTHREADS) cw[i] = a.in[I_CONVW][l * 1536 + i];
    __syncthreads();
    const int per = (MTOK * 64 + nblk - 1) / nblk, lo = blk * per, hi = min(lo + per, MTOK * 64);
    for (int it0 = lo + F.tid; it0 < hi; it0 += 4 * NTHREADS) conv_batch<4>(CB, ZC, CA, cw, it0, NTHREADS, hi);
}

__device__ __forceinline__ void mixers_phase(Frame& F, const Args& a, int l, const bool do_conv) {
    F.tid = opaque_tid(F.wave); F.lane = F.tid & 63;
    const int tid = F.tid, lane = F.lane, wave = F.wave, l31 = lane & 31, hi = lane >> 5;
    const bf16_t* Q = (const bf16_t*)(F.ws + WS_Q); const bf16_t* Kb = (const bf16_t*)(F.ws + WS_K); const bf16_t* Vb = (const bf16_t*)(F.ws + WS_V);
    const bf16_t* CB = (const bf16_t*)(F.ws + WS_CB); const bf16_t* CC = (const bf16_t*)(F.ws + WS_ZC);
    const bf16_t* U = (const bf16_t*)(F.ws + WS_U);
    bf16_t* AO = (bf16_t*)(F.ws + WS_AO); bf16_t* YS = (bf16_t*)(F.ws + WS_YS); bf16_t* CA = (bf16_t*)(F.ws + WS_CA);
    const unsigned char* smm = F.ws + WS_SSMM + (size_t)(l & 1) * SSMM_BUF;
    const bf16_t* WY = (const bf16_t*)(smm + SM_WY); const bf16_t* GT = (const bf16_t*)(smm + SM_GT); const float* L16 = (const float*)(smm + SM_L16);
    LAS unsigned char* kl = F.lds; LAS unsigned char* vt = F.lds + AT_VT_OFF;
    LAS unsigned char* ux = F.lds; LAS float* S = (LAS float*)(F.lds + SSM_S_OFF);
    LAS float* cw = (LAS float*)(F.lds + CONVW_OFF);
    if (do_conv) for (int i = tid; i < 1536; i += NTHREADS) cw[i] = a.in[I_CONVW][l * 1536 + i];
    const int conv_per_blk = (MTOK * 64 + F.G - 1) / F.G;
    int conv_next = do_conv ? blockIdx.x * conv_per_blk : MTOK * 64; const int conv_end = do_conv ? min(conv_next + conv_per_blk, MTOK * 64) : MTOK * 64;
    const int n_units = (BATCH * 32 - (int)blockIdx.x + F.G - 1) / F.G;
    const int conv_per_slot = (conv_per_blk + 2 * n_units - 1) / (2 * n_units);
    for (int unit = blockIdx.x; unit < BATCH * 32; unit += F.G) {
        AMP_BEGIN(9);
        {
            const int b = unit & 7, n = unit >> 4, kvh = (unit >> 3) & 1;
            const int rowq0 = b * SEQ + n * 128, rowk0 = rowq0 - 128;
            const int hq = kvh * 4 + (wave >> 1);
            u32x4 kv[4], vv[4];
#pragma unroll
            for (int i = 0; i < 4; ++i) {
                const int v = tid + i * NTHREADS, key = v >> 3, dc = v & 7;
                const int rk = (n == 0 && key < 128) ? rowq0 : rowk0 + key;
                kv[i] = *(const u32x4*)(Kb + (size_t)rk * 128 + kvh * 64 + dc * 8);
                vv[i] = *(const u32x4*)(Vb + (size_t)rk * 128 + kvh * 64 + dc * 8);
            }
            bf16x8 qf[2][4];
#pragma unroll
            for (int sb = 0; sb < 2; ++sb)
#pragma unroll
                for (int ks = 0; ks < 4; ++ks) qf[sb][ks] = *(const bf16x8*)(Q + (size_t)(rowq0 + (wave & 1) * 64 + sb * 32 + l31) * 512 + hq * 64 + ks * 16 + hi * 8);
            const float sl = a.in[I_SINK][l * 8 + hq] * LOG2E;
#pragma unroll
            for (int i = 0; i < 4; ++i) {
                const int v = tid + i * NTHREADS, key = v >> 3, dc = v & 7;
                *(LAS u32x4*)(kl + key * AT_KPITCH + dc * 16) = kv[i];
                LAS bf16_t* vp = (LAS bf16_t*)(vt + (dc * 8) * AT_VPITCH + key * 2);
                vp[0 * (AT_VPITCH / 2)] = (bf16_t)(vv[i].x & 0xffffu); vp[1 * (AT_VPITCH / 2)] = (bf16_t)(vv[i].x >> 16);
                vp[2 * (AT_VPITCH / 2)] = (bf16_t)(vv[i].y & 0xffffu); vp[3 * (AT_VPITCH / 2)] = (bf16_t)(vv[i].y >> 16);
                vp[4 * (AT_VPITCH / 2)] = (bf16_t)(vv[i].z & 0xffffu); vp[5 * (AT_VPITCH / 2)] = (bf16_t)(vv[i].z >> 16);
                vp[6 * (AT_VPITCH / 2)] = (bf16_t)(vv[i].w & 0xffffu); vp[7 * (AT_VPITCH / 2)] = (bf16_t)(vv[i].w >> 16);
            }
            __syncthreads();
#pragma unroll
            for (int sb = 0; sb < 2; ++sb) {
                const int q0 = (wave & 1) * 64 + sb * 32;
                const size_t qrow = (size_t)(rowq0 + q0 + l31);
                f32x16 sc[5];
#pragma unroll
                for (int kt = 0; kt < 5; ++kt) {
                    f32x16 acc = {};
                    const LAS unsigned char* kp = kl + (q0 + 32 * kt + l31) * AT_KPITCH + hi * 16;
#pragma unroll
                    for (int ks = 0; ks < 4; ++ks) acc = __builtin_amdgcn_mfma_f32_32x32x16_bf16(*(const LAS bf16x8*)(kp + ks * 32), qf[sb][ks], acc, 0, 0, 0);
                    sc[kt] = acc;
                }
                const int dlt = l31 - 4 * hi;
                float mx = -1e30f;
#pragma unroll
                for (int kt = 0; kt < 5; ++kt) {
                    const bool tile_ok = (n > 0) || (q0 + 32 * kt >= 128);
                    if (!tile_ok) {
#pragma unroll
                        for (int r = 0; r < 16; ++r) sc[kt][r] = -1e30f;
                    } else if (kt == 0 || kt == 4) {
#pragma unroll
                        for (int r = 0; r < 16; ++r) {
                            const int c0 = (r & 3) + 8 * (r >> 2);
                            const bool ok = (kt == 0) ? (c0 > dlt) : (c0 <= dlt);
                            sc[kt][r] = ok ? sc[kt][r] : -1e30f;
                        }
                    }
#pragma unroll
                    for (int r = 0; r < 16; ++r) mx = fmaxf(mx, sc[kt][r]);
                }
                mx = fmaxf(mx, __shfl_xor(mx, 32));
                mx = fmaxf(mx, sl);
                float ls = 0.f;
#pragma unroll
                for (int kt = 0; kt < 5; ++kt)
#pragma unroll
                    for (int r = 0; r < 16; ++r) { const float p = __builtin_amdgcn_exp2f(sc[kt][r] - mx); sc[kt][r] = p; ls += p; }
                ls = xsum32p(ls);
                ls += __builtin_amdgcn_exp2f(sl - mx);
                f32x16 o0 = {}, o1 = {};
#pragma unroll
                for (int kt = 0; kt < 5; ++kt)
#pragma unroll
                    for (int s2 = 0; s2 < 2; ++s2) {
                        u32x4 pw; pw.x = pk2(sc[kt][8 * s2 + 0], sc[kt][8 * s2 + 1]); pw.y = pk2(sc[kt][8 * s2 + 2], sc[kt][8 * s2 + 3]); pw.z = pk2(sc[kt][8 * s2 + 4], sc[kt][8 * s2 + 5]); pw.w = pk2(sc[kt][8 * s2 + 6], sc[kt][8 * s2 + 7]);
                        const bf16x8 pf = __builtin_bit_cast(bf16x8, pw);
                        const int col = q0 + 32 * kt + 16 * s2 + 4 * hi;
                        const LAS unsigned char* vp0 = vt + l31 * AT_VPITCH + col * 2;
                        const LAS unsigned char* vp1 = vp0 + 32 * AT_VPITCH;
                        const u32x2 a0 = *(const LAS u32x2*)(vp0), a1 = *(const LAS u32x2*)(vp0 + 16);
                        const u32x2 c0 = *(const LAS u32x2*)(vp1), c1 = *(const LAS u32x2*)(vp1 + 16);
                        u32x4 va; va.x = a0.x; va.y = a0.y; va.z = a1.x; va.w = a1.y;
                        u32x4 vc; vc.x = c0.x; vc.y = c0.y; vc.z = c1.x; vc.w = c1.y;
                        o0 = __builtin_amdgcn_mfma_f32_32x32x16_bf16(__builtin_bit_cast(bf16x8, va), pf, o0, 0, 0, 0);
                        o1 = __builtin_amdgcn_mfma_f32_32x32x16_bf16(__builtin_bit_cast(bf16x8, vc), pf, o1, 0, 0, 0);
                    }
                const float inv = __builtin_amdgcn_rcpf(ls);
                bf16_t* op = AO + qrow * 512 + hq * 64 + 8 * hi;
#pragma unroll
                for (int hh = 0; hh < 2; ++hh) {
                    unsigned wx[4], wy[4];
#pragma unroll
                    for (int qd = 0; qd < 4; ++qd) {
                        float y0, y1, y2, y3;
                        if (hh == 0) { y0 = o0[4 * qd]; y1 = o0[4 * qd + 1]; y2 = o0[4 * qd + 2]; y3 = o0[4 * qd + 3]; } else { y0 = o1[4 * qd]; y1 = o1[4 * qd + 1]; y2 = o1[4 * qd + 2]; y3 = o1[4 * qd + 3]; }
                        wx[qd] = pk2(y0 * inv, y1 * inv); wy[qd] = pk2(y2 * inv, y3 * inv);
                    }
                    const auto a0x = __builtin_amdgcn_permlane32_swap(wx[0], wx[1], false, false), a0y = __builtin_amdgcn_permlane32_swap(wy[0], wy[1], false, false);
                    const auto a1x = __builtin_amdgcn_permlane32_swap(wx[2], wx[3], false, false), a1y = __builtin_amdgcn_permlane32_swap(wy[2], wy[3], false, false);
                    u32x4 lo4, hi4; lo4.x = a0x[0]; lo4.y = a0y[0]; lo4.z = a0x[1]; lo4.w = a0y[1]; hi4.x = a1x[0]; hi4.y = a1y[0]; hi4.z = a1x[1]; hi4.w = a1y[1];
                    *(u32x4*)(op + 32 * hh) = lo4; *(u32x4*)(op + 32 * hh + 16) = hi4;
                }
            }
        }
        AMP_END(9);
        AMP_BEGIN(10);
        {
            const int b = unit & 7, g = unit >> 3;
            const bf16_t* ug = U + (size_t)(b * 32 + g) * SEQ * 16;
            const bf16_t* wy = WY + (size_t)g * 256 * 384; const bf16_t* gt = GT + (size_t)g * 128 * 256;
            u32x4 ur[4];
#pragma unroll
            for (int i = 0; i < 4; ++i) ur[i] = ((const u32x4*)ug)[tid + i * NTHREADS];
            const int rb = wave >> 2, cb = wave & 3;
            float xr = 0.f, xi = 0.f, lr = 0.f, li = 0.f;
            { lr = L16[(g * 64 + lane) * 2]; li = L16[(g * 64 + lane) * 2 + 1]; }
            __syncthreads();
#pragma unroll 1
            for (int half = 0; half < 2; ++half) {
                bf16x8 gfr[16];
                { const __amdgpu_buffer_rsrc_t rg_ = bsrc(gt); const unsigned lo_ = (unsigned)lane * 16u, so_ = (unsigned)cb * 16u * 1024u;
#pragma unroll
                  for (int ks = 0; ks < 16; ++ks) gfr[ks] = __builtin_bit_cast(bf16x8, bld16s(rg_, lo_, so_ + (unsigned)ks * 1024u)); }
#pragma unroll
                for (int i = 0; i < 4; ++i) { const int v = tid + i * NTHREADS, c = v >> 5, kc = v & 31; *(LAS u32x4*)(ux + c * UX_PITCH + kc * 16) = ur[i]; }
                if (half == 0) {
#pragma unroll
                    for (int i = 0; i < 4; ++i) ur[i] = ((const u32x4*)(ug + (size_t)1024 * 16))[tid + i * NTHREADS];
                }
                __syncthreads();
                {
                    f32x16 acc = {};
                    const LAS unsigned char* ap = ux + (rb * 32 + l31) * UX_PITCH + hi * 16;
#pragma unroll
                    for (int ks = 0; ks < 16; ++ks) acc = __builtin_amdgcn_mfma_f32_32x32x16_bf16(*(const LAS bf16x8*)(ap + ks * 32), gfr[ks], acc, 0, 0, 0);
#pragma unroll
                    for (int r = 0; r < 16; ++r) S[(rb * 32 + (r & 3) + 8 * (r >> 2) + 4 * hi) * 128 + cb * 32 + l31] = acc[r];
                }
                bf16x8 afr[24];
                const int rbk = (wave < 4) ? wave : 11 - wave;
                { const __amdgpu_buffer_rsrc_t rw_ = bsrc(wy); const unsigned lo_ = (unsigned)lane * 16u, so_ = (unsigned)rbk * 24u * 1024u;
#pragma unroll
                  for (int ks = 0; ks < 24; ++ks) if (ks >= 16 || ks <= 2 * rbk + 1) afr[ks] = __builtin_bit_cast(bf16x8, bld16s(rw_, lo_, so_ + (unsigned)ks * 1024u)); else afr[ks] = (bf16x8){0, 0, 0, 0, 0, 0, 0, 0}; }
                __syncthreads();
                if (!do_conv) {
                    const f32x2 L1 = {lr, lr}, L2 = {-li, li};
                    f32x2 P[8]; f32x2 A = {0.f, 0.f};
#pragma unroll
                    for (int q = 0; q < 8; ++q) {
                        f32x2 sv; sv[0] = S[(8 * wave + q) * 128 + lane]; sv[1] = S[(8 * wave + q) * 128 + 64 + lane];
                        P[q] = A;
                        const f32x2 As = __builtin_shufflevector(A, A, 1, 0);
                        A = L1 * A + sv; A = L2 * As + A;
                    }
                    LAS float* T = S + 64 * 128;
                    T[wave * 128 + lane] = A[0]; T[wave * 128 + 64 + lane] = A[1];
                    float pr = lr, pi = li;
#pragma unroll
                    for (int k = 0; k < 3; ++k) { const float nr = pr * pr - pi * pi, ni = 2.f * pr * pi; pr = nr; pi = ni; }
                    const f32x2 M1 = {pr, pr}, M2 = {-pi, pi};
                    __syncthreads();
                    f32x2 C = {xr, xi}, Cw = C;
#pragma unroll
                    for (int j = 0; j < 8; ++j) {
                        if (j == wave) Cw = C;
                        f32x2 tv; tv[0] = T[j * 128 + lane]; tv[1] = T[j * 128 + 64 + lane];
                        const f32x2 Cs = __builtin_shufflevector(C, C, 1, 0);
                        C = M1 * C + tv; C = M2 * Cs + C;
                    }
                    xr = C[0]; xi = C[1];
                    f32x2 Y = Cw;
#pragma unroll
                    for (int q = 0; q < 8; ++q) {
                        const f32x2 X = Y + P[q];
                        const unsigned w = pk2(X[0], X[1]);
                        *(LAS bf16_t*)(ux + (8 * wave + q) * UX_PITCH + (256 + lane) * 2) = (bf16_t)(w & 0xffffu);
                        *(LAS bf16_t*)(ux + (8 * wave + q) * UX_PITCH + (320 + lane) * 2) = (bf16_t)(w >> 16);
                        const f32x2 Ys = __builtin_shufflevector(Y, Y, 1, 0);
                        Y = L1 * Y; Y = L2 * Ys + Y;
                    }
                } else if (wave == 0) {
                    f32x2 X = {xr, xi}; const f32x2 L1 = {lr, lr}, L2 = {-li, li};
                    f32x2 sn[8];
#pragma unroll
                    for (int q = 0; q < 8; ++q) { sn[q][0] = S[q * 128 + lane]; sn[q][1] = S[q * 128 + 64 + lane]; }
#pragma unroll 1
                    for (int c0 = 0; c0 < 64; c0 += 8) {
                        f32x2 sv[8];
#pragma unroll
                        for (int q = 0; q < 8; ++q) sv[q] = sn[q];
                        const int cn = (c0 + 8) & 63;
#pragma unroll
                        for (int q = 0; q < 8; ++q) { sn[q][0] = S[(cn + q) * 128 + lane]; sn[q][1] = S[(cn + q) * 128 + 64 + lane]; }
#pragma unroll
                        for (int q = 0; q < 8; ++q) {
                            const unsigned w = pk2(X[0], X[1]);
                            *(LAS bf16_t*)(ux + (c0 + q) * UX_PITCH + (256 + lane) * 2) = (bf16_t)(w & 0xffffu);
                            *(LAS bf16_t*)(ux + (c0 + q) * UX_PITCH + (320 + lane) * 2) = (bf16_t)(w >> 16);
                            const f32x2 Xs = __builtin_shufflevector(X, X, 1, 0);
                            X = L1 * X + sv[q];
                            X = L2 * Xs + X;
                        }
                    }
                    xr = X[0]; xi = X[1];
                } else {
                    const int slot_end = min(conv_next + conv_per_slot, conv_end);
                    for (int it = conv_next + (tid - 64); it < slot_end; it += NTHREADS - 64) conv_item(CB, CC, CA, cw, it);
                }
                conv_next = min(conv_next + conv_per_slot, conv_end);
                __syncthreads();
                {
                    f32x16 acc0 = {}, acc1 = {};
                    const LAS unsigned char* bp0 = ux + l31 * UX_PITCH + hi * 16;
                    const LAS unsigned char* bp1 = bp0 + 32 * UX_PITCH;
#pragma unroll
                    for (int ks = 0; ks < 24; ++ks) {
                        if (ks < 16 && ks > 2 * rbk + 1) continue;
                        const bf16x8 b0 = *(const LAS bf16x8*)(bp0 + ks * 32);
                        const bf16x8 b1 = *(const LAS bf16x8*)(bp1 + ks * 32);
                        acc0 = __builtin_amdgcn_mfma_f32_32x32x16_bf16(afr[ks], b0, acc0, 0, 0, 0);
                        acc1 = __builtin_amdgcn_mfma_f32_32x32x16_bf16(afr[ks], b1, acc1, 0, 0, 0);
                    }
#pragma unroll
                    for (int cbk = 0; cbk < 2; ++cbk) {
                        unsigned wx[4], wy[4];
#pragma unroll
                        for (int q = 0; q < 4; ++q) {
                            float y0, y1, y2, y3;
                            if (cbk == 0) { y0 = acc0[4 * q]; y1 = acc0[4 * q + 1]; y2 = acc0[4 * q + 2]; y3 = acc0[4 * q + 3]; } else { y0 = acc1[4 * q]; y1 = acc1[4 * q + 1]; y2 = acc1[4 * q + 2]; y3 = acc1[4 * q + 3]; }
                            wx[q] = pk2(gelu_tanh(y0), gelu_tanh(y1)); wy[q] = pk2(gelu_tanh(y2), gelu_tanh(y3));
                        }
                        const auto s0x = __builtin_amdgcn_permlane32_swap(wx[0], wx[2], false, false), s0y = __builtin_amdgcn_permlane32_swap(wy[0], wy[2], false, false);
                        const auto s1x = __builtin_amdgcn_permlane32_swap(wx[1], wx[3], false, false), s1y = __builtin_amdgcn_permlane32_swap(wy[1], wy[3], false, false);
                        u32x4 lo4, hi4; lo4.x = s0x[0]; lo4.y = s0y[0]; lo4.z = s0x[1]; lo4.w = s0y[1]; hi4.x = s1x[0]; hi4.y = s1y[0]; hi4.z = s1x[1]; hi4.w = s1y[1];
                        const size_t row = (size_t)b * SEQ + half * 1024 + 16 * (cbk * 32 + l31) + 2 * rbk + hi;
                        *(u32x4*)(YS + row * 512 + g * 16) = lo4; *(u32x4*)(YS + row * 512 + g * 16 + 8) = hi4;
                    }
                }
                __syncthreads();
            }
        }
        AMP_END(10);
    }
    for (int it = conv_next + tid; it < conv_end; it += NTHREADS) conv_item(CB, CC, CA, cw, it);
}

__device__ __forceinline__ void final_norm(Frame& F, const Args& a) {
    F.tid = opaque_tid(F.wave); F.lane = F.tid & 63;
    const int gw = blockIdx.x * NWAVES + F.wave, NGW = F.G * NWAVES;
    const float* ss = (const float*)(F.ws + WS_ROWSS); const float* gn = a.in[I_NFIN];
    const bf16_t* XB = (const bf16_t*)(F.ws + WS_XBF);
    for (int r = gw; r < MTOK; r += NGW) {
        const float rs = row_rs(ss, r);
        u32x2 hv[4];
#pragma unroll
        for (int j = 0; j < 4; ++j) hv[j] = *(const u32x2*)(XB + (size_t)r * DM + 256 * j + 4 * F.lane);
        f32x4* xr = (f32x4*)(a.out + (size_t)r * DM) + F.lane; const f32x4* gp = (const f32x4*)gn + F.lane;
#pragma unroll
        for (int j = 0; j < 4; ++j) { const f32x4 gg = gp[64 * j]; f32x4 v; v[0] = bflo(hv[j].x); v[1] = bfhi(hv[j].x); v[2] = bflo(hv[j].y); v[3] = bfhi(hv[j].y);
            xr[64 * j] = v * rs * gg; }
    }
}

#ifndef REP_INPROJ
#define REP_INPROJ 1
#endif
#ifndef REP_MIXERS
#define REP_MIXERS 1
#endif
#ifndef REP_FFNIN
#define REP_FFNIN 1
#endif
#ifndef REP_BAR
#define REP_BAR 1
#endif
#ifndef REP_MIXO
#define REP_MIXO 1
#endif
#ifndef REP_FFNOUT
#define REP_FFNOUT 1
#endif
#ifndef REP_MERGE
#define REP_MERGE 1
#endif
#define RUN_GEMM(g, S, E, acc, fresh) pg8::gemm_phase<decltype(E), true, true, pg8::NoHook>(F.lds, g, S, E, acc, fresh, pg8::NoHook{}, F.wave)
__global__ void __launch_bounds__(NTHREADS, 2) fwd_kernel(Args args) {
    extern __shared__ __attribute__((aligned(16))) unsigned char lds[];
    Frame F;
    F.lds = (LAS unsigned char*)lds; F.tid = threadIdx.x; F.lane = F.tid & 63; F.wave = __builtin_amdgcn_readfirstlane(F.tid >> 6); F.G = gridDim.x; F.ws = args.ws;
    const int lo = args.ph_lo, hi = args.ph_hi;
#define IN(k) (lo <= (k) && (k) < hi)
#define SEAM(k) do { if (IN(k) && IN((k) + 1)) { for (int rb_ = 0; rb_ < REP_BAR; ++rb_) xcd_barrier(bar); } } while (0)
#define SEAM_X(k) do { if (IN(k) && IN((k) + 1)) { for (int rb_ = 0; rb_ < REP_BAR; ++rb_) xcd_barrier(bar, 1); } } while (0)
#define SEAM_G(k) do { if (IN(k) && IN((k) + 1)) { for (int rb_ = 0; rb_ < REP_BAR; ++rb_) xcd_barrier(bar, 2); } } while (0)
#define REPEAT(n) for (int rep_ = 0; rep_ < (n); ++rep_, (rep_ < (n) ? xcd_barrier(bar) : (void)0))
    for (int u = F.tid; u < (LDS_BYTES - RING_BYTES) / 4; u += NTHREADS) ((LAS unsigned*)(F.lds + RING_BYTES))[u] = 0u;
    __syncthreads();
    XcdBarrier bar; bar.bar = (unsigned*)(args.ws + WS_CTL) + 4096; bar.x = 0; bar.st = (volatile LAS unsigned*)(F.lds + MISC_OFF); bar.wave = F.wave;
    if (hi - lo > 1) bar = xcd_barrier_post((unsigned*)(args.ws + WS_CTL) + 4096, (volatile LAS unsigned*)(F.lds + MISC_OFF), F.wave);
    unsigned char* ws0 = args.ws;
    unsigned* xcc_tbl = (unsigned*)(args.ws + WS_CTL) + 1024;
    if (hi - lo > 1 && xb_thread0(F.wave)) __hip_atomic_store(&xcc_tbl[blockIdx.x], xb_xcc_id() + 1u, __ATOMIC_RELAXED, __HIP_MEMORY_SCOPE_AGENT);
    const int gwave = blockIdx.x * NWAVES + F.wave, ngwave = F.G * NWAVES;
    { AMP_BEGIN(0); if (IN(0)) { prep_global(F, args); prep_weights(F, args, 0, 0, N_WITEMS, gwave, ngwave); } AMP_END(0); }
    SEAM(0);
    if (IN(0) && IN(1) && F.G == 256 && lo == 0 && hi == N_PHASES) {
        const int ln = (int)__builtin_amdgcn_mbcnt_hi(~0u, __builtin_amdgcn_mbcnt_lo(~0u, 0u));
        const unsigned head = __hip_atomic_load(&xcc_tbl[ln & 7], __ATOMIC_RELAXED, __HIP_MEMORY_SCOPE_AGENT);
        bool ok = head != 0u;
#pragma unroll
        for (int k = 0; k < 4; ++k) ok = ok && (__hip_atomic_load(&xcc_tbl[64 * k + ln], __ATOMIC_RELAXED, __HIP_MEMORY_SCOPE_AGENT) == head);
        bar.local_ok = __builtin_amdgcn_readfirstlane((int)(__builtin_amdgcn_ballot_w64(ok) == ~0ull)) != 0;
    }
    if (IN(1)) { prep_ssm(F, args, 0, (int)blockIdx.x, F.G); __syncthreads(); }
    SEAM(1);

#pragma unroll 1
    for (int l = 0; l < DEPTH; ++l) {
        const int pb = PH_L0 + l * PH_PER_LAYER;
        unsigned char* ws = ws0; asm volatile("" : "+s"(ws));
        bf16_t* W = (bf16_t*)(ws + WS_W + (size_t)(l & 1) * W_BUF);
        bf16_t* XB = (bf16_t*)(ws + WS_XBF);
        float* ROWSS = (float*)(ws + WS_ROWSS);
        bf16_t* Q = (bf16_t*)(ws + WS_Q); bf16_t* Kb = (bf16_t*)(ws + WS_K); bf16_t* Vb = (bf16_t*)(ws + WS_V);
        bf16_t* CB = (bf16_t*)(ws + WS_CB); bf16_t* CC = (bf16_t*)(ws + WS_ZC); bf16_t* U = (bf16_t*)(ws + WS_U);
        bf16_t* MG = (bf16_t*)(ws + WS_MG); bf16_t* Z = (bf16_t*)(ws + WS_Z);
        bf16_t* GT = (bf16_t*)(ws + WS_GT); bf16_t* HD = (bf16_t*)(ws + WS_HD);
        bf16_t* AO = (bf16_t*)(ws + WS_AO); bf16_t* YS = (bf16_t*)(ws + WS_YS); bf16_t* CA = (bf16_t*)(ws + WS_CA);
        int bid = blockIdx.x, Gv = F.G; asm volatile("" : "+s"(bid), "+s"(Gv));
        const bool split = (Gv == 256) && IN(pb + 2) && IN(pb + 3);
        AMP_BEGIN(1);
        if (IN(pb + 0)) {
            pg8::Gemm g{XB, XB, XB, W + WO_IN, W + WO_IN, W + WO_IN, DM, 0}; pg8::StaticOrder S; S.init(MTOK, INCOLS, F.G, (int)blockIdx.x, 1);
            pg8::EpiInProj E{ROWSS, (const float*)(ws + WS_ROPE), (const float*)(ws + WS_ROPE) + SEQ * 8, args.in[I_BGATE] + l * 3072, Q, Kb, Vb, CB, CC, U, GT};
            if (l + 1 < DEPTH) { if (Gv == 256) { if (bid >= 192) { prep_ssm(F, args, l + 1, bid - 192, 64); __syncthreads(); } } else { prep_ssm(F, args, l + 1, bid, Gv); __syncthreads(); } }
            REPEAT(REP_INPROJ) { pg8::Acc acc; RUN_GEMM(g, S, E, acc, true); }
        }
        AMP_END(1);
        SEAM_X(pb + 0);
        AMP_BEGIN(2);
        if (IN(pb + 1)) REPEAT(REP_MIXERS) { mixers_phase(F, args, l, !split); }
        AMP_END(2);
        SEAM_X(pb + 1);
#define GLU_UNITS() do { \
            {     \
                pg8::Gemm g{YS, YS, YS, W + WO_GLU, W + WO_GLU, W + WO_GLU, 512, 0}; pg8::StaticOrder S; S.init(MTOK, 512, F.G, (int)blockIdx.x, 1); \
                pg8::EpiGlu E{nullptr, YS, Z}; \
                pg8::Acc acc; RUN_GEMM(g, S, E, acc, true); \
            } \
            if (split) { if (bid >= 128) { conv_phase(F, args, l, (bid & 7) * 16 + (((bid >> 3) & 7) * 2 + ((bid - 128) >> 6)), 128);        __syncthreads(); } }     \
            } while (0)
        if (split) REPEAT(REP_MERGE) {
            { AMP_BEGIN(3); GLU_UNITS(); AMP_END(3); }
            AMP_BEGIN(4);
            pg8::Gemm g{AO, CA, Z, W + WO_AO, W + WO_CO, W + WO_SO, 512, 0}; pg8::StaticOrder S; S.init(MTOK, DM, F.G, (int)blockIdx.x, 3);
            pg8::EpiMerge E{nullptr, GT, MG, 0};
            const BarrierHook H{&bar, 1};
            pg8::Acc acc; pg8::gemm_phase<pg8::EpiMerge, true, true, BarrierHook>(F.lds, g, S, E, acc, true, H, F.wave);
            AMP_END(4);
        } else {
            if (IN(pb + 2)) GLU_UNITS();
            SEAM(pb + 2);
            if (IN(pb + 3)) {
                pg8::Gemm g{AO, CA, Z, W + WO_AO, W + WO_CO, W + WO_SO, 512, 0}; pg8::StaticOrder S; S.init(MTOK, DM, F.G, (int)blockIdx.x, 3);
                pg8::EpiMerge E{nullptr, GT, MG, 0};
                pg8::Acc acc; RUN_GEMM(g, S, E, acc, true);
            }
        }
#undef GLU_UNITS
        SEAM_G(pb + 3);
        AMP_BEGIN(5);
        if (IN(pb + 4)) {
            pg8::Gemm g{MG, MG, MG, W + WO_MIX, W + WO_MIX, W + WO_MIX, DM, 0}; pg8::StaticOrder S; S.init(MTOK, DM, F.G, (int)blockIdx.x, 1);
            REPEAT(REP_MIXO) { pg8::EpiResid E{nullptr, args.in[I_X], XB, ROWSS + (size_t)MTOK * 16, false, rep_ + 1 < REP_MIXO};        pg8::Acc acc; RUN_GEMM(g, S, E, acc, true); }
        }
        AMP_END(5);
        SEAM_G(pb + 4);
        AMP_BEGIN(6);
        if (IN(pb + 5)) {
            pg8::Gemm g{XB, XB, XB, W + WO_FI, W + WO_FI, W + WO_FI, DM, 0}; pg8::StaticOrder S; S.init(MTOK, FFN2, F.G, (int)blockIdx.x, 1);
            pg8::EpiFfnIn E{ROWSS + (size_t)MTOK * 16, HD};
            if (l + 1 < DEPTH) {
                if (Gv == 256) { if (bid >= 128) { prep_weights(F, args, l + 1, 0, N_WITEMS, bid * NWAVES + F.wave - 1024, 1024); __syncthreads(); } } else { prep_weights(F, args, l + 1, 0, N_WITEMS, bid * NWAVES + F.wave, Gv * NWAVES); __syncthreads(); }
            }
            REPEAT(REP_FFNIN) { pg8::Acc acc; RUN_GEMM(g, S, E, acc, true); }
        }
        AMP_END(6);
        SEAM_G(pb + 5);
        AMP_BEGIN(7);
        const bool fuse_final = (l == DEPTH - 1) && IN(pb + 6) && IN(PH_FINAL) && (Gv == 256);
        if (IN(pb + 6)) {
            pg8::Gemm g{HD, HD, HD, W + WO_FO, W + WO_FO, W + WO_FO, FFN, HD_PITCH}; pg8::StaticOrder S; S.init(MTOK, DM, F.G, (int)blockIdx.x, 1);
            if (fuse_final) {
                EpiResidFinal E{nullptr, XB, args.out, ROWSS, args.in[I_NFIN], &bar};
                pg8::Acc acc; RUN_GEMM(g, S, E, acc, true);
            } else {
                REPEAT(REP_FFNOUT) { pg8::EpiResid E{nullptr, args.in[I_X], XB, ROWSS, false, rep_ + 1 < REP_FFNOUT}; pg8::Acc acc; RUN_GEMM(g, S, E, acc, true); }
            }
        }
        AMP_END(7);
        if (!fuse_final) { if (IN(pb + 6) && IN(pb + 7)) xcd_barrier(bar, 3); }
    }
    { AMP_BEGIN(8); const bool final_fused = IN(PH_L0 + (DEPTH - 1) * PH_PER_LAYER + 6) && IN(PH_FINAL) && (F.G == 256); if (IN(PH_FINAL) && !final_fused) final_norm(F, args); AMP_END(8); }
#undef IN
}

extern "C" void kernel_launch(void* const* d_in, const int* in_sizes, int n_in, void* d_out, int out_size, void* d_ws, size_t ws_size, hipStream_t stream) {
    static int grid = 0;
    if (grid == 0) {
        if (n_in != 23 || out_size != MTOK * DM || ws_size < WS_END) { fprintf(stderr, "kernel_launch: unexpected shapes (n_in %d out %d ws %zu)\n", n_in, out_size, ws_size); grid = -1; return; }
        if (hipFuncSetAttribute((const void*)fwd_kernel, hipFuncAttributeMaxDynamicSharedMemorySize, LDS_BYTES) != hipSuccess) { fprintf(stderr, "hipFuncSetAttribute failed\n"); grid = -1; return; }
        int dev = 0, cus = 0, per_cu = 0; (void)hipGetDevice(&dev); (void)hipDeviceGetAttribute(&cus, hipDeviceAttributeMultiprocessorCount, dev);
        if (hipOccupancyMaxActiveBlocksPerMultiprocessor(&per_cu, (const void*)fwd_kernel, NTHREADS, LDS_BYTES) != hipSuccess || per_cu < 1) { fprintf(stderr, "occupancy query failed (%d)\n", per_cu); (void)hipGetLastError(); per_cu = 1; }
        grid = cus > 0 ? cus : 256;
    }
    if (grid < 0) return;
    (void)hipMemsetAsync((char*)d_ws, 0, ZERO_BYTES, stream);
    Args a{};
    for (int i = 0; i < 23; ++i) a.in[i] = (const float*)d_in[i];
    a.out = (float*)d_out; a.ws = (unsigned char*)d_ws;
#if N_LAUNCH_MODE == 1
    a.ph_lo = 0; a.ph_hi = N_PHASES; a.li = 0;
    void* kargs[] = {&a};
    hipError_t e = hipLaunchCooperativeKernel((const void*)fwd_kernel, dim3(grid), dim3(NTHREADS), kargs, LDS_BYTES, stream);
    if (e != hipSuccess) fprintf(stderr, "cooperative launch failed: %s (grid %d)\n", hipGetErrorString(e), grid);
#else
    for (int p = 0; p < N_PHASES; ++p) {
        a.ph_lo = p; a.ph_hi = p + 1; a.li = 0;
        hipLaunchKernelGGL(fwd_kernel, dim3(grid), dim3(NTHREADS), LDS_BYTES, stream, a);
    }
#endif
}
```
